# Optimizing an MI355X kernel written in HIP

```python
import math
import jax, jax.numpy as jnp
from jax import lax
import numpy as np

D_MODEL = 2048
BATCH = 4
SEQ = 2048
DEPTH = 1

MEM_LEN = 256
D_ATTN = D_MODEL // 2
D_SSM = D_MODEL - D_ATTN
DA_HEADS = 4
DA_QK_DIM = D_ATTN // DA_HEADS // 2
DA_V_DIM = 2 * DA_QK_DIM
Q_BLOCK = 128
SSM_GROUP = 16
SSM_GROUPS = D_SSM // SSM_GROUP
SSM_STATE = 64
X_HEADS = 4
X_HEAD_DIM = D_MODEL // X_HEADS
MOE_GROUPS = 8
EXP_PER_GROUP = 8
N_EXPERTS = MOE_GROUPS * EXP_PER_GROUP
TOP_K_FINE = 2
D_FF_EXPERT = D_MODEL // 4
MOE_BLOCK = 128
EPS = 1e-6
Q_COLS = DA_HEADS * 2 * DA_QK_DIM
K_COLS = DA_HEADS * 2 * DA_QK_DIM
V_COLS = DA_HEADS * DA_V_DIM
U_COLS = D_SSM
D_IN_PROJ = Q_COLS + K_COLS + V_COLS + U_COLS

kernel_name = "hymba_diffattn_s5_hmoe_layer"


def rms_norm(x, w):
    xf = x.astype(jnp.float32)
    y = xf * lax.rsqrt(jnp.mean(xf * xf, axis=-1, keepdims=True) + EPS)
    return (y * w.astype(jnp.float32)).astype(x.dtype)


def diff_attention(q, k, v, lam):
    bsz, seq = q.shape[0], q.shape[1]
    nb = seq // Q_BLOCK
    qb = q.reshape(bsz, nb, Q_BLOCK, DA_HEADS, 2, DA_QK_DIM).transpose(1, 0, 2, 3, 4, 5)
    kpos = jnp.arange(seq)
    scale = DA_QK_DIM ** -0.5
    neg = jnp.finfo(jnp.float32).min

    def block(args):
        qi, i = args
        s = jnp.einsum('bqhcd,bkhcd->bhcqk', qi, k).astype(jnp.float32) * scale
        qpos = i * Q_BLOCK + jnp.arange(Q_BLOCK)
        mask = kpos[None, :] <= qpos[:, None]
        p = jax.nn.softmax(jnp.where(mask, s, neg), axis=-1)
        p = p[:, :, 0] - lam * p[:, :, 1]
        return jnp.einsum('bhqk,bkhe->bqhe', p.astype(v.dtype), v)

    out = lax.map(block, (qb, jnp.arange(nb)))
    return out.transpose(1, 0, 2, 3, 4).reshape(bsz, seq, DA_HEADS, DA_V_DIM)


def _ssm_combine(e1, e2):
    a1r, a1i, b1r, b1i = e1
    a2r, a2i, b2r, b2i = e2
    return (a2r * a1r - a2i * a1i,
            a2r * a1i + a2i * a1r,
            a2r * b1r - a2i * b1i + b2r,
            a2r * b1i + a2i * b1r + b2i)


def s5_branch(u, lam_re, lam_im, log_dt, b_re, b_im, c_re, c_im, d_skip, glu_w, glu_b):
    bsz, seq = u.shape[0], u.shape[1]
    f32 = jnp.float32
    uf = u.astype(f32).reshape(bsz, seq, SSM_GROUPS, SSM_GROUP)
    lr = jnp.minimum(lam_re.astype(f32), -1e-4)
    li = lam_im.astype(f32)
    dt = jnp.exp(log_dt.astype(f32))[:, None]
    mag = jnp.exp(lr * dt)
    lb_re, lb_im = mag * jnp.cos(li * dt), mag * jnp.sin(li * dt)
    den = lr * lr + li * li
    coef_re = ((lb_re - 1.0) * lr + lb_im * li) / den
    coef_im = (lb_im * lr - (lb_re - 1.0) * li) / den
    br, bi = b_re.astype(f32), b_im.astype(f32)
    bb_re = coef_re[..., None] * br - coef_im[..., None] * bi
    bb_im = coef_re[..., None] * bi + coef_im[..., None] * br
    bu_re = jnp.einsum('gph,blgh->blgp', bb_re, uf)
    bu_im = jnp.einsum('gph,blgh->blgp', bb_im, uf)
    shape_a = (1, seq, SSM_GROUPS, SSM_STATE)
    a_re = jnp.broadcast_to(lb_re, shape_a)
    a_im = jnp.broadcast_to(lb_im, shape_a)
    _, _, xr, xi = lax.associative_scan(_ssm_combine, (a_re, a_im, bu_re, bu_im), axis=1)
    y = (jnp.einsum('ghp,blgp->blgh', c_re.astype(f32), xr)
         - jnp.einsum('ghp,blgp->blgh', c_im.astype(f32), xi)
         + d_skip.astype(f32) * uf)
    y = jax.nn.gelu(y.reshape(bsz, seq, D_SSM))
    y = y * jax.nn.sigmoid(y @ glu_w.astype(f32) + glu_b.astype(f32))
    return y.astype(u.dtype)


def memory_cross_attention(hn, mn, xq_w, xkv_w, xq_norm_w, xk_norm_w, xo_w):
    bsz, seq = hn.shape[0], hn.shape[1]
    m = mn.shape[1]
    q = rms_norm((hn @ xq_w).reshape(bsz, seq, X_HEADS, X_HEAD_DIM), xq_norm_w)
    kv = (mn @ xkv_w).reshape(bsz, m, 2, X_HEADS, X_HEAD_DIM)
    k = rms_norm(kv[:, :, 0], xk_norm_w)
    v = kv[:, :, 1]
    s = jnp.einsum('bqhd,bmhd->bhqm', q, k).astype(jnp.float32) * (X_HEAD_DIM ** -0.5)
    p = jax.nn.softmax(s, axis=-1)
    o = jnp.einsum('bhqm,bmhd->bqhd', p.astype(v.dtype), v).reshape(bsz, seq, D_MODEL)
    return o @ xo_w


def hier_moe(xn, w_c, b_c, w_f, b_f, w_g, w_u, w_d):
    bsz, seq, d = xn.shape
    t = bsz * seq
    xt = xn.reshape(t, d)
    p_c = jax.nn.softmax((xt @ w_c + b_c).astype(jnp.float32), axis=-1)
    grp = jnp.argmax(p_c, axis=-1).astype(jnp.int32)
    p_grp = jnp.max(p_c, axis=-1)
    fl = (xt @ w_f + b_f).astype(jnp.float32).reshape(t, MOE_GROUPS, EXP_PER_GROUP)
    fl = jnp.take_along_axis(fl, grp[:, None, None], axis=1)[:, 0]
    w_top, j_top = lax.top_k(jax.nn.softmax(fl, axis=-1), TOP_K_FINE)
    w_top = w_top / jnp.sum(w_top, axis=-1, keepdims=True) * p_grp[:, None]
    expert = grp[:, None] * EXP_PER_GROUP + j_top.astype(jnp.int32)
    n_assign = t * TOP_K_FINE
    e_flat = expert.reshape(n_assign)
    t_flat = jnp.repeat(jnp.arange(t, dtype=jnp.int32), TOP_K_FINE)
    w_flat = w_top.reshape(n_assign)
    order = jnp.argsort(e_flat)
    e_s, t_s, w_s = e_flat[order], t_flat[order], w_flat[order]
    counts = jnp.bincount(e_flat, length=N_EXPERTS)
    starts = jnp.cumsum(counts) - counts
    padded = (counts + MOE_BLOCK - 1) // MOE_BLOCK * MOE_BLOCK
    pad_end = jnp.cumsum(padded)
    pad_start = pad_end - padded
    dest = pad_start[e_s] + jnp.arange(n_assign) - starts[e_s]
    n_rows = (n_assign + N_EXPERTS * (MOE_BLOCK - 1) + MOE_BLOCK - 1) // MOE_BLOCK * MOE_BLOCK
    n_blocks = n_rows // MOE_BLOCK
    row_tok = jnp.zeros((n_rows,), jnp.int32).at[dest].set(t_s)
    row_w = jnp.zeros((n_rows,), jnp.float32).at[dest].set(w_s)
    blk_exp = jnp.minimum(
        jnp.searchsorted(pad_end, jnp.arange(n_blocks) * MOE_BLOCK, side='right'),
        N_EXPERTS - 1)
    xs = xt[row_tok].reshape(n_blocks, MOE_BLOCK, d)

    def run(args):
        xb, e = args
        return (jax.nn.silu(xb @ w_g[e]) * (xb @ w_u[e])) @ w_d[e]

    ys = lax.map(run, (xs, blk_exp)).reshape(n_rows, d)
    out = jnp.zeros((t, d), ys.dtype).at[row_tok].add(ys * row_w[:, None].astype(ys.dtype))
    return out.reshape(bsz, seq, d).astype(xn.dtype)


def setup_inputs(seed: int = 0) -> dict:
    key = jax.random.key(seed)
    ks = iter(jax.random.split(key, 64))

    def nrm(shape, scale):
        return jax.random.normal(next(ks), shape, jnp.float32) * scale

    def gain(shape):
        return 1.0 + 0.02 * jax.random.normal(next(ks), shape, jnp.float32)

    L, D, G, P, H = DEPTH, D_MODEL, SSM_GROUPS, SSM_STATE, SSM_GROUP
    n_idx = jnp.arange(P, dtype=jnp.float32)
    inp = {}
    inp['x'] = nrm((BATCH, SEQ, D), 1.0)
    inp['mem'] = nrm((BATCH, MEM_LEN, D), 1.0)
    inp['norm1_w'] = gain((L, D))
    inp['w_in'] = nrm((L, D, D_IN_PROJ), D ** -0.5)
    inp['q_norm_w'] = gain((L, DA_QK_DIM))
    inp['k_norm_w'] = gain((L, DA_QK_DIM))
    inp['lambda_q1'] = nrm((L, DA_QK_DIM), 0.1)
    inp['lambda_k1'] = nrm((L, DA_QK_DIM), 0.1)
    inp['lambda_q2'] = nrm((L, DA_QK_DIM), 0.1)
    inp['lambda_k2'] = nrm((L, DA_QK_DIM), 0.1)
    inp['subln_w'] = gain((L, DA_V_DIM))
    inp['ssm_lambda_re'] = -0.5 + nrm((L, G, P), 0.01)
    inp['ssm_lambda_im'] = math.pi * n_idx + nrm((L, G, P), 0.01)
    inp['ssm_log_dt'] = jax.random.uniform(next(ks), (L, G), jnp.float32,
                                           math.log(0.001), math.log(0.1))
    inp['ssm_b_re'] = nrm((L, G, P, H), (2.0 * H) ** -0.5)
    inp['ssm_b_im'] = nrm((L, G, P, H), (2.0 * H) ** -0.5)
    inp['ssm_c_re'] = nrm((L, G, H, P), (2.0 * P) ** -0.5)
    inp['ssm_c_im'] = nrm((L, G, H, P), (2.0 * P) ** -0.5)
    inp['ssm_d'] = nrm((L, G, H), 1.0)
    inp['ssm_glu_w'] = nrm((L, D_SSM, D_SSM), D_SSM ** -0.5)
    inp['ssm_glu_b'] = nrm((L, D_SSM), 0.01)
    inp['ssm_out_norm_w'] = gain((L, D_SSM))
    inp['w_out'] = nrm((L, D, D), D ** -0.5)
    inp['norm2_w'] = gain((L, D))
    inp['mem_norm_w'] = gain((L, D))
    inp['xq_w'] = nrm((L, D, D), D ** -0.5)
    inp['xkv_w'] = nrm((L, D, 2 * D), D ** -0.5)
    inp['xq_norm_w'] = gain((L, X_HEAD_DIM))
    inp['xk_norm_w'] = gain((L, X_HEAD_DIM))
    inp['xo_w'] = nrm((L, D, D), D ** -0.5)
    inp['norm3_w'] = gain((L, D))
    inp['router_coarse_w'] = nrm((L, D, MOE_GROUPS), D ** -0.5)
    inp['router_coarse_b'] = nrm((L, MOE_GROUPS), 0.01)
    inp['router_fine_w'] = nrm((L, D, N_EXPERTS), D ** -0.5)
    inp['router_fine_b'] = nrm((L, N_EXPERTS), 0.01)
    inp['expert_w_gate'] = nrm((L, N_EXPERTS, D, D_FF_EXPERT), D ** -0.5)
    inp['expert_w_up'] = nrm((L, N_EXPERTS, D, D_FF_EXPERT), D ** -0.5)
    inp['expert_w_down'] = nrm((L, N_EXPERTS, D_FF_EXPERT, D), D_FF_EXPERT ** -0.5)
    return inp


def reference(x, mem, norm1_w, w_in, q_norm_w, k_norm_w, lambda_q1, lambda_k1,
              lambda_q2, lambda_k2, subln_w, ssm_lambda_re, ssm_lambda_im, ssm_log_dt,
              ssm_b_re, ssm_b_im, ssm_c_re, ssm_c_im, ssm_d, ssm_glu_w, ssm_glu_b,
              ssm_out_norm_w, w_out, norm2_w, mem_norm_w, xq_w, xkv_w, xq_norm_w,
              xk_norm_w, xo_w, norm3_w, router_coarse_w, router_coarse_b,
              router_fine_w, router_fine_b, expert_w_gate, expert_w_up, expert_w_down):
    bsz, seq = x.shape[0], x.shape[1]
    h = x
    for l in range(DEPTH):
        lam_init = 0.8 - 0.6 * math.exp(-0.3 * l)
        xn = rms_norm(h, norm1_w[l])
        proj = xn @ w_in[l]
        q, k, v, u = jnp.split(proj, [Q_COLS, Q_COLS + K_COLS, Q_COLS + K_COLS + V_COLS], axis=-1)
        q = rms_norm(q.reshape(bsz, seq, DA_HEADS, 2, DA_QK_DIM), q_norm_w[l])
        k = rms_norm(k.reshape(bsz, seq, DA_HEADS, 2, DA_QK_DIM), k_norm_w[l])
        v = v.reshape(bsz, seq, DA_HEADS, DA_V_DIM)
        f32 = jnp.float32
        lam = (jnp.exp(jnp.sum(lambda_q1[l].astype(f32) * lambda_k1[l].astype(f32)))
               - jnp.exp(jnp.sum(lambda_q2[l].astype(f32) * lambda_k2[l].astype(f32)))
               + lam_init)
        a = diff_attention(q, k, v, lam)
        a = (rms_norm(a, subln_w[l]) * (1.0 - lam_init)).reshape(bsz, seq, D_ATTN)
        s = s5_branch(u, ssm_lambda_re[l], ssm_lambda_im[l], ssm_log_dt[l], ssm_b_re[l],
                      ssm_b_im[l], ssm_c_re[l], ssm_c_im[l], ssm_d[l], ssm_glu_w[l], ssm_glu_b[l])
        s = rms_norm(s, ssm_out_norm_w[l])
        h = h + (jnp.concatenate([a, s.astype(a.dtype)], axis=-1) @ w_out[l]).astype(h.dtype)
        hn = rms_norm(h, norm2_w[l])
        mn = rms_norm(mem, mem_norm_w[l])
        h = h + memory_cross_attention(hn, mn, xq_w[l], xkv_w[l], xq_norm_w[l],
                                       xk_norm_w[l], xo_w[l]).astype(h.dtype)
        hn = rms_norm(h, norm3_w[l])
        h = h + hier_moe(hn, router_coarse_w[l], router_coarse_b[l], router_fine_w[l],
                         router_fine_b[l], expert_w_gate[l], expert_w_up[l],
                         expert_w_down[l]).astype(h.dtype)
    return h
```

```cpp
#include <hip/hip_runtime.h>
#include <hip/hip_bf16.h>
#include <cstdio>
#include <cstdint>
#include <cstddef>
#include <cmath>
__device__ __forceinline__ int mk_otid() { int t = threadIdx.x; asm volatile("" : "+v"(t)); return t; }

namespace pg8 {
#define PG8_LAS __attribute__((address_space(3)))
typedef unsigned short bf16_t;
typedef short bf16x8 __attribute__((ext_vector_type(8)));
typedef float f32x4 __attribute__((ext_vector_type(4)));
typedef float f32x2 __attribute__((ext_vector_type(2)));
typedef unsigned u32x4 __attribute__((ext_vector_type(4)));
typedef unsigned u32x2 __attribute__((ext_vector_type(2)));
constexpr int BM = 256, BK = 64, HALF = 128, HTB = HALF * BK * 2, STAGE_BYTES = 8 * HTB;

__host__ __device__ __forceinline__ int lds_byte(int r, int c) { const int st = (r >> 4) * 2 + (c >> 5), rr = r & 15, cc = c & 31, ob = rr * 64 + cc * 2; return st * 1024 + (ob ^ (((ob >> 9) & 1) << 5)); }
__host__ __device__ __forceinline__ void stage_rc(int b, int& R, int& C) { const int st = b / 1024, sb = b % 1024, swz = sb ^ (((sb >> 9) & 1) << 5); R = (st >> 1) * 16 + swz / 64; C = (st & 1) * 32 + (swz % 64) / 2; }
__host__ __device__ __forceinline__ int perm32(int rho) { const int n = rho >> 4, i = rho & 15; return 8 * (i >> 2) + 4 * n + (i & 3); }

struct Unit { const char* A; const char* B; int pm, pn, aux0, aux1; };
struct Gemm { int K, lda, ldb; };

__device__ __forceinline__ unsigned cvt_pk_bf16(float lo, float hi) { unsigned r; asm volatile("v_cvt_pk_bf16_f32 %0, %1, %2" : "=v"(r) : "v"(lo), "v"(hi)); return r; }
__device__ __forceinline__ float bf_lo(unsigned w) { return __uint_as_float(w << 16); }
__device__ __forceinline__ float bf_hi(unsigned w) { return __uint_as_float(w & 0xffff0000u); }

template <class Epi, class Sched, bool SP2 = true>
__device__ __forceinline__ void gemm_phase(PG8_LAS unsigned char* lds, const Gemm g, const Sched& S, const Epi& E) {
    const int tid = mk_otid(), wid = __builtin_amdgcn_readfirstlane(tid >> 6), lane = tid & 63, wr = wid >> 2, wc = wid & 3, fr = lane & 15, fq = lane >> 4;
    const int K = g.K, nt = K / BK;
    unsigned voffA[2], voffB[2];
#pragma unroll
    for (int i = 0; i < 2; ++i) { int R, C; stage_rc(tid * 16 + i * 8192, R, C); const int Rb = Epi::PERM ? ((R & ~31) + perm32(R & 31)) : R;
        voffA[i] = (unsigned)(R * g.lda + C) * 2u; voffB[i] = (unsigned)(Rb * g.ldb + C) * 2u; }
    const size_t kstep = (size_t)(BK * 2);
    const size_t hstepA = (size_t)HALF * g.lda * 2, hstepB = (size_t)HALF * g.ldb * 2;
    const unsigned ldsw = (unsigned)wid * 1024u;
    const int aoff = lds_byte(wr * 64 + fr, fq * 8), boff = lds_byte(wc * 32 + fr, fq * 8);
#define PG8_SA(b, h) (((b) * 2 + (h)) * HTB)
#define PG8_SB(b, h) ((4 + (b) * 2 + (h)) * HTB)
#define PG8_STAGE(bufoff, gbase, voff) do { _Pragma("unroll") for (int _i = 0; _i < 2; ++_i) \
        __builtin_amdgcn_global_load_lds((const unsigned*)((const char*)(gbase) + (voff)[_i]), (PG8_LAS unsigned*)(lds + (bufoff) + ldsw + _i * 8192), 16, 0, 0); } while (0)
#define PG8_LDA(dst, b, h) do { _Pragma("unroll") for (int m = 0; m < 4; ++m) _Pragma("unroll") for (int k = 0; k < 2; ++k) dst[m][k] = *(const PG8_LAS bf16x8*)(lds + PG8_SA(b, h) + aoff + m * 2048 + k * 1024); } while (0)
#define PG8_LDB(dst, b, h) do { _Pragma("unroll") for (int n = 0; n < 2; ++n) _Pragma("unroll") for (int k = 0; k < 2; ++k) dst[n][k] = *(const PG8_LAS bf16x8*)(lds + PG8_SB(b, h) + boff + n * 2048 + k * 1024); } while (0)
#define PG8_MMA(ai, bj, At, Bt) do { __builtin_amdgcn_s_setprio(1); _Pragma("unroll") for (int m = 0; m < 4; ++m) _Pragma("unroll") for (int n = 0; n < 2; ++n) _Pragma("unroll") for (int k = 0; k < 2; ++k) \
        acc[ai][bj][m][n] = __builtin_amdgcn_mfma_f32_16x16x32_bf16(Bt[n][k], At[m][k], acc[ai][bj][m][n], 0, 0, 0); __builtin_amdgcn_s_setprio(0); } while (0)
#define PG8_WAIT_V(n) asm volatile("s_waitcnt vmcnt(" #n ")" ::: "memory")
#define PG8_WAIT_L(n) asm volatile("s_waitcnt lgkmcnt(" #n ")" ::: "memory")
#define PG8_BAR __builtin_amdgcn_s_barrier()
#define PG8_SCHED __builtin_amdgcn_sched_barrier(0)
    Unit cur, nxt; int ui = 0;
    if (!S.next(0, cur)) return;
    f32x4 acc[2][2][4][2];
#pragma unroll
    for (int a = 0; a < 2; ++a)
#pragma unroll
        for (int b = 0; b < 2; ++b)
#pragma unroll
            for (int m = 0; m < 4; ++m)
#pragma unroll
                for (int n = 0; n < 2; ++n) acc[a][b][m][n] = (f32x4){0.f, 0.f, 0.f, 0.f};
    bf16x8 At[4][2], B0[2][2], B1[2][2];
    const char* cA = cur.A; const char* cB = cur.B;
    E.prep(cur);
    if constexpr (SP2) {
        PG8_STAGE(PG8_SB(0, 0), cB, voffB); PG8_STAGE(PG8_SB(0, 1), cB + hstepB, voffB); PG8_STAGE(PG8_SA(0, 0), cA, voffA); PG8_STAGE(PG8_SA(0, 1), cA + hstepA, voffA);
        if (wr == 1) PG8_BAR;
        PG8_WAIT_V(2); PG8_BAR;
        PG8_STAGE(PG8_SB(1, 0), cB + kstep, voffB); PG8_STAGE(PG8_SA(1, 0), cA + kstep, voffA); PG8_STAGE(PG8_SB(1, 1), cB + hstepB + kstep, voffB);
        PG8_WAIT_V(6); PG8_BAR;
    } else {
        PG8_STAGE(PG8_SB(0, 0), cB, voffB); PG8_STAGE(PG8_SA(0, 0), cA, voffA); PG8_STAGE(PG8_SB(0, 1), cB + hstepB, voffB); PG8_STAGE(PG8_SA(0, 1), cA + hstepA, voffA);
        if (wr == 1) PG8_BAR;
        PG8_WAIT_V(4); PG8_BAR;
        PG8_STAGE(PG8_SB(1, 0), cB + kstep, voffB); PG8_STAGE(PG8_SA(1, 0), cA + kstep, voffA); PG8_STAGE(PG8_SB(1, 1), cB + hstepB + kstep, voffB);
        PG8_WAIT_V(6); PG8_BAR;
    }
    for (;;) {
        const bool has_next = S.next(ui + 1, nxt);
        const char* nA = has_next ? nxt.A : cA; const char* nB = has_next ? nxt.B : cB;
        for (int t = 0; t < nt; t += 2) {
            const bool last = (t == nt - 2);
            const char* a1 = cA + (size_t)(t + 1) * kstep;
            const char* a2 = last ? nA : cA + (size_t)(t + 2) * kstep; const char* b2 = last ? nB : cB + (size_t)(t + 2) * kstep;
            const char* a3 = a2 + kstep; const char* b3 = b2 + kstep;
            if constexpr (Epi::MIDT >= 0) { if (t == Epi::MIDT) { int fr_ = fr, fq_ = fq; asm volatile("" : "+v"(fr_), "+v"(fq_)); E.mid(acc, cur, wr, wc, fr_, fq_); } }
            if constexpr (SP2) {
            PG8_LDB(B0, 0, 0); PG8_LDB(B1, 0, 1); PG8_SCHED; PG8_LDA(At, 0, 0); PG8_STAGE(PG8_SA(1, 1), a1 + hstepA, voffA);
            PG8_WAIT_V(8); PG8_WAIT_L(0); PG8_BAR; PG8_MMA(0, 0, At, B0); PG8_MMA(0, 1, At, B1); PG8_BAR; PG8_SCHED;
            PG8_LDA(At, 0, 1); PG8_STAGE(PG8_SB(0, 0), b2, voffB); PG8_STAGE(PG8_SB(0, 1), b2 + hstepB, voffB); PG8_STAGE(PG8_SA(0, 0), a2, voffA);
            PG8_WAIT_V(8); PG8_WAIT_L(0); PG8_BAR; PG8_MMA(1, 0, At, B0); PG8_MMA(1, 1, At, B1); PG8_BAR; PG8_SCHED;
            PG8_LDB(B0, 1, 0); PG8_LDB(B1, 1, 1); PG8_SCHED; PG8_LDA(At, 1, 0); PG8_STAGE(PG8_SA(0, 1), a2 + hstepA, voffA);
            PG8_WAIT_V(8); PG8_WAIT_L(0); PG8_BAR; PG8_MMA(0, 0, At, B0); PG8_MMA(0, 1, At, B1); PG8_BAR; PG8_SCHED;
            PG8_LDA(At, 1, 1); PG8_STAGE(PG8_SB(1, 0), b3, voffB); PG8_STAGE(PG8_SB(1, 1), b3 + hstepB, voffB); PG8_STAGE(PG8_SA(1, 0), a3, voffA);
            PG8_WAIT_V(8); PG8_WAIT_L(0); PG8_BAR; PG8_MMA(1, 0, At, B0); PG8_MMA(1, 1, At, B1); PG8_BAR; PG8_SCHED;
            } else {
            PG8_LDB(B0, 0, 0); PG8_SCHED; PG8_LDA(At, 0, 0); PG8_STAGE(PG8_SA(1, 1), a1 + hstepA, voffA);
            PG8_WAIT_L(8); PG8_BAR; PG8_WAIT_L(0); PG8_MMA(0, 0, At, B0); PG8_BAR; PG8_SCHED;
            PG8_LDB(B1, 0, 1); PG8_STAGE(PG8_SB(0, 0), b2, voffB);
            PG8_BAR; PG8_WAIT_L(0); PG8_MMA(0, 1, At, B1); PG8_BAR;
            PG8_LDA(At, 0, 1); PG8_STAGE(PG8_SA(0, 0), a2, voffA);
            PG8_BAR; PG8_WAIT_L(0); PG8_MMA(1, 0, At, B0); PG8_BAR; PG8_SCHED;
            PG8_STAGE(PG8_SB(0, 1), b2 + hstepB, voffB);
            PG8_WAIT_V(6); PG8_BAR; PG8_MMA(1, 1, At, B1); PG8_BAR;
            PG8_LDB(B0, 1, 0); PG8_SCHED; PG8_LDA(At, 1, 0); PG8_STAGE(PG8_SA(0, 1), a2 + hstepA, voffA);
            PG8_WAIT_L(8); PG8_BAR; PG8_WAIT_L(0); PG8_MMA(0, 0, At, B0); PG8_BAR; PG8_SCHED;
            PG8_LDB(B1, 1, 1); PG8_STAGE(PG8_SB(1, 0), b3, voffB);
            PG8_BAR; PG8_WAIT_L(0); PG8_MMA(0, 1, At, B1); PG8_BAR;
            PG8_LDA(At, 1, 1); PG8_STAGE(PG8_SA(1, 0), a3, voffA);
            PG8_BAR; PG8_WAIT_L(0); PG8_MMA(1, 0, At, B0); PG8_BAR; PG8_SCHED;
            PG8_STAGE(PG8_SB(1, 1), b3 + hstepB, voffB);
            PG8_WAIT_V(6); PG8_BAR; PG8_MMA(1, 1, At, B1); PG8_BAR;
            }
        }
        if (wr == 0) PG8_BAR;
        { int fr_ = fr, fq_ = fq; asm volatile("" : "+v"(fr_), "+v"(fq_));
          E(acc, cur, wr, wc, fr_, fq_); }
        if (!has_next) break;
        E.prep(nxt);
#pragma unroll
        for (int a = 0; a < 2; ++a)
#pragma unroll
            for (int b = 0; b < 2; ++b)
#pragma unroll
                for (int m = 0; m < 4; ++m)
#pragma unroll
                    for (int n = 0; n < 2; ++n) acc[a][b][m][n] = (f32x4){0.f, 0.f, 0.f, 0.f};
        cur = nxt; cA = nA; cB = nB; ++ui;
        if (wr == 1) PG8_BAR;
    }
    PG8_WAIT_V(0);
    PG8_BAR;
#undef PG8_SA
#undef PG8_SB
#undef PG8_STAGE
#undef PG8_LDA
#undef PG8_LDB
#undef PG8_MMA
#undef PG8_WAIT_V
#undef PG8_WAIT_L
#undef PG8_SCHED
}
}

namespace attn {
constexpr int D = 128;
constexpr float THR = 8.f;
constexpr bool WSKIP = false;
constexpr float SCALE = 0.08838834764831845f;
constexpr int NW = 8, QBLK = 32, KVBLK = 64, QB = NW * QBLK;
constexpr int SHM_V = KVBLK * D * 2, SHM_K = KVBLK * D * 2;
constexpr int LDS_BYTES = 2 * SHM_V + 2 * SHM_K + NW * 64 * 4;

using bf16 = __hip_bfloat16;
typedef short bf16x8 __attribute__((ext_vector_type(8)));
typedef short s16x4 __attribute__((ext_vector_type(4)));
typedef float f32x16 __attribute__((ext_vector_type(16)));
typedef float f32x4 __attribute__((ext_vector_type(4)));
typedef unsigned u32x4 __attribute__((ext_vector_type(4)));
template <class A, class Bt> struct same_t { static constexpr bool v = false; };
template <class A> struct same_t<A, A> { static constexpr bool v = true; };

#define KSWZ(row, colB) ((row) * 256 + ((colB) ^ (((row) & 7) << 4)))
#define SBAR() __builtin_amdgcn_sched_barrier(0)
__device__ __forceinline__ int v_st(int k, int c) { const int kk = (k & ~0xC) | ((k & 4) << 1) | ((k & 8) >> 1); return ((kk >> 3) * 4 + (c >> 5)) * 512 + ((kk & 7) * 32 + (c & 31)) * 2; }
__device__ __forceinline__ int v_rd_base(int lane) { return ((lane & 3) << 3) | (((lane >> 2) & 3) << 6) | (((lane >> 4) & 1) << 5) | (((lane >> 5) & 1) << 8); }
constexpr int v_rd_off(int d0, int ks, int half) { return d0 * 512 + ks * 4096 + half * 2048; }
__device__ __forceinline__ int crow(int r, int hi) { return (r & 3) + 8 * (r >> 2) + 4 * hi; }
__device__ __forceinline__ unsigned cvtpk(float lo, float hi) {
    unsigned r; asm volatile("v_cvt_pk_bf16_f32 %0, %1, %2" : "=v"(r) : "v"(lo), "v"(hi)); return r;
}
__device__ __forceinline__ bf16x8 pack8(f32x4 a, f32x4 b) {
    u32x4 w = {cvtpk(a[0], a[1]), cvtpk(a[2], a[3]), cvtpk(b[0], b[1]), cvtpk(b[2], b[3])};
    return *reinterpret_cast<bf16x8*>(&w);
}
template <class T> __device__ __forceinline__ bf16x8 load8(const T* p) {
    if constexpr (same_t<T, float>::v) { return pack8(*(const f32x4*)p, *(const f32x4*)(p + 4)); }
    else { return *reinterpret_cast<const bf16x8*>(p); }
}
__device__ __forceinline__ void mask_tile(f32x16& p0, f32x16& p1, int dq, unsigned W) {
    const float NEG = -__builtin_inff();
#pragma unroll
    for (int r = 0; r < 16; ++r) {
        const int c = (r & 3) + 8 * (r >> 2);
        if ((unsigned)(dq - c) >= W) p0[r] = NEG;
        if ((unsigned)(dq - c - 32) >= W) p1[r] = NEG;
    }
}
__device__ __forceinline__ void partialSM(f32x16& p0, f32x16& p1, float& m_reg, float& mn, float& alpha) {
    float pmax = p0[0]; for (int r = 1; r < 16; ++r) pmax = fmaxf(pmax, p0[r]); for (int r = 0; r < 16; ++r) pmax = fmaxf(pmax, p1[r]);
    { auto rr = __builtin_amdgcn_permlane32_swap(__float_as_uint(pmax), __float_as_uint(pmax), false, false);
      pmax = fmaxf(__uint_as_float(rr[0]), __uint_as_float(rr[1])); }
    constexpr float C2 = 1.4426950408889634f * SCALE;
    if (__builtin_expect(__all((pmax - m_reg) * SCALE <= THR), 1)) { mn = m_reg; alpha = 1.f; }
    else { mn = fmaxf(m_reg, pmax); alpha = __builtin_amdgcn_exp2f((m_reg - mn) * C2); m_reg = mn; }
    const float mnL = -mn * C2;
    for (int r = 0; r < 16; ++r) p0[r] = fmaf(p0[r], C2, mnL); for (int r = 0; r < 16; ++r) p1[r] = fmaf(p1[r], C2, mnL);
    for (int r = 0; r < 16; ++r) p0[r] = __builtin_amdgcn_exp2f(p0[r]);
}
__device__ __forceinline__ void finishSM(f32x16& p0, f32x16& p1, float alpha, float& l_reg, bf16x8& pa0, bf16x8& pa1, bf16x8& pa2, bf16x8& pa3) {
    for (int r = 0; r < 16; ++r) p1[r] = __builtin_amdgcn_exp2f(p1[r]);
    float ps = 0; for (int r = 0; r < 16; ++r) ps += p0[r]; for (int r = 0; r < 16; ++r) ps += p1[r];
    { auto rr = __builtin_amdgcn_permlane32_swap(__float_as_uint(ps), __float_as_uint(ps), false, false);
      ps = __uint_as_float(rr[0]) + __uint_as_float(rr[1]); }
    l_reg = l_reg * alpha + ps;
#define PK4(P, B_, OUT) do { unsigned a0 = cvtpk(P[B_+0], P[B_+1]), a1 = cvtpk(P[B_+2], P[B_+3]);                          \
        unsigned b0 = cvtpk(P[B_+4], P[B_+5]), b1 = cvtpk(P[B_+6], P[B_+7]);                                             \
        auto r0 = __builtin_amdgcn_permlane32_swap(a0, b0, false, false); auto r1 = __builtin_amdgcn_permlane32_swap(a1, b1, false, false); \
        u32x4 w = {r0[0], r1[0], r0[1], r1[1]}; OUT = *reinterpret_cast<bf16x8*>(&w); } while (0)
    PK4(p0, 0, pa0); PK4(p0, 8, pa1); PK4(p1, 0, pa2); PK4(p1, 8, pa3);
#undef PK4
}
template <int KB, bool SK>
__device__ __forceinline__ void qkt(f32x16& p0, f32x16& p1, const char* K_lds, int r32, int hi, const bf16x8* qr, bool act) {
    if (SK && !act) { const float NEG = -__builtin_inff();
#pragma unroll
        for (int r = 0; r < 16; ++r) { p0[r] = NEG; p1[r] = NEG; } return; }
    p0 = f32x16{}; p1 = f32x16{};
    const char* kb[4];
#pragma unroll
    for (int dd = 0; dd < 4; ++dd) kb[dd] = K_lds + KB * SHM_K + KSWZ(r32, (dd * 16 + hi * 8) * 2);
#pragma unroll
    for (int d0 = 0; d0 < 8; ++d0) { const char* a = kb[d0 & 3] + (d0 >> 2) * 128;
        bf16x8 b0 = *reinterpret_cast<const bf16x8*>(a);
        bf16x8 b1 = *reinterpret_cast<const bf16x8*>(a + 32 * 256);
        p0 = __builtin_amdgcn_mfma_f32_32x32x16_bf16(b0, qr[d0], p0, 0, 0, 0);
        p1 = __builtin_amdgcn_mfma_f32_32x32x16_bf16(b1, qr[d0], p1, 0, 0, 0); }
}
template <int VB, bool SK>
__device__ __forceinline__ void pv_tile(f32x16* o, int vb0, bf16x8 pa0, bf16x8 pa1, bf16x8 pa2, bf16x8 pa3, bool act) {
    if (SK && !act) return;
#define TRRD(dst, off) asm volatile("ds_read_b64_tr_b16 %0, %1 offset:%2" : "=&v"(dst) : "v"(vb0), "i"(off) : "memory")
#define PV_D0(d0) do { s16x4 l0, l1, l2, l3, h0, h1, h2, h3; constexpr int b_ = VB * SHM_V + v_rd_off(d0, 0, 0);     \
        TRRD(l0, b_); TRRD(h0, b_ + 2048); TRRD(l1, b_ + 4096); TRRD(h1, b_ + 6144); TRRD(l2, b_ + 8192); TRRD(h2, b_ + 10240); TRRD(l3, b_ + 12288); TRRD(h3, b_ + 14336); \
        asm volatile("s_waitcnt lgkmcnt(0)" ::: "memory"); SBAR();                 \
        o[d0] = __builtin_amdgcn_mfma_f32_32x32x16_bf16(pa0, (bf16x8){l0[0], l0[1], l0[2], l0[3], h0[0], h0[1], h0[2], h0[3]}, o[d0], 0, 0, 0);   \
        o[d0] = __builtin_amdgcn_mfma_f32_32x32x16_bf16(pa1, (bf16x8){l1[0], l1[1], l1[2], l1[3], h1[0], h1[1], h1[2], h1[3]}, o[d0], 0, 0, 0);   \
        o[d0] = __builtin_amdgcn_mfma_f32_32x32x16_bf16(pa2, (bf16x8){l2[0], l2[1], l2[2], l2[3], h2[0], h2[1], h2[2], h2[3]}, o[d0], 0, 0, 0);   \
        o[d0] = __builtin_amdgcn_mfma_f32_32x32x16_bf16(pa3, (bf16x8){l3[0], l3[1], l3[2], l3[3], h3[0], h3[1], h3[2], h3[3]}, o[d0], 0, 0, 0); } while (0)
    PV_D0(0); PV_D0(1); PV_D0(2); PV_D0(3);
#undef PV_D0
#undef TRRD
}

template <class TIn, class TOut> struct BlockRef { const TIn* Q; const TIn* K; const TIn* V; TOut* O; int P0; };
template <class TIn> struct Seam {
    bf16x8 qr[8];
    bf16x8 st_v0, st_v1, st_k0, st_k1; f32x4 sf0, sf1, sf2, sf3;
    f32x4 tq[16];
};
__device__ __forceinline__ int swa_jlo(int P0, int W) { const int lowk = P0 - W + 1; return lowk > 0 ? lowk / KVBLK : 0; }
#define ROW(p, k0, rr) ((p) + (size_t)((k0) + (rr)) * D + sc)
#define VMW() asm volatile("s_waitcnt vmcnt(0)" ::: "memory")
#define VMWN(n) asm volatile("s_waitcnt vmcnt(%0)" :: "i"(n) : "memory")
#define SLOAD_H(Kp, Vp, k0) do { S.st_v0 = load8<TIn>(ROW(Vp, k0, sr)); S.st_v1 = load8<TIn>(ROW(Vp, k0, 32 + sr));              \
                         S.st_k0 = load8<TIn>(ROW(Kp, k0, sr)); S.st_k1 = load8<TIn>(ROW(Kp, k0, 32 + sr)); } while (0)
#define SWRITE_HK(bf) do { *(bf16x8*)(K_lds + (bf) * SHM_K + kws) = S.st_k0; *(bf16x8*)(K_lds + (bf) * SHM_K + kws + 32 * 256) = S.st_k1; } while (0)
#define SWRITE_HV(bf) do { *(bf16x8*)(V_lds + (bf) * SHM_V + vst0) = S.st_v0; *(bf16x8*)(V_lds + (bf) * SHM_V + vst1) = S.st_v1; } while (0)
#define SWRITE_H(bf) do { SWRITE_HV(bf); SWRITE_HK(bf); } while (0)
#define SLOAD_F(p, k0) do { S.sf0 = *(const f32x4*)ROW(p, k0, sr); S.sf1 = *(const f32x4*)(ROW(p, k0, sr) + 4);                \
                            S.sf2 = *(const f32x4*)ROW(p, k0, 32 + sr); S.sf3 = *(const f32x4*)(ROW(p, k0, 32 + sr) + 4); } while (0)
#define SWRITE_KF(bf) do { *(bf16x8*)(K_lds + (bf) * SHM_K + kws) = pack8(S.sf0, S.sf1); *(bf16x8*)(K_lds + (bf) * SHM_K + kws + 32 * 256) = pack8(S.sf2, S.sf3); } while (0)
#define SWRITE_VF(bf) do { *(bf16x8*)(V_lds + (bf) * SHM_V + vst0) = pack8(S.sf0, S.sf1); *(bf16x8*)(V_lds + (bf) * SHM_V + vst1) = pack8(S.sf2, S.sf3); } while (0)
template <class TIn, class TOut>
__device__ __forceinline__ void causal_swa_prime(const BlockRef<TIn, TOut>& cur, int W, char* lds, Seam<TIn>& S) {
    constexpr bool F32 = same_t<TIn, float>::v;
    const int tid = mk_otid(), wid = __builtin_amdgcn_readfirstlane(tid >> 6), lane = tid & 63, r32 = lane & 31, hi = lane >> 5;
    const int sr = tid >> 4, sc = (tid & 15) * 8, kws = KSWZ(sr, sc * 2); char* K_lds = lds + 2 * SHM_V;
    const int kb0 = swa_jlo(cur.P0, W) * KVBLK;
    for (int d0 = 0; d0 < 8; ++d0) S.qr[d0] = load8<TIn>(cur.Q + (size_t)(wid * QBLK + r32) * D + d0 * 16 + hi * 8);
    if constexpr (F32) { SLOAD_F((const float*)cur.K, kb0); VMW(); SWRITE_KF(0); SBAR(); SLOAD_F((const float*)cur.V, kb0); }
    else { SLOAD_H(cur.K, cur.V, kb0); VMW(); SWRITE_HK(0); }
    __syncthreads();
}
template <class TIn, class TOut>
__device__ __forceinline__ void causal_swa_block(const BlockRef<TIn, TOut>& cur, const BlockRef<TIn, TOut>& nxt, int skv, int W, char* lds, Seam<TIn>& S) {
    constexpr bool F32 = same_t<TIn, float>::v;
    const int tid = mk_otid(), wid = __builtin_amdgcn_readfirstlane(tid >> 6), lane = tid & 63, r32 = lane & 31, hi = lane >> 5;
    const int j_lo = swa_jlo(cur.P0, W);
    int j_hi = (cur.P0 + QB - 1) / KVBLK + 1; if (j_hi > skv / KVBLK) j_hi = skv / KVBLK;
    const int NT = j_hi - j_lo;
    const int kbn = swa_jlo(nxt.P0, W) * KVBLK;
    const int qlo = cur.P0 + wid * QBLK, qm = qlo + r32 - 4 * hi;
    char* V_lds = lds; char* K_lds = lds + 2 * SHM_V;
    float* ws = (float*)(lds + 2 * SHM_V + 2 * SHM_K) + wid * 64; float* li_l = ws, * al_l = ws + 32;
    float m_reg = -1e30f, l_reg = 0; f32x16 o[4] = {};
    const int sr = tid >> 4, sc = (tid & 15) * 8, vst0 = v_st(sr, sc), vst1 = v_st(32 + sr, sc), kws = KSWZ(sr, sc * 2);
    const int vb0 = (int)(uintptr_t)V_lds + v_rd_base(lane);
    const TIn* Kh = cur.K; const TIn* Vh = cur.V;
#define RESC(a) do { if (__any((a) < 1.f)) { if (hi == 0) al_l[r32] = (a); asm volatile("s_waitcnt lgkmcnt(0)" ::: "memory");              \
                     for (int d_ = 0; d_ < 4; ++d_) for (int r = 0; r < 16; ++r) o[d_][r] *= al_l[crow(r, hi)]; } } while (0)
#define KBASE(t) ((j_lo + (t)) * KVBLK)
#define ACT(t) (KBASE(t) <= qlo + QBLK - 1 && KBASE(t) + KVBLK - 1 >= qlo - W + 1)
#define MASKT(P0_, P1_, t) do { const int kb_ = KBASE(t); if ((!SK || ACT(t)) && (kb_ + KVBLK - 1 > qlo || kb_ <= qlo + QBLK - 1 - W)) mask_tile(P0_, P1_, qm - kb_, (unsigned)W); } while (0)
    constexpr int NQL = F32 ? 16 : 8;
    constexpr bool SK = WSKIP && !F32;
#define SEAM_K0() do { VMWN(NQL); if constexpr (F32) { SWRITE_KF(0); SBAR(); SLOAD_F((const float*)nxt.V, kbn); } else { SWRITE_HK(0); } SBAR(); } while (0)
    f32x16 pA0, pA1, pB0, pB1; float mnA, mnB, alA, alB; bf16x8 pa0, pa1, pa2, pa3;
    if constexpr (F32) { VMW(); SWRITE_VF(0); SBAR(); } else { SWRITE_HV(0); SBAR(); }
    if (NT > 1) { if constexpr (F32) SLOAD_F((const float*)Kh, KBASE(1)); else SLOAD_H(Kh, Vh, KBASE(1)); }
    SBAR(); qkt<0, SK>(pA0, pA1, K_lds, r32, hi, S.qr, ACT(0));
    if constexpr (F32) { if (NT > 1) { VMW(); SWRITE_KF(1); SBAR(); SLOAD_F((const float*)Vh, KBASE(1)); } }
    MASKT(pA0, pA1, 0); partialSM(pA0, pA1, m_reg, mnA, alA);
    if (NT > 1) { VMW(); if constexpr (F32) { SWRITE_VF(1); SBAR(); if (NT > 2) SLOAD_F((const float*)Kh, KBASE(2)); } else SWRITE_H(1); }
    __syncthreads();
#define HALF_STEP(PX0, PX1, mnX, alX, PY0, PY1, alY, t, KB, VB, SB) do {                                                      \
        SBAR(); qkt<KB, SK>(PX0, PX1, K_lds, r32, hi, S.qr, ACT(t));                                             \
        finishSM(PY0, PY1, alY, l_reg, pa0, pa1, pa2, pa3); SBAR();                                                           \
        if ((t) + 1 < NT) { if constexpr (F32) { VMW(); SWRITE_KF(SB); SBAR(); SLOAD_F((const float*)Vh, KBASE((t) + 1)); }  \
                            else { SLOAD_H(Kh, Vh, KBASE((t) + 1)); } SBAR(); }                                               \
        pv_tile<VB, SK>(o, vb0, pa0, pa1, pa2, pa3, ACT((t) - 1)); MASKT(PX0, PX1, (t)); partialSM(PX0, PX1, m_reg, mnX, alX);                                        \
        __syncthreads();                                                                                                      \
        if ((t) + 1 < NT) { VMW(); if constexpr (F32) { SWRITE_VF(SB); SBAR(); if ((t) + 2 < NT) SLOAD_F((const float*)Kh, KBASE((t) + 2)); } \
                            else { SWRITE_H(SB); } }                                                                          \
        RESC(alX); __syncthreads(); } while (0)
    for (int t = 1; t + 1 < NT; t += 2) {
        HALF_STEP(pB0, pB1, mnB, alB, pA0, pA1, alA, t, 1, 0, 0);
        HALF_STEP(pA0, pA1, mnA, alA, pB0, pB1, alB, t + 1, 0, 1, 1);
    }
    const bool even = (NT & 1) == 0;
    if (even) { SBAR(); qkt<1, SK>(pB0, pB1, K_lds, r32, hi, S.qr, ACT(NT - 1)); SBAR(); }
#define QROW(e) (nxt.Q + (size_t)(wid * QBLK + r32) * D + ((e) >> 1) * 16 + hi * 8 + ((e) & 1) * 4)
    if constexpr (F32) { SLOAD_F((const float*)nxt.K, kbn); SBAR();
#pragma unroll
        for (int e = 0; e < 8; ++e) S.tq[e] = *(const f32x4*)QROW(e); }
    else { SLOAD_H(nxt.K, nxt.V, kbn); SBAR();
#pragma unroll
        for (int d0 = 0; d0 < 8; ++d0) S.qr[d0] = load8<TIn>(nxt.Q + (size_t)(wid * QBLK + r32) * D + d0 * 16 + hi * 8); }
    SBAR();
    finishSM(pA0, pA1, alA, l_reg, pa0, pa1, pa2, pa3); SBAR();
    if constexpr (F32) {
#pragma unroll
        for (int e = 8; e < 16; ++e) S.tq[e] = *(const f32x4*)QROW(e); SBAR(); }
#undef QROW
    pv_tile<0, SK>(o, vb0, pa0, pa1, pa2, pa3, ACT(even ? NT - 2 : NT - 1));
    if (even) { MASKT(pB0, pB1, NT - 1); partialSM(pB0, pB1, m_reg, mnB, alB); __syncthreads(); RESC(alB);
        finishSM(pB0, pB1, alB, l_reg, pa0, pa1, pa2, pa3); SBAR(); pv_tile<1, SK>(o, vb0, pa0, pa1, pa2, pa3, ACT(NT - 1)); }
    SBAR(); SEAM_K0();
    if (hi == 0) li_l[r32] = l_reg; asm volatile("s_waitcnt lgkmcnt(0)" ::: "memory");
    float rli[16];
#pragma unroll
    for (int r = 0; r < 16; ++r) rli[r] = __builtin_amdgcn_rcpf(li_l[crow(r, hi)]);
    TOut* Ow = cur.O + (size_t)(wid * QBLK) * D;
#pragma unroll
    for (int r = 0; r < 16; ++r) { const int orow = crow(r, hi);
#pragma unroll
        for (int d0 = 0; d0 < 4; ++d0) { const float v = o[d0][r] * rli[r];
            if constexpr (same_t<TOut, float>::v) { Ow[(size_t)orow * D + d0 * 32 + r32] = v; }
            else { const float vn = __shfl_xor(v, 1);
                   if ((r32 & 1) == 0) *(unsigned*)(Ow + (size_t)orow * D + d0 * 32 + r32) = cvtpk(v, vn); } } }
    if constexpr (F32) {
#pragma unroll
        for (int d0 = 0; d0 < 8; ++d0) S.qr[d0] = pack8(S.tq[2 * d0], S.tq[2 * d0 + 1]); }
    __syncthreads();
#undef RESC
#undef KBASE
#undef ACT
#undef MASKT
#undef SEAM_K0
#undef HALF_STEP
}
#undef ROW
#undef VMW
#undef VMWN
#undef SLOAD_H
#undef SWRITE_HK
#undef SWRITE_HV
#undef SWRITE_H
#undef SLOAD_F
#undef SWRITE_KF
#undef SWRITE_VF
}

namespace mk {
using pg8::bf16_t; using pg8::f32x4; using pg8::f32x2; using pg8::u32x4; using pg8::u32x2; using pg8::bf16x8; using pg8::cvt_pk_bf16; using pg8::bf_lo; using pg8::bf_hi;
#define GAS __attribute__((address_space(1)))
#define LAS __attribute__((address_space(3)))
typedef GAS unsigned gu32;
#define RLX_AGENT __ATOMIC_RELAXED, __HIP_MEMORY_SCOPE_AGENT
#define LDS_WAIT() asm volatile("s_waitcnt lgkmcnt(0)" ::: "memory")
#define VM_WAIT() asm volatile("s_waitcnt vmcnt(0)" ::: "memory")

constexpr int NWAVES = 8, NTHR = 512;
constexpr int D = 2048, NB = 4, SEQ = 2048, T = NB * SEQ, MEM = 256, TM = NB * MEM;
constexpr int DIN = 4096, DSSM = 1024, NG = 64, NP = 64, NH = 16, NE = 64, DFF = 512;
constexpr float EPS = 1e-6f;

constexpr size_t MiB = 1u << 20;
constexpr size_t WS_CTL = 0, CTL_ZERO_BYTES = 1 * MiB;
constexpr size_t WS_TAB = 1 * MiB;
constexpr size_t WS_W1T = 2 * MiB;
constexpr size_t WS_WGLU = 18 * MiB;
constexpr size_t WS_WOUT = 20 * MiB;
constexpr size_t WS_WXQ = 28 * MiB, WS_WXK = 36 * MiB, WS_WXV = 44 * MiB, WS_WXO = 52 * MiB;
constexpr size_t WS_SSMT = 60 * MiB;
constexpr size_t WS_XN = 76 * MiB;
constexpr size_t WS_MN = 108 * MiB;
constexpr size_t WS_QH = 112 * MiB, WS_KH = 128 * MiB, WS_VH = 144 * MiB, WS_U = 160 * MiB;
constexpr size_t WS_OH = 176 * MiB;
constexpr size_t WS_CAT = 208 * MiB;
constexpr size_t WS_YG = 240 * MiB;
constexpr size_t WS_H1 = 256 * MiB;
constexpr size_t WS_KX = 320 * MiB, WS_VXT = 324 * MiB;
constexpr size_t WS_SSQ = 328 * MiB;
constexpr size_t WS_QX = 336 * MiB;
constexpr size_t WS_PX = 368 * MiB;
constexpr size_t WS_OX = 384 * MiB;
constexpr size_t WS_MOE = 416 * MiB;
constexpr size_t WS_XS = 424 * MiB;
constexpr size_t WS_ACT = 492 * MiB;
constexpr size_t WS_YS = 112 * MiB;
constexpr size_t WS_WE1 = 512 * MiB;
constexpr size_t WS_WE2 = 768 * MiB;
constexpr size_t WS_END = 896 * MiB;
constexpr size_t SQ_S = 0;
constexpr size_t SQ_H1 = 16 * (size_t)T;
constexpr size_t SQ_QX = 48 * (size_t)T;
constexpr size_t SQ_L = 80 * (size_t)T;
constexpr size_t SQ_H2 = 96 * (size_t)T;
constexpr size_t SQ_KX = 128 * (size_t)T;
constexpr int CW_BAR = 4096;
constexpr int CW_CNT = 16384;

constexpr int RING_OFF = 0, RING_BYTES = 131072;
constexpr int EPI_TBL = 131072;
constexpr int RTAB_OFF = 157696;
constexpr int MISC_OFF = 158720;
constexpr int LDS_BYTES = 163840;

__device__ __forceinline__ unsigned f2bf(float f) { unsigned u = __builtin_bit_cast(unsigned, f); return (u + 0x7fffu + ((u >> 16) & 1u)) >> 16; }
__device__ __forceinline__ unsigned pk2(float lo, float hi) { return f2bf(lo) | (f2bf(hi) << 16); }
__device__ __forceinline__ float wave_sum(float v) {
#pragma unroll
    for (int o = 1; o < 64; o <<= 1) v += __shfl_xor(v, o);
    return v;
}

#define XB_TMO      128
#define XB_XCNT(j)  (256  + 64 * (j))
#define XB_XSUB(j)  (1280 + 64 * (j))
#define XB_XGEN(j)  (2304 + 64 * (j))
#define XB_TOP      3328
#define XB_TOPGEN   3392
#define XCD_BAR_WORDS 3456
#define XB_SPIN_CAP (1u << 20)
__device__ __forceinline__ unsigned xb_ld(unsigned* p)              { return __hip_atomic_load(p, __ATOMIC_RELAXED, __HIP_MEMORY_SCOPE_AGENT); }
__device__ __forceinline__ unsigned xb_add(unsigned* p, unsigned v) { return __hip_atomic_fetch_add(p, v, __ATOMIC_RELAXED, __HIP_MEMORY_SCOPE_AGENT); }
__device__ __forceinline__ unsigned xb_xcc_id() { return (unsigned)__builtin_amdgcn_s_getreg((3 << 11) | 20) & 0xFu; }
#define XB_SPIN(cond, bar) do { unsigned _sp = 0; while (cond) { __builtin_amdgcn_s_sleep(1); \
    if ((++_sp & 255u) == 0u) { if (xb_ld(&(bar)[XB_TMO])) break; if (_sp > XB_SPIN_CAP) { atomicAdd(&(bar)[XB_TMO], 1u); break; } } } } while (0)
struct XcdBarrier { unsigned* bar; unsigned x; volatile LAS unsigned* st; };
__device__ __forceinline__ XcdBarrier xcd_barrier_post(unsigned* bar, volatile LAS unsigned* st) {
    XcdBarrier b; b.bar = bar; b.x = xb_xcc_id(); b.st = st;
    if (threadIdx.x == 0) (void)xb_add(&bar[XB_XCNT(b.x)], 1u);
    return b;
}
__device__ __forceinline__ void xcd_barrier_complete(unsigned* bar, unsigned x, unsigned& nloc, unsigned& nx) {
    const unsigned G = gridDim.x * gridDim.y * gridDim.z;
    unsigned sum, cnt, mine, sp = 0u;
    for (;;) {
        sum = 0u; cnt = 0u; mine = 0u;
#pragma unroll
        for (unsigned j = 0; j < 16; ++j) { const unsigned c = xb_ld(&bar[XB_XCNT(j)]); sum += c; cnt += (c > 0u) ? 1u : 0u; mine = (j == x) ? c : mine; }
        if (sum == G) break;
        __builtin_amdgcn_s_sleep(1);
        if ((++sp & 255u) == 0u) { if (xb_ld(&bar[XB_TMO])) break; if (sp > XB_SPIN_CAP) { atomicAdd(&bar[XB_TMO], 1u); break; } }
    }
    nloc = mine > 0u ? mine : 1u; nx = cnt > 0u ? cnt : 1u;
}
__device__ __forceinline__ void xcd_barrier(const XcdBarrier& b) {
    asm volatile("s_waitcnt vmcnt(0)" ::: "memory");
    __syncthreads();
    if (threadIdx.x == 0) {
        unsigned* bar = b.bar;
        __builtin_amdgcn_s_waitcnt(0);
        unsigned nloc = b.st[0], nx = b.st[1];
        if (nloc == 0u) { xcd_barrier_complete(bar, b.x, nloc, nx); b.st[0] = nloc; b.st[1] = nx; }
        const unsigned old = xb_add(&bar[XB_XSUB(b.x)], 1u);
        const unsigned gen = old / nloc;
        if (old + 1u == (gen + 1u) * nloc) {
            __builtin_amdgcn_fence(__ATOMIC_RELEASE, "agent");
            asm volatile("s_waitcnt vmcnt(0)" ::: "memory");
            const unsigned og = xb_add(&bar[XB_TOP], 1u);
            const unsigned tg = og / nx;
            if (og + 1u == (tg + 1u) * nx) xb_add(&bar[XB_TOPGEN], 1u);
            else XB_SPIN(xb_ld(&bar[XB_TOPGEN]) == tg, bar);
            __builtin_amdgcn_fence(__ATOMIC_ACQUIRE, "agent");
            xb_add(&bar[XB_XGEN(b.x)], 1u);
            asm volatile("s_waitcnt vmcnt(0)" ::: "memory");
        } else {
            XB_SPIN(xb_ld(&bar[XB_XGEN(b.x)]) == gen, bar);
            __builtin_amdgcn_fence(__ATOMIC_ACQUIRE, "agent");
            asm volatile("s_waitcnt vmcnt(0)" ::: "memory");
        }
    }
    __syncthreads();
}

struct Args { const float* in[38]; float* out; unsigned char* ws; int ph_lo, ph_hi; };
typedef const __attribute__((address_space(4))) char* kptr_t;
struct AV {
    kptr_t kp;
    __device__ __forceinline__ kptr_t base() const { kptr_t p = kp; asm volatile("" : "+s"(p)); return p; }
    __device__ __forceinline__ const float* in(int i) const { return *(const float* const __attribute__((address_space(4)))*)(base() + 8 * i); }
    __device__ __forceinline__ float* out() const { return *(float* const __attribute__((address_space(4)))*)(base() + 304); }
    __device__ __forceinline__ unsigned char* ws() const { return *(unsigned char* const __attribute__((address_space(4)))*)(base() + 312); }
    __device__ __forceinline__ int ph_lo() const { return *(const int __attribute__((address_space(4)))*)(base() + 320); }
    __device__ __forceinline__ int ph_hi() const { return *(const int __attribute__((address_space(4)))*)(base() + 324); }
};
static_assert(sizeof(Args) == 328 && offsetof(Args, out) == 304 && offsetof(Args, ws) == 312 && offsetof(Args, ph_lo) == 320, "Args layout vs AV offsets");

struct Frame {
    LAS unsigned char* lds;
    volatile LAS unsigned* MISC;
    gu32* ctl;
    int tid, lane, wave, vcu, G;
    unsigned char* ws;
};

__device__ __forceinline__ void xpose_item(const float* W, int ldw, int N, bf16_t* WT, int ldt, const float* kscale, int item, int lane) {
    const int nblk = N / 64, kb = item / nblk, nb = item % nblk, g = lane >> 4, c4 = lane & 15, k0 = 32 * kb + 8 * g, n0 = 64 * nb + 4 * c4;
    f32x4 v[8];
#pragma unroll
    for (int j = 0; j < 8; ++j) v[j] = __builtin_nontemporal_load((const f32x4*)(W + (size_t)(k0 + j) * ldw + n0));
    if (kscale) {
#pragma unroll
        for (int j = 0; j < 8; ++j) v[j] = v[j] * kscale[k0 + j]; }
#pragma unroll
    for (int c = 0; c < 4; ++c) { u32x4 o; o.x = cvt_pk_bf16(v[0][c], v[1][c]); o.y = cvt_pk_bf16(v[2][c], v[3][c]); o.z = cvt_pk_bf16(v[4][c], v[5][c]); o.w = cvt_pk_bf16(v[6][c], v[7][c]);
        *(u32x4*)(WT + (size_t)(n0 + c) * ldt + k0) = o; }
}
__device__ __forceinline__ void rms_row_to_bf16(const float* xrow, const float* w, bf16_t* orow, int lane) {
    const GAS f32x4* xr = (const GAS f32x4*)xrow + lane; const GAS f32x4* wr = (const GAS f32x4*)w + lane;
    f32x4 v[8]; float s = 0.f;
#pragma unroll
    for (int j = 0; j < 8; ++j) { v[j] = __builtin_nontemporal_load(xr + 64 * j); s += (v[j].x * v[j].x + v[j].y * v[j].y) + (v[j].z * v[j].z + v[j].w * v[j].w); }
    const float r = 1.0f / sqrtf(wave_sum(s) * (1.f / D) + EPS);
    GAS u32x2* o8 = (GAS u32x2*)orow + lane;
#pragma unroll
    for (int j = 0; j < 8; ++j) { const f32x4 ww = wr[64 * j]; u32x2 o; o.x = pk2(v[j].x * r * ww.x, v[j].y * r * ww.y); o.y = pk2(v[j].z * r * ww.z, v[j].w * r * ww.w); o8[64 * j] = o; }
}
__device__ __forceinline__ void rms_row2_to_bf16(const float* xa, const float* xb, const float* w, bf16_t* oa, bf16_t* ob, int lane) {
    const GAS f32x4* pa = (const GAS f32x4*)xa + lane; const GAS f32x4* pb = (const GAS f32x4*)xb + lane; const GAS f32x4* wr = (const GAS f32x4*)w + lane;
    f32x4 va[8], vb[8]; float sa = 0.f, sb = 0.f;
#pragma unroll
    for (int j = 0; j < 8; ++j) { va[j] = __builtin_nontemporal_load(pa + 64 * j); vb[j] = __builtin_nontemporal_load(pb + 64 * j); }
#pragma unroll
    for (int j = 0; j < 8; ++j) { sa += (va[j].x * va[j].x + va[j].y * va[j].y) + (va[j].z * va[j].z + va[j].w * va[j].w); sb += (vb[j].x * vb[j].x + vb[j].y * vb[j].y) + (vb[j].z * vb[j].z + vb[j].w * vb[j].w); }
    const float ra = 1.0f / sqrtf(wave_sum(sa) * (1.f / D) + EPS), rb = 1.0f / sqrtf(wave_sum(sb) * (1.f / D) + EPS);
    GAS u32x2* qa = (GAS u32x2*)oa + lane; GAS u32x2* qb = (GAS u32x2*)ob + lane;
#pragma unroll
    for (int j = 0; j < 8; ++j) { const f32x4 ww = wr[64 * j]; u32x2 o;
        o.x = pk2(va[j].x * ra * ww.x, va[j].y * ra * ww.y); o.y = pk2(va[j].z * ra * ww.z, va[j].w * ra * ww.w); qa[64 * j] = o;
        o.x = pk2(vb[j].x * rb * ww.x, vb[j].y * rb * ww.y); o.y = pk2(vb[j].z * rb * ww.z, vb[j].w * rb * ww.w); qb[64 * j] = o; }
}

constexpr size_t TAB_RWH = 65536, TAB_RWL = 65536 + 80 * 2048 * 2;
struct TileOrder {
    int nM, nN, nwg, G, c;
    __device__ __forceinline__ void init(int nM_, int nN_, int G_, int c_) { nM = nM_; nN = nN_; nwg = nM * nN; G = G_; c = c_; }
    __device__ __forceinline__ bool map(int i, int& pm, int& pn) const {
        const long L = (long)i * G + c; if (L >= nwg) return false;
        int wgid = (int)L; { const int q = nwg / 8, r = nwg % 8, xcd = wgid % 8, off = wgid / 8; wgid = (xcd < r ? xcd * (q + 1) : r * (q + 1) + (xcd - r) * q) + off; }
        const int nig = 8 * nN, gid = wgid / nig, fm = gid * 8, gsz = (nM - fm) < 8 ? (nM - fm) : 8;
        pm = fm + ((wgid % nig) % gsz); pn = (wgid % nig) / gsz; return true;
    }
};
struct PlainSched {
    TileOrder o; const char* A; const char* B; size_t tstepA, tstepB;
    __device__ __forceinline__ void init(const bf16_t* A_, int lda, const bf16_t* B_, int ldb, int M, int N, int G, int c) {
        o.init(M / 256, N / 256, G, c); A = (const char*)A_; B = (const char*)B_; tstepA = (size_t)256 * lda * 2; tstepB = (size_t)256 * ldb * 2; }
    __device__ __forceinline__ bool next(int i, pg8::Unit& u) const {
        int pm, pn; if (!o.map(i, pm, pn)) return false;
        u.pm = pm; u.pn = pn; u.aux0 = 0; u.aux1 = 0; u.A = A + (size_t)pm * tstepA; u.B = B + (size_t)pn * tstepB; return true; }
};
#define EPI_BAR() do { asm volatile("s_waitcnt lgkmcnt(0)" ::: "memory"); __builtin_amdgcn_s_barrier(); asm volatile("" ::: "memory"); } while (0)

struct EpiG1 {
    static constexpr bool PERM = true; static constexpr int MIDT = -1;
    bf16_t *Qh, *Kh, *Vh, *U; const float *qw, *kw; LAS float* tbl;
    __device__ __forceinline__ void mid(f32x4 (&)[2][2][4][2], const pg8::Unit&, int, int, int, int) const {}
    __device__ __forceinline__ void prep(const pg8::Unit&) const {}
    __device__ __forceinline__ void operator()(f32x4 (&acc)[2][2][4][2], const pg8::Unit& u, int wr, int wc, int fr, int fq) const {
        const int pn = u.pn, pm = u.pm, b = pm >> 3, s0 = (pm & 7) * 256 + wr * 64 + fr;
        if (pn < 8) {
#pragma unroll
            for (int ai = 0; ai < 2; ++ai)
#pragma unroll
                for (int m = 0; m < 4; ++m)
#pragma unroll
                    for (int bj = 0; bj < 2; ++bj) { const f32x4 x0 = acc[ai][bj][m][0], x1 = acc[ai][bj][m][1];
                        float s = (x0[0] * x0[0] + x0[1] * x0[1]) + (x0[2] * x0[2] + x0[3] * x0[3]) + (x1[0] * x1[0] + x1[1] * x1[1]) + (x1[2] * x1[2] + x1[3] * x1[3]);
                        s += __shfl_xor(s, 16); s += __shfl_xor(s, 32);
                        if (fq == 0) tbl[((ai * 128 + wr * 64 + m * 16 + fr) * 2 + bj) * 4 + wc] = s; }
            EPI_BAR();
            const float* w = (pn < 4 ? qw : kw) + wc * 32 + fq * 8; const f32x4 w0 = *(const f32x4*)w, w1 = *(const f32x4*)(w + 4);
            bf16_t* base = (pn < 4 ? Qh : Kh);
#pragma unroll
            for (int ai = 0; ai < 2; ++ai)
#pragma unroll
                for (int m = 0; m < 4; ++m)
#pragma unroll
                    for (int bj = 0; bj < 2; ++bj) { const f32x4 p = *(const LAS f32x4*)&tbl[((ai * 128 + wr * 64 + m * 16 + fr) * 2 + bj) * 4];
                        const float r = rsqrtf(((p[0] + p[1]) + (p[2] + p[3])) * (1.f / 128.f) + EPS);
                        const f32x4 v0 = acc[ai][bj][m][0] * r * w0, v1 = acc[ai][bj][m][1] * r * w1;
                        u32x4 o; o.x = cvt_pk_bf16(v0[0], v0[1]); o.y = cvt_pk_bf16(v0[2], v0[3]); o.z = cvt_pk_bf16(v1[0], v1[1]); o.w = cvt_pk_bf16(v1[2], v1[3]);
                        *(u32x4*)(base + ((size_t)((b * 8 + (pn & 3) * 2 + bj) * SEQ + s0 + ai * 128 + m * 16)) * 128 + wc * 32 + fq * 8) = o; }
        } else {
#pragma unroll
            for (int ai = 0; ai < 2; ++ai)
#pragma unroll
                for (int m = 0; m < 4; ++m)
#pragma unroll
                    for (int bj = 0; bj < 2; ++bj) { const f32x4 v0 = acc[ai][bj][m][0], v1 = acc[ai][bj][m][1];
                        u32x4 o; o.x = cvt_pk_bf16(v0[0], v0[1]); o.y = cvt_pk_bf16(v0[2], v0[3]); o.z = cvt_pk_bf16(v1[0], v1[1]); o.w = cvt_pk_bf16(v1[2], v1[3]);
                        bf16_t* dst = (pn < 12) ? Vh + ((size_t)((b * 8 + (pn & 3) * 2 + bj) * SEQ + s0 + ai * 128 + m * 16)) * 128 + wc * 32 + fq * 8
                                                : U + (size_t)(pm * 256 + wr * 64 + fr + ai * 128 + m * 16) * DSSM + (pn - 12) * 256 + bj * 128 + wc * 32 + fq * 8;
                        *(u32x4*)dst = o; }
        }
    }
};


constexpr size_t SSMT_G = (size_t)256 * 384 + 128 * 256;
__device__ __forceinline__ void ssm_tables(Frame& F, const AV& a, int g) {
    LAS f32x2* lamp = (LAS f32x2*)(F.lds);
    LAS f32x2* Bb = lamp + 17 * 64;
    LAS f32x2* Cc = Bb + 64 * 16;
    LAS float* Kt = (LAS float*)(Cc + 16 * 64);
    const float *lre = a.in(11), *lim = a.in(12), *logdt = a.in(13), *bre = a.in(14), *bim = a.in(15), *cre = a.in(16), *cim = a.in(17), *dsk = a.in(18);
    const int tid = F.tid;
    if (tid < 64) { const int p = tid;
        const double lr = fmin((double)lre[g * 64 + p], -1e-4), li = (double)lim[g * 64 + p], dt = exp((double)logdt[g]);
        const double mag = exp(lr * dt), br = mag * cos(li * dt), bi = mag * sin(li * dt), den = lr * lr + li * li;
        const double cr = ((br - 1.0) * lr + bi * li) / den, ci = (bi * lr - (br - 1.0) * li) / den;
        double pr = 1.0, pi = 0.0;
        for (int n = 0; n <= 16; ++n) { lamp[n * 64 + p] = (f32x2){(float)pr, (float)pi}; const double nr = pr * br - pi * bi, ni = pr * bi + pi * br; pr = nr; pi = ni; }
        ((f32x2*)(F.ws + WS_TAB))[64 + g * 64 + p] = lamp[16 * 64 + p];
        for (int h = 0; h < 16; ++h) { const double r = bre[(g * 64 + p) * 16 + h], i = bim[(g * 64 + p) * 16 + h]; Bb[p * 16 + h] = (f32x2){(float)(cr * r - ci * i), (float)(cr * i + ci * r)}; }
    }
    for (int e = tid; e < 1024; e += NTHR) { const int ho = e >> 6, p = e & 63; Cc[ho * 64 + p] = (f32x2){cre[(g * 16 + ho) * 64 + p], cim[(g * 16 + ho) * 64 + p]}; }
    __syncthreads();
    if (tid < 256) { const int tau = tid >> 4, ho = tid & 15; float s[16];
#pragma unroll
        for (int hi = 0; hi < 16; ++hi) s[hi] = 0.f;
        for (int p = 0; p < 64; ++p) { const f32x2 c = Cc[ho * 64 + p], l = lamp[tau * 64 + p]; const float clr = c.x * l.x - c.y * l.y, cli = c.x * l.y + c.y * l.x;
            const LAS f32x4* bp = (const LAS f32x4*)(Bb + p * 16);
#pragma unroll
            for (int h2 = 0; h2 < 8; ++h2) { const f32x4 b2 = bp[h2]; s[2 * h2] += clr * b2[0] - cli * b2[1]; s[2 * h2 + 1] += clr * b2[2] - cli * b2[3]; } }
#pragma unroll
        for (int hi = 0; hi < 16; ++hi) Kt[(tau * 16 + ho) * 16 + hi] = s[hi] + ((tau == 0 && hi == ho) ? dsk[g * 16 + ho] : 0.f);
    }
    __syncthreads();
    bf16_t* TY = (bf16_t*)(F.ws + WS_SSMT) + (size_t)g * SSMT_G; bf16_t* WSg = TY + 256 * 384;
    for (int e = tid; e < 256 * 192; e += NTHR) { const int m = e / 192, k0 = (e % 192) * 2, i = m >> 4, ho = m & 15; float v[2];
#pragma unroll
        for (int q = 0; q < 2; ++q) { const int k = k0 + q;
            if (k < 256) { const int j = k >> 4, hi = k & 15; v[q] = (j <= i) ? Kt[((i - j) * 16 + ho) * 16 + hi] : 0.f; }
            else { const int kk = k - 256, ri = kk >> 6, p = kk & 63; const f32x2 c = Cc[ho * 64 + p], l = lamp[(i + 1) * 64 + p];
                v[q] = ri == 0 ? (c.x * l.x - c.y * l.y) : -(c.x * l.y + c.y * l.x); } }
        *(unsigned*)(TY + (size_t)m * 384 + k0) = pk2(v[0], v[1]); }
    for (int e = tid; e < 128 * 128; e += NTHR) { const int n = e >> 7, k0 = (e & 127) * 2, ri = n >> 6, p = n & 63, j = k0 >> 4, hi = k0 & 15; float v[2];
        const f32x2 l = lamp[(15 - j) * 64 + p];
#pragma unroll
        for (int q = 0; q < 2; ++q) { const f32x2 bb = Bb[p * 16 + hi + q]; v[q] = ri == 0 ? (l.x * bb.x - l.y * bb.y) : (l.x * bb.y + l.y * bb.x); }
        *(unsigned*)(WSg + (size_t)n * 256 + k0) = pk2(v[0], v[1]); }
    __syncthreads();
}
__device__ __forceinline__ float gelu_tanh(float y) { const float z2 = -2.302208198f * (y + 0.044715f * y * y * y);     return y * __builtin_amdgcn_rcpf(1.f + __builtin_amdgcn_exp2f(z2)); }
__device__ __forceinline__ float sigmoid_fast(float z) { return __builtin_amdgcn_rcpf(1.f + __builtin_amdgcn_exp2f(-1.4426950408889634f * z)); }
__device__ __forceinline__ void ssm_unit(Frame& F, int b, int g) {
    LAS unsigned char* Ul = F.lds; LAS unsigned char* Sl = F.lds + 67584;
    const bf16_t* U = (const bf16_t*)(F.ws + WS_U); bf16_t* yg = (bf16_t*)(F.ws + WS_YG);
    const int tid = F.tid, lane = F.lane, wave = F.wave, fr = lane & 15, fq = lane >> 4;
    for (int q = tid; q < 4096; q += NTHR) { const int tok = q >> 1, half = q & 1;
        const u32x4 v = *(const u32x4*)(U + (size_t)(b * SEQ + tok) * DSSM + g * 16 + half * 8);
        *(LAS u32x4*)(Ul + (tok >> 4) * 528 + ((tok & 15) * 16 + half * 8) * 2) = v; }
    __syncthreads();
    const bf16_t* TY = (const bf16_t*)(F.ws + WS_SSMT) + (size_t)g * SSMT_G; const bf16_t* WSg = TY + 256 * 384;
    {
        f32x4 acc[8]; bf16x8 bfr[8];
#pragma unroll
        for (int ks = 0; ks < 8; ++ks) bfr[ks] = *(const bf16x8*)(WSg + (size_t)(16 * wave + fr) * 256 + 32 * ks + 8 * fq);
#pragma unroll
        for (int rb = 0; rb < 8; ++rb) acc[rb] = (f32x4){0.f, 0.f, 0.f, 0.f};
#pragma unroll
        for (int ks = 0; ks < 8; ++ks) {
#pragma unroll
            for (int rb = 0; rb < 8; ++rb) { const bf16x8 afr = *(const LAS bf16x8*)(Ul + (16 * rb + fr) * 528 + (32 * ks + 8 * fq) * 2);
                acc[rb] = __builtin_amdgcn_mfma_f32_16x16x32_bf16(afr, bfr[ks], acc[rb], 0, 0, 0); } }
#pragma unroll
        for (int rb = 0; rb < 8; ++rb)
#pragma unroll
            for (int r = 0; r < 4; ++r) *(LAS float*)(Sl + (16 * rb + 4 * fq + r) * 528 + (16 * wave + fr) * 4) = acc[rb][r];
    }
    __syncthreads();
    if (wave == 0) { const int p = lane; const f32x2 l = ((const f32x2*)(F.ws + WS_TAB))[64 + g * 64 + p]; float xr = 0.f, xi = 0.f;
#pragma unroll 1
        for (int cb = 0; cb < 128; cb += 16) { float sr[16], si[16];
#pragma unroll
            for (int j = 0; j < 16; ++j) { const LAS float* row = (const LAS float*)(Sl + (cb + j) * 528); sr[j] = row[p]; si[j] = row[64 + p]; }
#pragma unroll
            for (int j = 0; j < 16; ++j) { LAS float* row = (LAS float*)(Sl + (cb + j) * 528); row[p] = xr; row[64 + p] = xi;
                const float nr = l.x * xr - l.y * xi + sr[j], ni = l.x * xi + l.y * xr + si[j]; xr = nr; xi = ni; } } }
    __syncthreads();
#pragma unroll 1
    for (int cbi = 0; cbi < 2; ++cbi) { const int cb = 2 * wave + cbi;
        f32x4 acc[8]; bf16x8 bfr[12];
#pragma unroll
        for (int ks = 0; ks < 12; ++ks) bfr[ks] = *(const bf16x8*)(TY + (size_t)(16 * cb + fr) * 384 + 32 * ks + 8 * fq);
#pragma unroll
        for (int rb = 0; rb < 8; ++rb) acc[rb] = (f32x4){0.f, 0.f, 0.f, 0.f};
#pragma unroll
        for (int ks = 0; ks < 8; ++ks) {
#pragma unroll
            for (int rb = 0; rb < 8; ++rb) { const bf16x8 afr = *(const LAS bf16x8*)(Ul + (16 * rb + fr) * 528 + (32 * ks + 8 * fq) * 2);
                acc[rb] = __builtin_amdgcn_mfma_f32_16x16x32_bf16(afr, bfr[ks], acc[rb], 0, 0, 0); } }
#pragma unroll
        for (int ks = 0; ks < 4; ++ks) {
#pragma unroll
            for (int rb = 0; rb < 8; ++rb) { const LAS f32x4* xp = (const LAS f32x4*)(Sl + (16 * rb + fr) * 528 + (32 * ks + 8 * fq) * 4); const f32x4 x0 = xp[0], x1 = xp[1];
                u32x4 w; w.x = cvt_pk_bf16(x0[0], x0[1]); w.y = cvt_pk_bf16(x0[2], x0[3]); w.z = cvt_pk_bf16(x1[0], x1[1]); w.w = cvt_pk_bf16(x1[2], x1[3]);
                acc[rb] = __builtin_amdgcn_mfma_f32_16x16x32_bf16(__builtin_bit_cast(bf16x8, w), bfr[8 + ks], acc[rb], 0, 0, 0); } }
#pragma unroll
        for (int rb = 0; rb < 8; ++rb)
#pragma unroll
            for (int r = 0; r < 4; ++r) { const int c = 16 * rb + 4 * fq + r; const float y = gelu_tanh(acc[rb][r]);
                yg[(size_t)(b * SEQ + c * 16 + cb) * DSSM + g * 16 + fr] = (bf16_t)f2bf(y); }
    }
    __syncthreads();
}


__device__ __forceinline__ u32x4 pack8(const f32x4 v0, const f32x4 v1) { u32x4 o; o.x = cvt_pk_bf16(v0[0], v0[1]); o.y = cvt_pk_bf16(v0[2], v0[3]); o.z = cvt_pk_bf16(v1[0], v1[1]); o.w = cvt_pk_bf16(v1[2], v1[3]); return o; }
__device__ __forceinline__ float ssq8(const f32x4 a, const f32x4 b) { return ((a[0] * a[0] + a[1] * a[1]) + (a[2] * a[2] + a[3] * a[3])) + ((b[0] * b[0] + b[1] * b[1]) + (b[2] * b[2] + b[3] * b[3])); }
__device__ __forceinline__ float red_fq(float s) { s += __shfl_xor(s, 16); s += __shfl_xor(s, 32); return s; }

template <int NPART, bool RSQ> __device__ __forceinline__ void prep_rtab(const float* sq, size_t nrows, int p0, int rowbase, float inv_w, LAS float* rtab, LAS float* tmp) {
    const int tid = mk_otid();
    const int row = tid & 255, half = tid >> 8; float s = 0.f;
#pragma unroll
    for (int i = 0; i < NPART / 2; ++i) s += sq[(size_t)(p0 + half * (NPART / 2) + i) * nrows + rowbase + row];
    tmp[half * 256 + row] = s; EPI_BAR();
    if (tid < 256) { s = tmp[row] + tmp[256 + row]; rtab[row] = RSQ ? rsqrtf(s * inv_w + EPS) : 1.f / s; }
    EPI_BAR();
}
struct EpiGlu {
    static constexpr bool PERM = true; static constexpr int MIDT = -1;
    const bf16_t* yg; const float* bias; bf16_t* cat; float* sq;
    __device__ __forceinline__ void mid(f32x4 (&)[2][2][4][2], const pg8::Unit&, int, int, int, int) const {}
    __device__ __forceinline__ void prep(const pg8::Unit&) const {}
    __device__ __forceinline__ void operator()(f32x4 (&acc)[2][2][4][2], const pg8::Unit& u, int wr, int wc, int fr, int fq) const {
        const int row0 = u.pm * 256 + wr * 64 + fr, col0 = u.pn * 256 + wc * 32 + fq * 8;
        f32x4 bv[2][2];
#pragma unroll
        for (int bj = 0; bj < 2; ++bj) { bv[bj][0] = *(const f32x4*)(bias + col0 + bj * 128); bv[bj][1] = *(const f32x4*)(bias + col0 + bj * 128 + 4); }
#pragma unroll
        for (int ai = 0; ai < 2; ++ai) {
            u32x4 ypre[4][2];
#pragma unroll
            for (int m = 0; m < 4; ++m)
#pragma unroll
                for (int bj = 0; bj < 2; ++bj) ypre[m][bj] = *(const u32x4*)(yg + (size_t)(row0 + ai * 128 + m * 16) * DSSM + col0 + bj * 128);
            asm volatile("" ::: "memory");
#pragma unroll
            for (int m = 0; m < 4; ++m) { const int row = row0 + ai * 128 + m * 16; float s = 0.f;
#pragma unroll
                for (int bj = 0; bj < 2; ++bj) { const u32x4 yw = ypre[m][bj];
                    const f32x4 y0 = {bf_lo(yw.x), bf_hi(yw.x), bf_lo(yw.y), bf_hi(yw.y)}, y1 = {bf_lo(yw.z), bf_hi(yw.z), bf_lo(yw.w), bf_hi(yw.w)};
                    const f32x4 z0 = acc[ai][bj][m][0] + bv[bj][0], z1 = acc[ai][bj][m][1] + bv[bj][1]; f32x4 o0, o1;
#pragma unroll
                    for (int q = 0; q < 4; ++q) { o0[q] = y0[q] * sigmoid_fast(z0[q]); o1[q] = y1[q] * sigmoid_fast(z1[q]); }
                    *(u32x4*)(cat + (size_t)row * D + col0 + bj * 128) = pack8(o0, o1); s += ssq8(o0, o1); }
                s = red_fq(s); if (fq == 0) sq[(size_t)(u.pn * 4 + wc) * T + row] = s; }
            asm volatile("" ::: "memory");
        }
    }
};
struct EpiOut {
    static constexpr bool PERM = true; static constexpr int MIDT = 16;
    const float* x; float* h1; bf16_t* a2; const float* sqs; float* sqh; LAS float* rtab; LAS float* tmp;
    __device__ __forceinline__ void prep(const pg8::Unit& u) const { prep_rtab<16, true>(sqs, T, 0, u.pm * 256, 1.f / 1024.f, rtab, tmp); }
    __device__ __forceinline__ void mid(f32x4 (&acc)[2][2][4][2], const pg8::Unit& u, int wr, int wc, int fr, int fq) const {
        {
            const int t_ = mk_otid(); LAS unsigned* dump = (LAS unsigned*)((LAS unsigned char*)tmp + (139264 - EPI_TBL)) + (t_ >> 6) * 64;
#pragma unroll
            for (int j = 0; j < 4; ++j) { const int line = t_ + 512 * j;
                __builtin_amdgcn_global_load_lds((const unsigned*)(x + (size_t)(u.pm * 256 + (line >> 3)) * D + u.pn * 256 + (line & 7) * 32), dump, 4, 0, 0); } }
#pragma unroll
        for (int ai = 0; ai < 2; ++ai)
#pragma unroll
            for (int m = 0; m < 4; ++m) { const float r = rtab[ai * 128 + wr * 64 + m * 16 + fr];
#pragma unroll
                for (int bj = 0; bj < 2; ++bj) { acc[ai][bj][m][0] *= r; acc[ai][bj][m][1] *= r; } }
    }
    __device__ __forceinline__ void operator()(f32x4 (&acc)[2][2][4][2], const pg8::Unit& u, int wr, int wc, int fr, int fq) const {
        const int row0 = u.pm * 256 + wr * 64 + fr, col0 = u.pn * 256 + wc * 32 + fq * 8;
#pragma unroll
        for (int ai = 0; ai < 2; ++ai) {
            f32x4 pre[4][2][2];
#pragma unroll
            for (int m = 0; m < 4; ++m)
#pragma unroll
                for (int bj = 0; bj < 2; ++bj) { const size_t off = (size_t)(row0 + ai * 128 + m * 16) * D + col0 + bj * 128; pre[m][bj][0] = __builtin_nontemporal_load((const f32x4*)(x + off)); pre[m][bj][1] = __builtin_nontemporal_load((const f32x4*)(x + off + 4)); }
            asm volatile("" ::: "memory");
#pragma unroll
            for (int m = 0; m < 4; ++m) { const int row = row0 + ai * 128 + m * 16; float s = 0.f;
#pragma unroll
                for (int bj = 0; bj < 2; ++bj) { const size_t off = (size_t)row * D + col0 + bj * 128;
                    const f32x4 v0 = acc[ai][bj][m][0] + pre[m][bj][0], v1 = acc[ai][bj][m][1] + pre[m][bj][1];
                    *(u32x4*)(a2 + off) = pack8(v0, v1); s += ssq8(v0, v1); }
                s = red_fq(s); if (fq == 0) sqh[(size_t)(u.pn * 4 + wc) * T + row] = s; }
            asm volatile("" ::: "memory");
        }
    }
};
template <int PREP, int NPART, bool EXP2, int RES  , bool OUTF, bool OUTB, int SQM>
struct EpiGen {
    static constexpr bool PERM = true; static constexpr int MIDT = -1;
    const float* sqi; float inv_w; const float* res; float* of; bf16_t* ob; int ldo; float* sqo; LAS float* rtab; LAS float* tmp; const bf16_t* resb;
    __device__ __forceinline__ void mid(f32x4 (&)[2][2][4][2], const pg8::Unit&, int, int, int, int) const {}
    __device__ __forceinline__ void prep(const pg8::Unit& u) const { if constexpr (PREP != 0) prep_rtab<NPART, PREP == 1>(sqi, T, u.aux0, u.pm * 256, inv_w, rtab, tmp); }
    __device__ __forceinline__ void operator()(f32x4 (&acc)[2][2][4][2], const pg8::Unit& u, int wr, int wc, int fr, int fq) const {
        const int row0 = u.pm * 256 + wr * 64 + fr, col0 = u.pn * 256 + wc * 32 + fq * 8;
#pragma unroll
        for (int ai = 0; ai < 2; ++ai) {
            f32x4 pre[RES == 1 ? 4 : 1][2][2]; u32x4 preb[RES == 2 ? 4 : 1][2];
            if constexpr (RES == 1) {
#pragma unroll
                for (int m = 0; m < 4; ++m)
#pragma unroll
                    for (int bj = 0; bj < 2; ++bj) { const size_t off = (size_t)(row0 + ai * 128 + m * 16) * ldo + col0 + bj * 128; pre[m][bj][0] = *(const f32x4*)(res + off); pre[m][bj][1] = *(const f32x4*)(res + off + 4); }
                asm volatile("" ::: "memory"); }
            if constexpr (RES == 2) {
#pragma unroll
                for (int m = 0; m < 4; ++m)
#pragma unroll
                    for (int bj = 0; bj < 2; ++bj) preb[m][bj] = *(const u32x4*)(resb + (size_t)(row0 + ai * 128 + m * 16) * ldo + col0 + bj * 128);
                asm volatile("" ::: "memory"); }
#pragma unroll
            for (int m = 0; m < 4; ++m) { const int row = row0 + ai * 128 + m * 16; float s = 0.f;
                float r = 1.f; if constexpr (PREP != 0) r = rtab[ai * 128 + wr * 64 + m * 16 + fr];
#pragma unroll
                for (int bj = 0; bj < 2; ++bj) { const size_t off = (size_t)row * ldo + col0 + bj * 128;
                    f32x4 v0 = acc[ai][bj][m][0] * r, v1 = acc[ai][bj][m][1] * r;
                    if constexpr (EXP2) {
#pragma unroll
                        for (int q = 0; q < 4; ++q) { v0[q] = __builtin_amdgcn_exp2f(v0[q]); v1[q] = __builtin_amdgcn_exp2f(v1[q]); } }
                    if constexpr (RES == 1) { v0 += pre[m][bj][0]; v1 += pre[m][bj][1]; }
                    if constexpr (RES == 2) { const u32x4 w = preb[m][bj]; v0 += (f32x4){bf_lo(w.x), bf_hi(w.x), bf_lo(w.y), bf_hi(w.y)}; v1 += (f32x4){bf_lo(w.z), bf_hi(w.z), bf_lo(w.w), bf_hi(w.w)}; }
                    if constexpr (OUTF) { *(f32x4*)(of + off) = v0; *(f32x4*)(of + off + 4) = v1; }
                    if constexpr (OUTB) *(u32x4*)(ob + off) = pack8(v0, v1);
                    if constexpr (SQM == 1) s += ssq8(v0, v1);
                    if constexpr (SQM == 2) s += ((v0[0] + v0[1]) + (v0[2] + v0[3])) + ((v1[0] + v1[1]) + (v1[2] + v1[3])); }
                if constexpr (SQM != 0) { s = red_fq(s); if (fq == 0) sqo[(size_t)(u.aux1 + wc) * T + row] = s; } }
            if constexpr (RES != 0) asm volatile("" ::: "memory");
        }
    }
};

struct SchedSV {
    int G, c; const char* QX; const char* KX; const char* WO; const char* VX;
    __device__ __forceinline__ bool next(int i, pg8::Unit& u) const { const int L = i * G + c; if (L >= 256) return false;
        const int x = L & 7, h = (L >> 3) & 3, b = (L >> 5) & 3;
        if (L < 128) { u.pm = b * 8 + x; u.pn = h; u.aux0 = h * 8; u.aux1 = 0;
            u.A = QX + ((size_t)(b * SEQ + x * 256) * D + h * 512) * 2; u.B = KX + ((size_t)(b * MEM) * D + h * 512) * 2; }
        else { u.pm = b * 8 + x; u.pn = h; u.aux0 = 0; u.aux1 = 1;
            u.A = WO + ((size_t)(x * 256) * D + h * 512) * 2; u.B = VX + ((size_t)(b * MEM) * D + h * 512) * 2; }
        return true; }
};
struct EpiSV {
    static constexpr bool PERM = true; static constexpr int MIDT = -1;
    const float* sqi; bf16_t* px; bf16_t* vwt; LAS float* rtab; LAS float* tmp; LAS float* tbl;
    __device__ __forceinline__ void mid(f32x4 (&)[2][2][4][2], const pg8::Unit&, int, int, int, int) const {}
    __device__ __forceinline__ void prep(const pg8::Unit& u) const { if (u.aux1 == 0) prep_rtab<8, true>(sqi, T, u.aux0, u.pm * 256, 1.f / 512.f, rtab, tmp); }
    __device__ __forceinline__ void operator()(f32x4 (&acc)[2][2][4][2], const pg8::Unit& u, int wr, int wc, int fr, int fq) const {
        const int row0 = u.pm * 256 + wr * 64 + fr, col0 = u.pn * 256 + wc * 32 + fq * 8;
        if (u.aux1 != 0) {
#pragma unroll
            for (int ai = 0; ai < 2; ++ai)
#pragma unroll
                for (int m = 0; m < 4; ++m)
#pragma unroll
                    for (int bj = 0; bj < 2; ++bj) *(u32x4*)(vwt + (size_t)(row0 + ai * 128 + m * 16) * 1024 + col0 + bj * 128) = pack8(acc[ai][bj][m][0], acc[ai][bj][m][1]);
            return; }
#pragma unroll
        for (int ai = 0; ai < 2; ++ai)
#pragma unroll
            for (int m = 0; m < 4; ++m) { const int rl = ai * 128 + wr * 64 + m * 16 + fr; const float r = rtab[rl]; float s = 0.f;
#pragma unroll
                for (int bj = 0; bj < 2; ++bj)
#pragma unroll
                    for (int n = 0; n < 2; ++n) { f32x4 v = acc[ai][bj][m][n] * r;
#pragma unroll
                        for (int q = 0; q < 4; ++q) v[q] = __builtin_amdgcn_exp2f(v[q]);
                        acc[ai][bj][m][n] = v; s += (v[0] + v[1]) + (v[2] + v[3]); }
                s = red_fq(s); if (fq == 0) tbl[rl * 4 + wc] = s; }
        EPI_BAR();
#pragma unroll
        for (int ai = 0; ai < 2; ++ai)
#pragma unroll
            for (int m = 0; m < 4; ++m) { const int rl = ai * 128 + wr * 64 + m * 16 + fr; const f32x4 p = *(const LAS f32x4*)&tbl[rl * 4]; const float il = 1.f / ((p[0] + p[1]) + (p[2] + p[3]));
#pragma unroll
                for (int bj = 0; bj < 2; ++bj) *(u32x4*)(px + (size_t)(row0 + ai * 128 + m * 16) * 1024 + col0 + bj * 128) = pack8(acc[ai][bj][m][0] * il, acc[ai][bj][m][1] * il); }
    }
};
struct SchedPVW {
    TileOrder o; const char* A; const char* B;
    __device__ __forceinline__ bool next(int i, pg8::Unit& u) const { int pm, pn; if (!o.map(i, pm, pn)) return false;
        u.pm = pm; u.pn = pn; u.aux0 = 0; u.aux1 = pn * 4; u.A = A + (size_t)pm * 256 * 1024 * 2; u.B = B + ((size_t)(pm >> 3) * D + (size_t)pn * 256) * 1024 * 2; return true; }
};

struct SchedKV {
    int G, c; const char* MN; const char* WK; const char* WV;
    __device__ __forceinline__ bool next(int i, pg8::Unit& u) const { const int L = i * G + c; if (L >= 128) return false;
        const int pn = L & 7, pm = (L >> 3) & 3, kh = (L >> 5) & 1, wh = L >> 6;
        u.pm = pm; u.pn = pn; u.aux0 = wh * 2 + kh; u.aux1 = 0;
        u.A = MN + ((size_t)pm * 256 * D + kh * 1024) * 2; u.B = (wh ? WV : WK) + ((size_t)pn * 256 * D + kh * 1024) * 2; return true; }
};
struct EpiF32Slab {
    static constexpr bool PERM = true; static constexpr int MIDT = -1;
    float* O;
    __device__ __forceinline__ void mid(f32x4 (&)[2][2][4][2], const pg8::Unit&, int, int, int, int) const {}
    __device__ __forceinline__ void prep(const pg8::Unit&) const {}
    __device__ __forceinline__ void operator()(f32x4 (&acc)[2][2][4][2], const pg8::Unit& u, int wr, int wc, int fr, int fq) const {
        float* base = O + (size_t)u.aux0 * TM * D; const int row0 = u.pm * 256 + wr * 64 + fr, col0 = u.pn * 256 + wc * 32 + fq * 8;
#pragma unroll
        for (int ai = 0; ai < 2; ++ai)
#pragma unroll
            for (int m = 0; m < 4; ++m)
#pragma unroll
                for (int bj = 0; bj < 2; ++bj) { float* p = base + (size_t)(row0 + ai * 128 + m * 16) * D + col0 + bj * 128; *(f32x4*)p = acc[ai][bj][m][0]; *(f32x4*)(p + 4) = acc[ai][bj][m][1]; }
    }
};
__device__ __forceinline__ void kv_finish(Frame& F, const float* wq, const float* wk, int gw, int NGW) {
    const float* kf = (const float*)(F.ws + WS_QX); const float* vf = kf + (size_t)2 * TM * D;
    bf16_t* kx = (bf16_t*)(F.ws + WS_KX); bf16_t* vx = (bf16_t*)(F.ws + WS_VXT); const int lane = F.lane;
    for (int it = gw; it < TM * 4; it += NGW) { const int row = it >> 2, h = it & 3; const size_t off = (size_t)row * D + h * 512 + lane * 8;
        const f32x4 a0 = *(const f32x4*)(kf + off) + *(const f32x4*)(kf + (size_t)TM * D + off), a1 = *(const f32x4*)(kf + off + 4) + *(const f32x4*)(kf + (size_t)TM * D + off + 4);
        const f32x4 b0 = *(const f32x4*)(vf + off) + *(const f32x4*)(vf + (size_t)TM * D + off), b1 = *(const f32x4*)(vf + off + 4) + *(const f32x4*)(vf + (size_t)TM * D + off + 4);
        const float r = rsqrtf(wave_sum(ssq8(a0, a1)) * (1.f / 512.f) + EPS) * 0.04419417382415922f * 1.4426950408889634f;
        const f32x4 q0 = *(const f32x4*)(wq + lane * 8), q1 = *(const f32x4*)(wq + lane * 8 + 4), k0 = *(const f32x4*)(wk + lane * 8), k1 = *(const f32x4*)(wk + lane * 8 + 4);
        *(u32x4*)(kx + off) = pack8(a0 * r * q0 * k0, a1 * r * q1 * k1);
        *(u32x4*)(vx + off) = pack8(b0, b1); }
}

__device__ __forceinline__ void p0_prologue(Frame& F, const AV& a, int sel = 7) {
    const bool split = F.G >= 2 * NG;
    if (split) { if (F.vcu < NG) { if (sel & 1) ssm_tables(F, a, F.vcu); return; } } else { for (int g = F.vcu; g < NG; g += F.G) ssm_tables(F, a, g); }
    const int gw = (split ? F.vcu - NG : F.vcu) * NWAVES + F.wave, NGW = (split ? F.G - NG : F.G) * NWAVES;
    unsigned char* ws = F.ws;
    const float *w_in = a.in(3), *glu_w = a.in(19), *ssm_out_w = a.in(21), *w_out = a.in(22), *norm2_w = a.in(23), *xq_w = a.in(25), *xkv_w = a.in(26), *xo_w = a.in(29), *norm3_w = a.in(30);
    const float *e_wg = a.in(35), *e_wu = a.in(36), *e_wd = a.in(37);
    if (sel & 2) for (int it = gw; it < 4096; it += NGW) xpose_item(w_in, DIN, DIN, (bf16_t*)(ws + WS_W1T), D, nullptr, it, F.lane);
    if (!(sel & 4)) return;
    { const float* xin = a.in(0); const float* n1w = a.in(2); bf16_t* xn = (bf16_t*)(ws + WS_XN); int m = gw;
      for (; m + NGW < T; m += 2 * NGW) rms_row2_to_bf16(xin + (size_t)m * D, xin + (size_t)(m + NGW) * D, n1w, xn + (size_t)m * D, xn + (size_t)(m + NGW) * D, F.lane);
      if (m < T) rms_row_to_bf16(xin + (size_t)m * D, n1w, xn + (size_t)m * D, F.lane); }
    if (gw == 0) {
        const int l = F.lane; float s1 = a.in(6)[l] * a.in(7)[l] + a.in(6)[l + 64] * a.in(7)[l + 64], s2 = a.in(8)[l] * a.in(9)[l] + a.in(8)[l + 64] * a.in(9)[l + 64];
        s1 = wave_sum(s1); s2 = wave_sum(s2);
        if (l == 0) ((float*)(ws + WS_TAB))[0] = (float)(exp((double)s1) - exp((double)s2) + 0.2);
    }
}


struct AItem { int bh, qb0, qb1; };
__device__ __forceinline__ AItem a_decode(int L) { AItem it; it.bh = L >> 2; const int x = L & 3; it.qb0 = x; it.qb1 = 7 - x; return it; }
__device__ __forceinline__ attn::BlockRef<attn::bf16, attn::bf16> a_ref(const AItem& it, int pass, unsigned char* ws) {
    const int qb = pass ? it.qb1 : it.qb0, b = it.bh >> 4, vh = it.bh & 15, h = vh >> 2, c = (vh >> 1) & 1, vhalf = vh & 1;
    attn::BlockRef<attn::bf16, attn::bf16> r;
    r.Q = (const attn::bf16*)(ws + WS_QH) + ((size_t)(b * 8 + h * 2 + c) * SEQ + (size_t)qb * 256) * 128;
    r.K = (const attn::bf16*)(ws + WS_KH) + (size_t)(b * 8 + h * 2 + c) * SEQ * 128;
    r.V = (const attn::bf16*)(ws + WS_VH) + (size_t)(b * 8 + h * 2 + vhalf) * SEQ * 128;
    r.O = (attn::bf16*)(ws + WS_OH) + ((size_t)(b * 16 + vh) * SEQ + (size_t)qb * 256) * 128;
    r.P0 = qb * 256; return r;
}
__device__ __forceinline__ void p2_attention(Frame& F, char* lds) {
    using namespace attn;
    const int total = NB * 16 * 4, stride = F.G;
    int L = F.vcu; if (L >= total) return;
    AItem it = a_decode(L); int pass = 0;
    BlockRef<bf16, bf16> cur = a_ref(it, 0, F.ws);
    Seam<bf16> S;
    causal_swa_prime<bf16, bf16>(cur, SEQ, lds, S);
    for (;;) {
        const bool more_pass = pass == 0 && it.qb1 != it.qb0, more_item = L + stride < total, last = !more_pass && !more_item;
        AItem itn = it; int passn = pass + 1, Ln = L;
        if (!more_pass) { passn = 0; Ln = more_item ? L + stride : L; itn = a_decode(Ln); }
        const BlockRef<bf16, bf16> nxt = last ? cur : a_ref(itn, passn, F.ws);
        causal_swa_block<bf16, bf16>(cur, nxt, SEQ, SEQ, lds, S);
        if (last) break;
        cur = nxt; it = itn; pass = passn; L = Ln;
    }
}
__device__ __forceinline__ void p3_combine(Frame& F, const float* subln_w, int gw, int NGW) {
    const float lam = ((const float*)(F.ws + WS_TAB))[0];
    const bf16_t* Oh = (const bf16_t*)(F.ws + WS_OH); bf16_t* cat = (bf16_t*)(F.ws + WS_CAT);
    const int lane = F.lane, vhalf = lane >> 5, d = (lane & 31) * 4;
    const f32x4 w = *(const f32x4*)(subln_w + lane * 4);
    for (int it = gw; it < T * 4; it += NGW) {
        const int t = it >> 2, h = it & 3, b = t / SEQ, s = t % SEQ;
        const u32x2 a0 = *(const u32x2*)(Oh + ((size_t)(b * 16 + h * 4 + 0 + vhalf) * SEQ + s) * 128 + d);
        const u32x2 a1 = *(const u32x2*)(Oh + ((size_t)(b * 16 + h * 4 + 2 + vhalf) * SEQ + s) * 128 + d);
        f32x4 v; v[0] = bf_lo(a0.x) - lam * bf_lo(a1.x); v[1] = bf_hi(a0.x) - lam * bf_hi(a1.x); v[2] = bf_lo(a0.y) - lam * bf_lo(a1.y); v[3] = bf_hi(a0.y) - lam * bf_hi(a1.y);
        const float ss = wave_sum((v[0] * v[0] + v[1] * v[1]) + (v[2] * v[2] + v[3] * v[3]));
        const float r = rsqrtf(ss * (1.f / 256.f) + EPS) * 0.8f;
        u32x2 o; o.x = pk2(v[0] * r * w[0], v[1] * r * w[1]); o.y = pk2(v[2] * r * w[2], v[3] * r * w[3]);
        *(u32x2*)(cat + (size_t)t * D + 1024 + h * 256 + lane * 4) = o;
    }
}

constexpr size_t MOE_REC = 0, MOE_TOK = 3 * MiB, MOE_RWL = 4 * MiB;
constexpr int MT_CNT = 64, MT_START = 128, MT_MAX = 192;

__device__ __forceinline__ void p9_router(Frame& F, const AV& a, bool commit) {
    LAS float* part = (LAS float*)F.lds;
    LAS float* logit = part + 8 * 10 * 256;
    const bf16_t* h2b = (const bf16_t*)(F.ws + WS_H1); const bf16_t* rwh = (const bf16_t*)(F.ws + WS_TAB + TAB_RWH); const bf16_t* rwl = (const bf16_t*)(F.ws + WS_TAB + TAB_RWL);
    const float* sq = (const float*)(F.ws + WS_SSQ) + SQ_H2; const float *bc = a.in(32), *bfv = a.in(34);
    unsigned* rec = (unsigned*)(F.ws + WS_MOE + MOE_REC); unsigned* cnt = (unsigned*)(F.ctl + CW_CNT);
    const int tid = F.tid, lane = tid & 63, wave = F.wave, fr = lane & 15, fq = lane >> 4;
#ifdef TLB_TOUCH
    if (commit) {
        const int loc = (F.vcu & 31) * NTHR + mk_otid();
        if (loc < 4096) { float t0_, t1_, t2_;
            asm volatile("global_load_dword %0, %1, off" : "=v"(t0_) : "v"(a.in(35) + (size_t)loc * 16384) : "memory");
            asm volatile("global_load_dword %0, %1, off" : "=v"(t1_) : "v"(a.in(36) + (size_t)loc * 16384) : "memory");
            asm volatile("global_load_dword %0, %1, off" : "=v"(t2_) : "v"(a.in(37) + (size_t)loc * 16384) : "memory");
            asm volatile("s_waitcnt vmcnt(0)" ::: "memory");
            asm volatile("" :: "v"(t0_), "v"(t1_), "v"(t2_)); } }
#endif
    for (int t0 = F.vcu * 32; t0 < T; t0 += F.G * 32) {
        f32x4 acc[2][5];
#pragma unroll
        for (int i = 0; i < 2; ++i)
#pragma unroll
            for (int c = 0; c < 5; ++c) acc[i][c] = (f32x4){0.f, 0.f, 0.f, 0.f};
#pragma unroll 2
        for (int ks = 0; ks < 8; ++ks) { const int k = wave * 256 + ks * 32 + fq * 8;
            bf16x8 xh[2];
#pragma unroll
            for (int rb = 0; rb < 2; ++rb) xh[rb] = *(const bf16x8*)(h2b + (size_t)(t0 + rb * 16 + fr) * D + k);
#pragma unroll
            for (int cb = 0; cb < 5; ++cb) { const bf16x8 wh = *(const bf16x8*)(rwh + (size_t)(cb * 16 + fr) * D + k), wl = *(const bf16x8*)(rwl + (size_t)(cb * 16 + fr) * D + k);
#pragma unroll
                for (int rb = 0; rb < 2; ++rb) { acc[rb][cb] = __builtin_amdgcn_mfma_f32_16x16x32_bf16(xh[rb], wh, acc[rb][cb], 0, 0, 0);
                    acc[rb][cb] = __builtin_amdgcn_mfma_f32_16x16x32_bf16(xh[rb], wl, acc[rb][cb], 0, 0, 0); } }
        }
        __syncthreads();
#pragma unroll
        for (int rb = 0; rb < 2; ++rb)
#pragma unroll
            for (int cb = 0; cb < 5; ++cb) *(LAS f32x4*)(part + ((wave * 10 + rb * 5 + cb) * 64 + lane) * 4) = acc[rb][cb];
        __syncthreads();
        for (int e = tid; e < 10 * 256; e += NTHR) { float s = 0.f;
#pragma unroll
            for (int w = 0; w < 8; ++w) s += part[w * 2560 + e];
            const int tile = e >> 8, ln = (e >> 2) & 63, r = e & 3, rb = tile / 5, cb = tile % 5;
            logit[(rb * 16 + 4 * (ln >> 4) + r) * 80 + cb * 16 + (ln & 15)] = s; }
        __syncthreads();
        if (tid < 32 && commit) { const int t = t0 + tid; float s = 0.f;
            for (int p = 0; p < 32; ++p) s += sq[(size_t)p * T + t];
            const float r3 = rsqrtf(s * (1.f / 2048.f) + EPS);
            const LAS float* lg = logit + tid * 80;
            int grp = 0; float lc[8];
#pragma unroll
            for (int g = 0; g < 8; ++g) { lc[g] = lg[g] * r3 + bc[g]; }
            float mx = lc[0];
#pragma unroll
            for (int g = 1; g < 8; ++g) if (lc[g] > mx) { mx = lc[g]; grp = g; }
            float se = 0.f;
#pragma unroll
            for (int g = 0; g < 8; ++g) se += __expf(lc[g] - mx);
            const float pgrp = 1.f / se;
            int j0 = 0, j1 = 0; float v0 = -3e38f, v1 = -3e38f;
            for (int j = 0; j < 8; ++j) { const float f = lg[8 + grp * 8 + j] * r3 + bfv[grp * 8 + j];
                if (f > v0) { v1 = v0; j1 = j0; v0 = f; j0 = j; } else if (f > v1) { v1 = f; j1 = j; } }
            const float e1 = __expf(v1 - v0), w0 = pgrp / (1.f + e1), w1 = pgrp * e1 / (1.f + e1);
            const int ea = grp * 8 + j0, eb = grp * 8 + j1;
            const unsigned pa = __hip_atomic_fetch_add(cnt + ea, 1u, RLX_AGENT), pb = __hip_atomic_fetch_add(cnt + eb, 1u, RLX_AGENT);
            u32x4 r0 = {(unsigned)ea, (unsigned)eb, __float_as_uint(w0), __float_as_uint(w1)}, r1 = {pa, pb, __float_as_uint(r3), 0u};
            *(u32x4*)(rec + (size_t)t * 8) = r0; *(u32x4*)(rec + (size_t)t * 8 + 4) = r1;
            { unsigned short* tokl = (unsigned short*)(F.ws + WS_MOE + MOE_TOK); float* rwl = (float*)(F.ws + WS_MOE + MOE_RWL);
              tokl[(size_t)ea * T + pa] = (unsigned short)t; tokl[(size_t)eb * T + pb] = (unsigned short)t; rwl[(size_t)ea * T + pa] = w0; rwl[(size_t)eb * T + pb] = w1; }
            logit[tid * 80 + 72] = r3; }
        __syncthreads();
        if (commit) {
            bf16_t* hn3 = (bf16_t*)(F.ws + WS_XN); const f32x4* nw = (const f32x4*)a.in(30);
            for (int q = 0; q < 4; ++q) { const int tl = wave * 4 + q, t = t0 + tl; const float r3 = logit[tl * 80 + 72]; const u32x4* src = (const u32x4*)(h2b + (size_t)t * D);
#pragma unroll
                for (int j = 0; j < 4; ++j) { const int c8 = j * 64 + lane; const u32x4 w = src[c8];
                    const f32x4 v0 = {bf_lo(w.x), bf_hi(w.x), bf_lo(w.y), bf_hi(w.y)}, v1 = {bf_lo(w.z), bf_hi(w.z), bf_lo(w.w), bf_hi(w.w)};
                    *(u32x4*)(hn3 + (size_t)t * D + c8 * 8) = pack8(v0 * r3 * nw[c8 * 2], v1 * r3 * nw[c8 * 2 + 1]); } } }
        __syncthreads();
    }
}
__device__ __forceinline__ void moe_tables(Frame& F) {
    volatile LAS unsigned* M = F.MISC; const unsigned* cnt = (const unsigned*)(F.ctl + CW_CNT);
    __syncthreads();
    if (F.tid < 64) { const unsigned c = __hip_atomic_load(cnt + F.tid, RLX_AGENT); unsigned s = c;
#pragma unroll
        for (int o = 1; o < 64; o <<= 1) { const unsigned v = __shfl_up(s, o); if ((F.tid & 63) >= o) s += v; }
        M[MT_CNT + F.tid] = c; M[MT_START + F.tid] = s - c;
        unsigned mx = c;
#pragma unroll
        for (int o = 1; o < 64; o <<= 1) { const unsigned v = __shfl_xor(mx, o); mx = v > mx ? v : mx; }
        if (F.tid == 0) M[MT_MAX] = mx; }
    __syncthreads();
}
#ifndef FG_PASS
#define FG_PASS 320
#endif
#ifndef FG_STREAM
#define FG_STREAM 0
#endif
constexpr int FG_ROWS = 320, FG_MF = 5, FG_ABUF = FG_ROWS * 128, FG_BOFF = 3 * FG_ABUF, FG_BBUF = 128 * 128;
#define FG_DMA(slot, tile) do { _Pragma("unroll") for (int i_ = 0; i_ < 10; ++i_) if (i_ < 8 || i_ < nA) \
    __builtin_amdgcn_global_load_lds((const unsigned*)(Ab + (size_t)(tile) * 128 + rowoff[i_]), (LAS unsigned*)(lds + (slot) * FG_ABUF + (i_ * 4 + wave) * 1024), 16, 0, 0); } while (0)
#define FG_BLOAD(S, tile) do { unsigned long long p_ = (unsigned long long)(bsrc + (size_t)(tile) * 64 * ldb); asm volatile("" : "+v"(p_)); _Pragma("unroll") for (int r_ = 0; r_ < 8; ++r_) \
    asm volatile("global_load_dwordx4 %0, %1, off nt" : "=v"(bst##S[r_]) : "v"(p_ + (unsigned long long)r_ * ldb * 4) : "memory"); } while (0)
#define FG_BWRITE(S, buf) do { asm volatile("" : "+v"(bst##S[0]), "+v"(bst##S[1]), "+v"(bst##S[2]), "+v"(bst##S[3]), "+v"(bst##S[4]), "+v"(bst##S[5]), "+v"(bst##S[6]), "+v"(bst##S[7])); \
    _Pragma("unroll") for (int c_ = 0; c_ < 4; ++c_) { u32x4 w_; w_.x = cvt_pk_bf16(bst##S[0][c_], bst##S[1][c_]); w_.y = cvt_pk_bf16(bst##S[2][c_], bst##S[3][c_]); \
    w_.z = cvt_pk_bf16(bst##S[4][c_], bst##S[5][c_]); w_.w = cvt_pk_bf16(bst##S[6][c_], bst##S[7][c_]); \
    *(LAS u32x4*)(lds + FG_BOFF + (buf) * FG_BBUF + (4 * nq + c_) * 128 + ((kq ^ ((4 * nq + c_) & 7)) * 16)) = w_; } } while (0)
#define FG_WAITV(n) asm volatile("s_waitcnt vmcnt(%0)" :: "n"(n) : "memory")
#define FG_WAITVA(base) do { if (nA == 10) FG_WAITV((base) + 10); else if (nA == 9) FG_WAITV((base) + 9); else FG_WAITV((base) + 8); } while (0)
#define FG_BAR() do { asm volatile("s_waitcnt lgkmcnt(0)" ::: "memory"); __builtin_amdgcn_s_barrier(); asm volatile("" ::: "memory"); } while (0)
#define FG_LSTEP(t, S0, S1) do { if ((t) < nkt) { \
    if (!(MODE & 2) && (t) + 2 < nkt) FG_DMA(((t) + 2) % 3, (t) + 2); \
    if (!(MODE & 1) && (t) + 3 < nkt) FG_BLOAD(S0, (t) + 3); \
    if ((t) + 1 < nkt) { if ((t) + 3 < nkt) { if (MODE & 2) FG_WAITV(2 * NBL); else FG_WAITVA(2 * NBL); } else if ((t) + 2 < nkt) { if (MODE & 2) FG_WAITV(NBL); else FG_WAITVA(NBL); } else FG_WAITV(0); \
        __builtin_amdgcn_sched_barrier(0); FG_BWRITE(S1, ((t) + 1) & 1); } \
    FG_BAR(); } } while (0)
template <bool ACT, int MODE = 0>
__device__ __forceinline__ void fg_unit(Frame& F, const bf16_t* A, int lda, int K, int nrows, const float* Bg, const float* Bu, int ldb, bf16_t* O, int ldo, const float* roww,
                                        const unsigned short* tokl = nullptr) {
    LAS unsigned char* lds = F.lds;
    const int nkt = K / 64;
    for (int r0 = 0; r0 < nrows; r0 += FG_PASS) {
        const int pend = (r0 + FG_PASS < nrows) ? r0 + FG_PASS : nrows;
        constexpr int NC = ACT ? 64 : 128;
        LAS unsigned short* img = (LAS unsigned short*)lds;
        if (F.wave < 4) {
            const int wave = F.wave;
            int nA = (pend - r0 - wave * 8 + 31) >> 5; nA = nA < 8 ? 8 : (nA > 10 ? 10 : nA);
#ifdef FG_NOSKIP
            nA = 10;
#endif
            const char* Ab = (const char*)A + (ACT ? (size_t)0 : (size_t)r0 * lda * 2);
            unsigned rowoff[10];
            { const int l_ = mk_otid() & 63;
#pragma unroll
              for (int i = 0; i < 10; ++i) { const int row = i * 32 + wave * 8 + (l_ >> 3); const unsigned rr = ACT ? ((r0 + row < pend) ? (unsigned)tokl[r0 + row] : 0u) : (unsigned)row;
                  rowoff[i] = (rr * (unsigned)lda + (unsigned)(((l_ & 7) ^ ((l_ >> 3) & 7)) * 8)) * 2u; } }
            const int ltid = mk_otid() & 255, kq = ltid >> 5, nq = ltid & 31;
            const float* bsrc = (ACT ? (nq < 16 ? Bg + 4 * nq : Bu + 4 * (nq - 16)) : Bg + 4 * nq) + (size_t)(8 * kq) * ldb;
            constexpr int NBL = (MODE & 1) ? 0 : 8;
            f32x4 bst0[8], bst1[8], bst2[8];
            if (!(MODE & 2)) FG_DMA(0, 0); if (!(MODE & 1)) FG_BLOAD(0, 0); if (!(MODE & 2)) FG_DMA(1, 1); if (!(MODE & 1)) { FG_BLOAD(1, 1); FG_BLOAD(2, 2); }
            if (MODE & 2) FG_WAITV(2 * NBL); else FG_WAITVA(2 * NBL);
            __builtin_amdgcn_sched_barrier(0);
            FG_BWRITE(0, 0);
            FG_BAR();
            for (int t0 = 0; t0 < nkt; t0 += 3) { FG_LSTEP(t0, 0, 1); FG_LSTEP(t0 + 1, 1, 2); FG_LSTEP(t0 + 2, 2, 0); }
        } else {
            const int cw = F.wave - 4, lane = mk_otid() & 63, fr = lane & 15, fq = lane >> 4;
            f32x4 acc[FG_MF][8];
#pragma unroll
            for (int i = 0; i < FG_MF; ++i)
#pragma unroll
                for (int j = 0; j < 8; ++j) acc[i][j] = (f32x4){0.f, 0.f, 0.f, 0.f};
            const int abase = (cw * (FG_MF * 16) + fr) * 128, bbase = FG_BOFF + fr * 128;
            const int swz0 = ((fq) ^ (fr & 7)) * 16, swz1 = ((4 + fq) ^ (fr & 7)) * 16;
            FG_BAR();
            for (int t = 0; t < nkt; ++t) {
                if (!(MODE & 4)) { LAS unsigned char* ca = lds + (t % 3) * FG_ABUF + abase; LAS unsigned char* cb = lds + (t & 1) * FG_BBUF + bbase;
#pragma unroll
                    for (int ks = 0; ks < 2; ++ks) { const int swz = ks ? swz1 : swz0; bf16x8 bf[8], af[FG_MF];
#pragma unroll
                        for (int nf = 0; nf < 8; ++nf) bf[nf] = *(const LAS bf16x8*)(cb + swz + nf * 2048);
#pragma unroll
                        for (int mf = 0; mf < FG_MF; ++mf) af[mf] = *(const LAS bf16x8*)(ca + swz + mf * 2048);
                        __builtin_amdgcn_sched_barrier(0); __builtin_amdgcn_s_setprio(1);
#pragma unroll
                        for (int mf = 0; mf < FG_MF; ++mf)
#pragma unroll
                            for (int nf = 0; nf < 8; ++nf) acc[mf][nf] = __builtin_amdgcn_mfma_f32_16x16x32_bf16(af[mf], bf[nf], acc[mf][nf], 0, 0, 0);
                        __builtin_amdgcn_s_setprio(0); __builtin_amdgcn_sched_barrier(0); } }
                FG_BAR();
            }
            if (MODE == 0) {
                constexpr int NC = ACT ? 64 : 128, RS = NC * 2 + 16, CPR = NC / 8;
                LAS unsigned char* stg = lds + FG_BOFF + FG_BBUF + cw * 4608;
#pragma unroll
                for (int mf = 0; mf < FG_MF; ++mf) {
#pragma unroll
                    for (int r = 0; r < 4; ++r) { const int rl = fq * 4 + r, row = cw * (FG_MF * 16) + mf * 16 + rl;
                        if constexpr (ACT) {
#pragma unroll
                            for (int h = 0; h < 4; ++h) { const float g = acc[mf][h][r], up = acc[mf][4 + h][r]; const float v = g * sigmoid_fast(g) * up;
                                *(LAS unsigned short*)(stg + rl * RS + (h * 16 + fr) * 2) = (unsigned short)f2bf(v); }
                        } else {
                            const float w = (r0 + row < pend) ? roww[r0 + row] : 0.f;
#pragma unroll
                            for (int nf = 0; nf < 8; ++nf) *(LAS unsigned short*)(stg + rl * RS + (nf * 16 + fr) * 2) = (unsigned short)f2bf(acc[mf][nf][r] * w);
                        }
                    }
                    asm volatile("s_waitcnt lgkmcnt(0)" ::: "memory");
#pragma unroll
                    for (int q = 0; q < (16 * CPR) / 64; ++q) { const int sidx = q * 64 + lane, rl = sidx / CPR, ch = sidx % CPR, row = cw * (FG_MF * 16) + mf * 16 + rl;
                        const u32x4 v = *(const LAS u32x4*)(stg + rl * RS + ch * 16);
                        if (r0 + row < pend) *(u32x4*)(O + (size_t)(r0 + row) * ldo + ch * 8) = v; }
                    asm volatile("s_waitcnt lgkmcnt(0)" ::: "memory");
                }
            }
        }
    }
}
template <bool ACT>
__device__ __forceinline__ void fg_stream(Frame& F, const AV& args, const int nv) {
    LAS unsigned char* lds = F.lds; unsigned char* ws = F.ws;
    constexpr int K = ACT ? D : DFF, nkt = K / 64, lda = ACT ? D : DFF, ldb = ACT ? DFF : D, ldo = ACT ? DFF : D;
    const int NT = nv * nkt, G = F.G, vcu = F.vcu;
    if (F.wave < 4) {
        const int wave = F.wave;
        const int l_ = mk_otid() & 63;
        const int ltid = mk_otid() & 255, kq = ltid >> 5, nq = ltid & 31;
        const char* Ab; unsigned rowoff[10]; unsigned rowoff1[10];
        int nA; { int nmax = 0; for (int v = 0; v < nv; ++v) { const int L = vcu + v * G, n_ = (int)F.MISC[MT_CNT + (ACT ? (L >> 3) : (L >> 4))]; nmax = n_ > nmax ? n_ : nmax; }
                  nA = (nmax - wave * 8 + 31) >> 5; nA = nA < 8 ? 8 : (nA > 10 ? 10 : nA); }
        const unsigned swz_ = (unsigned)(((l_ & 7) ^ ((l_ >> 3) & 7)) * 8);
        if constexpr (ACT) {
            Ab = (const char*)(ws + WS_XN);
            { const int e = vcu >> 3, n = (int)F.MISC[MT_CNT + e]; const unsigned short* tokl = (const unsigned short*)(ws + WS_MOE + MOE_TOK) + (size_t)e * T;
#pragma unroll
              for (int i = 0; i < 10; ++i) { const int row = i * 32 + wave * 8 + (l_ >> 3); const unsigned rr = (row < n) ? (unsigned)tokl[row] : 0u; rowoff[i] = (rr * (unsigned)lda + swz_) * 2u; } }
            if (nv > 1) { const int e = (vcu + G) >> 3, n = (int)F.MISC[MT_CNT + e]; const unsigned short* tokl = (const unsigned short*)(ws + WS_MOE + MOE_TOK) + (size_t)e * T;
#pragma unroll
              for (int i = 0; i < 10; ++i) { const int row = i * 32 + wave * 8 + (l_ >> 3); const unsigned rr = (row < n) ? (unsigned)tokl[row] : 0u; rowoff1[i] = (rr * (unsigned)lda + swz_) * 2u; } }
            else {
#pragma unroll
              for (int i = 0; i < 10; ++i) rowoff1[i] = rowoff[i]; }
        } else {
            Ab = (const char*)(ws + WS_ACT) + (size_t)F.MISC[MT_START + (vcu >> 4)] * (DFF * 2);
#pragma unroll
            for (int i = 0; i < 10; ++i) { const int row = i * 32 + wave * 8 + (l_ >> 3); rowoff[i] = ((unsigned)row * (unsigned)lda + swz_) * 2u; rowoff1[i] = 0; }
        }
#define FS_BBASE(v_) (ACT ? ((nq < 16 ? args.in(35) : args.in(36)) + (size_t)((vcu + (v_) * G) >> 3) * D * DFF + ((vcu + (v_) * G) & 7) * 64 + 4 * (nq & 15) + (size_t)(8 * kq) * ldb) \
                          : (args.in(37) + (size_t)((vcu + (v_) * G) >> 4) * DFF * D + ((vcu + (v_) * G) & 15) * 128 + 4 * nq + (size_t)(8 * kq) * ldb))
        const float* pB = FS_BBASE(0);
        int ktB = 0, vB = 0, ktA = 0, vA = 0, ktC = 0;
#define FS_BLOAD(S) do { unsigned long long p_ = (unsigned long long)pB; asm volatile("" : "+v"(p_)); _Pragma("unroll") for (int r_ = 0; r_ < 8; ++r_) \
    asm volatile("global_load_dwordx4 %0, %1, off nt" : "=v"(bst##S[r_]) : "v"(p_ + (unsigned long long)r_ * ldb * 4) : "memory"); \
    if (++ktB == nkt) { ktB = 0; ++vB; if (vB < nv) pB = FS_BBASE(vB); } else pB += (size_t)64 * ldb; } while (0)
#define FS_DMA(slot) do { FG_DMA(slot, ktA); if (++ktA == nkt) { ktA = 0; ++vA; if (vA < nv) { \
    if constexpr (ACT) { _Pragma("unroll") for (int i_ = 0; i_ < 10; ++i_) rowoff[i_] = rowoff1[i_]; } \
    else Ab = (const char*)(ws + WS_ACT) + (size_t)F.MISC[MT_START + ((vcu + vA * G) >> 4)] * (DFF * 2); } } } while (0)
#define FS_STEP(g, PH, S0, S1) do { if ((g) < NT) { \
    if ((g) + 2 < NT) FS_DMA(((PH) + 2) % 3); \
    if ((g) + 3 < NT) FS_BLOAD(S0); \
    if ((g) + 1 < NT) { if ((g) + 3 < NT) FG_WAITVA(16); else if ((g) + 2 < NT) FG_WAITVA(8); else FG_WAITV(0); \
        if (ktC == 0 && (g) > 0) FG_BAR(); \
        __builtin_amdgcn_sched_barrier(0); FG_BWRITE(S1, ((g) + 1) & 1); } \
    FG_BAR(); if (++ktC == nkt) ktC = 0; } } while (0)
        f32x4 bst0[8], bst1[8], bst2[8];
        FS_DMA(0); FS_BLOAD(0); FS_DMA(1); FS_BLOAD(1); FS_BLOAD(2);
        FG_WAITVA(16);
        __builtin_amdgcn_sched_barrier(0);
        FG_BWRITE(0, 0);
        FG_BAR();
        for (int g0 = 0; g0 < NT; g0 += 3) { FS_STEP(g0, 0, 0, 1); FS_STEP(g0 + 1, 1, 1, 2); FS_STEP(g0 + 2, 2, 2, 0); }
    } else {
        const int cw = F.wave - 4, lane = mk_otid() & 63, fr = lane & 15, fq = lane >> 4;
        const int abase = (cw * (FG_MF * 16) + fr) * 128, bbase = FG_BOFF + fr * 128;
        const int swz0 = ((fq) ^ (fr & 7)) * 16, swz1 = ((4 + fq) ^ (fr & 7)) * 16;
        int slot = 0, par = 0;
        FG_BAR();
        for (int v = 0; v < nv; ++v) {
            f32x4 acc[FG_MF][8];
#pragma unroll
            for (int i = 0; i < FG_MF; ++i)
#pragma unroll
                for (int j = 0; j < 8; ++j) acc[i][j] = (f32x4){0.f, 0.f, 0.f, 0.f};
            for (int t = 0; t < nkt; ++t) {
                { LAS unsigned char* ca = lds + slot * FG_ABUF + abase; LAS unsigned char* cb = lds + par * FG_BBUF + bbase;
#pragma unroll
                    for (int ks = 0; ks < 2; ++ks) { const int swz = ks ? swz1 : swz0; bf16x8 bf[8], af[FG_MF];
#pragma unroll
                        for (int nf = 0; nf < 8; ++nf) bf[nf] = *(const LAS bf16x8*)(cb + swz + nf * 2048);
#pragma unroll
                        for (int mf = 0; mf < FG_MF; ++mf) af[mf] = *(const LAS bf16x8*)(ca + swz + mf * 2048);
                        __builtin_amdgcn_sched_barrier(0); __builtin_amdgcn_s_setprio(1);
#pragma unroll
                        for (int mf = 0; mf < FG_MF; ++mf)
#pragma unroll
                            for (int nf = 0; nf < 8; ++nf) acc[mf][nf] = __builtin_amdgcn_mfma_f32_16x16x32_bf16(af[mf], bf[nf], acc[mf][nf], 0, 0, 0);
                        __builtin_amdgcn_s_setprio(0); __builtin_amdgcn_sched_barrier(0); } }
                FG_BAR();
                slot = (slot == 2) ? 0 : slot + 1; par ^= 1;
            }
            {
                const int lane = mk_otid() & 63, fr = lane & 15, fq = lane >> 4;
                const int L = vcu + v * G, e = ACT ? (L >> 3) : (L >> 4), ct = ACT ? (L & 7) : (L & 15);
                const int row0 = (int)F.MISC[MT_START + e], pend = (int)F.MISC[MT_CNT + e];
                bf16_t* O = ACT ? (bf16_t*)(ws + WS_ACT) + (size_t)row0 * DFF + ct * 64 : (bf16_t*)(ws + WS_YS) + (size_t)row0 * D + ct * 128;
                const float* roww = (const float*)(ws + WS_MOE + MOE_RWL) + (size_t)e * T;
                constexpr int NC = ACT ? 64 : 128, RS = NC * 2 + 16, CPR = NC / 8;
                LAS unsigned char* stg = lds + FG_BOFF + FG_BBUF + cw * 4608;
#pragma unroll
                for (int mf = 0; mf < FG_MF; ++mf) {
#pragma unroll
                    for (int r = 0; r < 4; ++r) { const int rl = fq * 4 + r, row = cw * (FG_MF * 16) + mf * 16 + rl;
                        if constexpr (ACT) {
#pragma unroll
                            for (int h = 0; h < 4; ++h) { const float g = acc[mf][h][r], up = acc[mf][4 + h][r]; const float vv = g * sigmoid_fast(g) * up;
                                *(LAS unsigned short*)(stg + rl * RS + (h * 16 + fr) * 2) = (unsigned short)f2bf(vv); }
                        } else {
                            const float w = (row < pend) ? roww[row] : 0.f;
#pragma unroll
                            for (int nf = 0; nf < 8; ++nf) *(LAS unsigned short*)(stg + rl * RS + (nf * 16 + fr) * 2) = (unsigned short)f2bf(acc[mf][nf][r] * w);
                        }
                    }
                    asm volatile("s_waitcnt lgkmcnt(0)" ::: "memory");
#pragma unroll
                    for (int q = 0; q < (16 * CPR) / 64; ++q) { const int sidx = q * 64 + lane, rl = sidx / CPR, ch = sidx % CPR, row = cw * (FG_MF * 16) + mf * 16 + rl;
                        const u32x4 vv = *(const LAS u32x4*)(stg + rl * RS + ch * 16);
                        if (row < pend) *(u32x4*)(O + (size_t)row * ldo + ch * 8) = vv; }
                    asm volatile("s_waitcnt lgkmcnt(0)" ::: "memory");
                }
            }
            if (v + 1 < nv) FG_BAR();
        }
    }
}
__device__ __forceinline__ void p13_combine(Frame& F, const AV& a, bool commit = true) {
    moe_tables(F);
    const unsigned* rec = (const unsigned*)(F.ws + WS_MOE + MOE_REC); const bf16_t* ys = (const bf16_t*)(F.ws + WS_YS);
    const int lane = F.lane;
    for (int t = F.vcu * NWAVES + F.wave; t < T; t += F.G * NWAVES) {
        const u32x4 r0 = *(const u32x4*)(rec + (size_t)t * 8), r1 = *(const u32x4*)(rec + (size_t)t * 8 + 4);
        const unsigned rowa = F.MISC[MT_START + r0.x] + r1.x, rowb = F.MISC[MT_START + r0.y] + r1.y;
        f32x4* o = (f32x4*)(a.out() + (size_t)t * D); const u32x4* hb = (const u32x4*)((const bf16_t*)(F.ws + WS_H1) + (size_t)t * D);
#pragma unroll
        for (int j = 0; j < 4; ++j) { const int c8 = j * 64 + lane;
            const u32x4 ya = *(const u32x4*)(ys + (size_t)rowa * D + c8 * 8), yb = *(const u32x4*)(ys + (size_t)rowb * D + c8 * 8), hw = hb[c8];
            f32x4 v0, v1;
            v0[0] = bf_lo(hw.x) + bf_lo(ya.x) + bf_lo(yb.x); v0[1] = bf_hi(hw.x) + bf_hi(ya.x) + bf_hi(yb.x); v0[2] = bf_lo(hw.y) + bf_lo(ya.y) + bf_lo(yb.y); v0[3] = bf_hi(hw.y) + bf_hi(ya.y) + bf_hi(yb.y);
            v1[0] = bf_lo(hw.z) + bf_lo(ya.z) + bf_lo(yb.z); v1[1] = bf_hi(hw.z) + bf_hi(ya.z) + bf_hi(yb.z); v1[2] = bf_lo(hw.w) + bf_lo(ya.w) + bf_lo(yb.w); v1[3] = bf_hi(hw.w) + bf_hi(ya.w) + bf_hi(yb.w);
            if (commit) { __builtin_nontemporal_store(v0, o + c8 * 2); __builtin_nontemporal_store(v1, o + c8 * 2 + 1); } else { asm volatile("" :: "v"(v0), "v"(v1)); } }
    }
}

__device__ __forceinline__ void mid_weight_copies(Frame& F, const AV& a, int gw, int NGW) {
    unsigned char* ws = F.ws; const float *glu_w = a.in(19), *xkv_w = a.in(26);
    constexpr int J1 = 512, J2 = J1 + 2048, J3 = J2 + 2048;
    for (int it = gw; it < J3; it += NGW) {
        if (it < J1) xpose_item(glu_w, DSSM, DSSM, (bf16_t*)(ws + WS_WGLU), DSSM, nullptr, it, F.lane);
        else if (it < J2) xpose_item(xkv_w, 4096, D, (bf16_t*)(ws + WS_WXK), D, nullptr, it - J1, F.lane);
        else xpose_item(xkv_w + 2048, 4096, D, (bf16_t*)(ws + WS_WXV), D, nullptr, it - J2, F.lane);
    }
    for (int m = gw; m < TM; m += NGW) rms_row_to_bf16(a.in(1) + (size_t)m * D, a.in(24), (bf16_t*)(ws + WS_MN) + (size_t)m * D, F.lane);
}

__device__ __forceinline__ void late_weight_copies(Frame& F, const AV& a, int gw, int NGW) {
    unsigned char* ws = F.ws; const float *ssm_out_w = a.in(21), *w_out = a.in(22), *norm2_w = a.in(23), *xq_w = a.in(25), *xo_w = a.in(29);
    constexpr int K0 = 1024, K1 = K0 + 1024, K2 = K1 + 2048, K3 = K2 + 2048;
    for (int it = gw; it < K3; it += NGW) {
        if (it < K0) xpose_item(w_out, D, D, (bf16_t*)(ws + WS_WOUT) + 1024, D, nullptr, it, F.lane);
        else if (it < K1) xpose_item(w_out + (size_t)1024 * D, D, D, (bf16_t*)(ws + WS_WOUT), D, ssm_out_w, it - K0, F.lane);
        else if (it < K2) xpose_item(xq_w, D, D, (bf16_t*)(ws + WS_WXQ), D, norm2_w, it - K1, F.lane);
        else xpose_item(xo_w, D, D, (bf16_t*)(ws + WS_WXO), D, nullptr, it - K2, F.lane);
    }
    const float* norm3_w = a.in(30);
    { bf16_t* rwh = (bf16_t*)(ws + WS_TAB + TAB_RWH); bf16_t* rwl = (bf16_t*)(ws + WS_TAB + TAB_RWL); const float *rc_w = a.in(31), *rf_w = a.in(33);
      for (int i = gw * 64 + F.lane; i < 80 * D; i += NGW * 64) { const int c = i / D, k = i % D; float v = c < 8 ? rc_w[k * 8 + c] : (c < 72 ? rf_w[k * 64 + c - 8] : 0.f); v *= norm3_w[k];
          const unsigned hb = f2bf(v); rwh[i] = (bf16_t)hb; rwl[i] = (bf16_t)f2bf(v - __uint_as_float(hb << 16)); } }
}


#ifdef PROBE_STREAM
__device__ __forceinline__ void stream_probe(Frame& F, const AV& args) {
    const int tid = mk_otid(), lane = tid & 63, wave = tid >> 6;
    LAS unsigned* dummy = (LAS unsigned*)(F.lds + RING_OFF + wave * 1024);
#if PROBE_STREAM == 1
    for (int L = F.vcu; L < NE * 8; L += F.G) { const int e = L >> 3, jt = L & 7;
        const char* g = (const char*)(args.in(35) + (size_t)e * D * DFF + jt * 64) + (size_t)(wave * 4 + (lane >> 4)) * (DFF * 4) + (lane & 15) * 16;
        const char* u = (const char*)(args.in(36) + (size_t)e * D * DFF + jt * 64) + (size_t)(wave * 4 + (lane >> 4)) * (DFF * 4) + (lane & 15) * 16;
        for (int kb = 0; kb < D / 32; ++kb) {
            __builtin_amdgcn_global_load_lds((const unsigned*)(g + (size_t)kb * 32 * DFF * 4), dummy, 16, 0, 0);
            __builtin_amdgcn_global_load_lds((const unsigned*)(u + (size_t)kb * 32 * DFF * 4), dummy, 16, 0, 0);
            asm volatile("s_waitcnt vmcnt(12)" ::: "memory");
        } }
#elif PROBE_STREAM == 2
    for (int L = F.vcu; L < NE * 8; L += F.G) {
        const char* g = (const char*)args.in(35) + (size_t)L * (1 << 20) + wave * 1024 + lane * 16;
        const char* u = (const char*)args.in(36) + (size_t)L * (1 << 20) + wave * 1024 + lane * 16;
        for (int kb = 0; kb < 128; ++kb) {
            __builtin_amdgcn_global_load_lds((const unsigned*)(g + (size_t)kb * 8192), dummy, 16, 0, 0);
            __builtin_amdgcn_global_load_lds((const unsigned*)(u + (size_t)kb * 8192), dummy, 16, 0, 0);
            asm volatile("s_waitcnt vmcnt(12)" ::: "memory");
        } }
#elif PROBE_STREAM == 3
    for (int L = F.vcu; L < NE * 16; L += F.G) { const int e = L >> 4, nt = L & 15;
        const char* g = (const char*)(args.in(37) + (size_t)e * DFF * D + nt * 128) + (size_t)(wave * 2 + (lane >> 5)) * (D * 4) + (lane & 31) * 16;
        for (int kb = 0; kb < DFF / 16; kb += 2) {
            __builtin_amdgcn_global_load_lds((const unsigned*)(g + (size_t)kb * 16 * D * 4), dummy, 16, 0, 0);
            __builtin_amdgcn_global_load_lds((const unsigned*)(g + (size_t)(kb + 1) * 16 * D * 4), dummy, 16, 0, 0);
            asm volatile("s_waitcnt vmcnt(12)" ::: "memory");
        } }
#elif PROBE_STREAM == 4
    for (int L = F.vcu; L < NE * 16; L += F.G) {
        const char* g = (const char*)args.in(37) + (size_t)L * (1 << 18) + wave * 1024 + lane * 16;
        for (int kb = 0; kb < 32; kb += 2) {
            __builtin_amdgcn_global_load_lds((const unsigned*)(g + (size_t)kb * 8192), dummy, 16, 0, 0);
            __builtin_amdgcn_global_load_lds((const unsigned*)(g + (size_t)(kb + 1) * 8192), dummy, 16, 0, 0);
            asm volatile("s_waitcnt vmcnt(12)" ::: "memory");
        } }
#elif PROBE_STREAM >= 5 && PROBE_STREAM <= 9
    if (wave < 4) {
    const int ltid = tid, kq = ltid >> 5, nq = ltid & 31;
    for (int L = F.vcu; L < NE * 8; L += F.G) { const int e = L >> 3, jt = L & 7;
        const float* base = (nq < 16 ? args.in(35) : args.in(36)) + (size_t)e * D * DFF + jt * 64 + (nq & 15) * 4 + (size_t)(8 * kq) * DFF;
        pg8::f32x4 s0[8], s1[8], s2[8]; pg8::f32x4 spc[8]; int spb = 0; (void)spc; (void)spb;
#define SP_LD(S, t_) { const float* bp = base + (size_t)((t_) < 32 ? (t_) : 31) * 64 * DFF; _Pragma("unroll") for (int r_ = 0; r_ < 8; ++r_) { SP_ONE(S[r_], bp + (size_t)r_ * DFF); } }
#if PROBE_STREAM == 5 || PROBE_STREAM >= 8
#define SP_ONE(v_, p_) asm volatile("global_load_dwordx4 %0, %1, off nt" : "=v"(v_) : "v"(p_) : "memory")
#elif PROBE_STREAM == 6
#define SP_ONE(v_, p_) asm volatile("global_load_dwordx4 %0, %1, off" : "=v"(v_) : "v"(p_) : "memory")
#else
#define SP_ONE(v_, p_) __builtin_amdgcn_global_load_lds((const unsigned*)(p_), dummy, 16, 0, 0)
#endif
#if PROBE_STREAM >= 9
#define SP_BAR { _Pragma("unroll") for (int c_ = 0; c_ < 4; ++c_) { u32x4 w_; w_.x = cvt_pk_bf16(spc[0][c_], spc[1][c_]); w_.y = cvt_pk_bf16(spc[2][c_], spc[3][c_]); \
    w_.z = cvt_pk_bf16(spc[4][c_], spc[5][c_]); w_.w = cvt_pk_bf16(spc[6][c_], spc[7][c_]); \
    *(LAS u32x4*)(F.lds + FG_BOFF + (spb & 1) * FG_BBUF + (4 * nq + c_) * 128 + ((kq ^ ((4 * nq + c_) & 7)) * 16)) = w_; } ++spb; \
    asm volatile("s_waitcnt lgkmcnt(0)" ::: "memory"); __builtin_amdgcn_s_barrier(); }
#elif PROBE_STREAM >= 8
#define SP_BAR __builtin_amdgcn_s_barrier();
#else
#define SP_BAR
#endif
#if PROBE_STREAM >= 9
#define SP_USE(S) { _Pragma("unroll") for (int r_ = 0; r_ < 8; ++r_) { asm volatile("" : "+v"(S[r_])); spc[r_] = S[r_]; } }
#else
#define SP_USE(S) { _Pragma("unroll") for (int r_ = 0; r_ < 8; ++r_) asm volatile("" :: "v"(S[r_])); }
#endif
        SP_LD(s0, 0) SP_LD(s1, 1)
        for (int t = 0; t < 33; t += 3) {
            SP_LD(s2, t + 2) asm volatile("s_waitcnt vmcnt(16)" ::: "memory"); SP_USE(s0) SP_BAR
            SP_LD(s0, t + 3) asm volatile("s_waitcnt vmcnt(16)" ::: "memory"); SP_USE(s1) SP_BAR
            SP_LD(s1, t + 4) asm volatile("s_waitcnt vmcnt(16)" ::: "memory"); SP_USE(s2) SP_BAR
        }
        asm volatile("s_waitcnt vmcnt(0)" ::: "memory"); SP_USE(s0) SP_USE(s1)
        }
    }
#if PROBE_STREAM >= 8
    else { for (int L = F.vcu; L < NE * 8; L += F.G) for (int t = 0; t < 33; ++t) __builtin_amdgcn_s_barrier(); }
#endif
#elif PROBE_STREAM == 10 || PROBE_STREAM == 11 || PROBE_STREAM == 12
    LAS unsigned char* lds = F.lds;
    const char* Ab = (const char*)(F.ws + WS_XN);
    constexpr int lda = D;
    if (wave < 4) {
        const int ltid = tid, kq = ltid >> 5, nq = ltid & 31;
#if PROBE_STREAM == 10 || PROBE_STREAM == 12
        unsigned rowoff[10];
#endif
        for (int L = F.vcu; L < NE * 8; L += F.G) { const int e = L >> 3, jt = L & 7;
#if PROBE_STREAM == 10 || PROBE_STREAM == 12
#pragma unroll
            for (int i = 0; i < 10; ++i) { const int row = i * 32 + wave * 8 + (lane >> 3); const unsigned rr = (unsigned)((e * 128 + row * 25) & 8191);
                rowoff[i] = (rr * (unsigned)lda + (unsigned)(((lane & 7) ^ ((lane >> 3) & 7)) * 8)) * 2u; }
#define SPA_DMA(t_) FG_DMA(((t_) % 3), ((t_) < 32 ? (t_) : 31));
#define SPA_N 10
#else
#define SPA_DMA(t_)
#define SPA_N 0
#endif
            const float* base = (nq < 16 ? args.in(35) : args.in(36)) + (size_t)e * D * DFF + jt * 64 + (nq & 15) * 4 + (size_t)(8 * kq) * DFF;
            f32x4 s0[8], s1[8], s2[8]; f32x4 spc[8]; int spb = 0;
#if PROBE_STREAM == 12
#define SQ_LD(S, t_) { _Pragma("unroll") for (int r_ = 0; r_ < 8; ++r_) S[r_] = (f32x4){0.f, 0.f, 0.f, 0.f}; }
#undef FG_WAITV
#define FG_WAITV(n) asm volatile("s_waitcnt vmcnt(10)" ::: "memory")
#else
#define SQ_LD(S, t_) { const float* bp = base + (size_t)((t_) < 32 ? (t_) : 31) * 64 * DFF; _Pragma("unroll") for (int r_ = 0; r_ < 8; ++r_) { asm volatile("global_load_dwordx4 %0, %1, off nt" : "=v"(S[r_]) : "v"(bp + (size_t)r_ * DFF) : "memory"); } }
#endif
#define SQ_USE(S) { _Pragma("unroll") for (int r_ = 0; r_ < 8; ++r_) { asm volatile("" : "+v"(S[r_])); spc[r_] = S[r_]; } }
#define SQ_BAR { _Pragma("unroll") for (int c_ = 0; c_ < 4; ++c_) { u32x4 w_; w_.x = cvt_pk_bf16(spc[0][c_], spc[1][c_]); w_.y = cvt_pk_bf16(spc[2][c_], spc[3][c_]); \
    w_.z = cvt_pk_bf16(spc[4][c_], spc[5][c_]); w_.w = cvt_pk_bf16(spc[6][c_], spc[7][c_]); \
    *(LAS u32x4*)(lds + FG_BOFF + (spb & 1) * FG_BBUF + (4 * nq + c_) * 128 + ((kq ^ ((4 * nq + c_) & 7)) * 16)) = w_; } ++spb; \
    asm volatile("s_waitcnt lgkmcnt(0)" ::: "memory"); __builtin_amdgcn_s_barrier(); }
            SPA_DMA(0) SQ_LD(s0, 0) SPA_DMA(1) SQ_LD(s1, 1)
            for (int t = 0; t < 33; t += 3) {
                SPA_DMA(t + 2) SQ_LD(s2, t + 2) FG_WAITV(16 + SPA_N); SQ_USE(s0) SQ_BAR
                SPA_DMA(t + 3) SQ_LD(s0, t + 3) FG_WAITV(16 + SPA_N); SQ_USE(s1) SQ_BAR
                SPA_DMA(t + 4) SQ_LD(s1, t + 4) FG_WAITV(16 + SPA_N); SQ_USE(s2) SQ_BAR
            }
            asm volatile("s_waitcnt vmcnt(0)" ::: "memory"); SQ_USE(s0) SQ_USE(s1)
        }
    } else {
#if PROBE_STREAM == 11
        const int wave_hi = wave;
        { const int wave = wave_hi - 4; unsigned rowoff[10];
        for (int L = F.vcu; L < NE * 8; L += F.G) { const int e = L >> 3;
#pragma unroll
            for (int i = 0; i < 10; ++i) { const int row = i * 32 + wave * 8 + (lane >> 3); const unsigned rr = (unsigned)((e * 128 + row * 25) & 8191);
                rowoff[i] = (rr * (unsigned)lda + (unsigned)(((lane & 7) ^ ((lane >> 3) & 7)) * 8)) * 2u; }
            FG_DMA(0, 0); FG_DMA(1, 1);
            for (int t = 0; t < 33; ++t) { FG_DMA(((t + 2) % 3), ((t + 2) < 32 ? (t + 2) : 31)); FG_WAITV(10); __builtin_amdgcn_s_barrier(); }
            asm volatile("s_waitcnt vmcnt(0)" ::: "memory");
        } }
#else
        for (int L = F.vcu; L < NE * 8; L += F.G) for (int t = 0; t < 33; ++t) __builtin_amdgcn_s_barrier();
#endif
    }
#endif
    asm volatile("s_waitcnt vmcnt(0)" ::: "memory");
    __syncthreads();
}
#endif

__global__ void __launch_bounds__(NTHR, 2) mk_fwd(Args args_by_value) {
    (void)args_by_value;
    AV args; args.kp = (kptr_t)__builtin_amdgcn_kernarg_segment_ptr();
    extern __shared__ __attribute__((aligned(16))) unsigned char lds[];
    Frame F;
    F.lds = (LAS unsigned char*)lds;
    F.MISC = (volatile LAS unsigned*)(F.lds + MISC_OFF);
    F.tid = threadIdx.x; F.lane = F.tid & 63; F.wave = __builtin_amdgcn_readfirstlane(F.tid >> 6);
    F.G = gridDim.x; { const int bx = blockIdx.x; F.vcu = (F.G % 8 == 0) ? (bx % 8) * (F.G / 8) + bx / 8 : bx; }
    F.ws = args.ws(); F.ctl = (gu32*)(F.ws + WS_CTL);
    for (int u = F.tid; u < (LDS_BYTES - MISC_OFF) / 4; u += NTHR) ((LAS unsigned*)(F.lds + MISC_OFF))[u] = 0u;
    __syncthreads();
    XcdBarrier bar = xcd_barrier_post((unsigned*)(F.ctl + CW_BAR), F.MISC + 8);
    const int lo = args.ph_lo(), hi = args.ph_hi();
#ifndef PROBE_MASK
#define PROBE_MASK 0
#define PROBE_EXTRA 0
#endif
#ifndef PROBE_MODE
#define PROBE_MODE 0
#endif
#define IN(k) (lo <= (k) && (k) < hi)
#define BOTH(k) (IN(k) && IN((k) + 1))
#define GRID_BAR() xcd_barrier(bar)
    unsigned char* ws = F.ws;
    if (IN(0)) for (int rep_ = 0; rep_ < (((PROBE_MASK >> 0) & 1) ? 1 + PROBE_EXTRA : 1); ++rep_) { F.tid = mk_otid(); F.lane = F.tid & 63; p0_prologue(F, args, (rep_ < (((PROBE_MASK >> 0) & 1) ? PROBE_EXTRA : 0)) ? PROBE_MODE : 7); } if (BOTH(0)) GRID_BAR();
    if (IN(1)) for (int rep_ = 0; rep_ < (((PROBE_MASK >> 1) & 1) ? 1 + PROBE_EXTRA : 1); ++rep_) { F.tid = mk_otid(); F.lane = F.tid & 63;
        pg8::Gemm g{D, D, D}; PlainSched S; S.init((const bf16_t*)(ws + WS_XN), D, (const bf16_t*)(ws + WS_W1T), D, T, DIN, F.G, (int)blockIdx.x);
        EpiG1 E{(bf16_t*)(ws + WS_QH), (bf16_t*)(ws + WS_KH), (bf16_t*)(ws + WS_VH), (bf16_t*)(ws + WS_U), args.in(4), args.in(5), (LAS float*)(F.lds + EPI_TBL)};
        pg8::gemm_phase<EpiG1, PlainSched>(F.lds + RING_OFF, g, S, E);
    } if (BOTH(1)) GRID_BAR();
#ifdef PROBE_XBAR
    for (int xb_ = 0; xb_ < PROBE_XBAR; ++xb_) GRID_BAR();
#endif
    if (IN(2)) for (int rep_ = 0; rep_ < (((PROBE_MASK >> 2) & 1) ? 1 + PROBE_EXTRA : 1); ++rep_) { F.tid = mk_otid(); F.lane = F.tid & 63; if (rep_ == 0 || PROBE_MODE != 9) p2_attention(F, (char*)lds + RING_OFF);
        if (rep_ == 0 || PROBE_MODE != 8) for (int L = F.vcu; L < NB * NG; L += F.G) ssm_unit(F, L & 3, L >> 2);
        if (rep_ == 0) mid_weight_copies(F, args, F.vcu * NWAVES + F.wave, F.G * NWAVES);
        } if (BOTH(2)) GRID_BAR();
    if (IN(3)) for (int rep_ = 0; rep_ < (((PROBE_MASK >> 3) & 1) ? 1 + PROBE_EXTRA : 1); ++rep_) { F.tid = mk_otid(); F.lane = F.tid & 63;
        p3_combine(F, args.in(10), F.vcu * NWAVES + F.wave, F.G * NWAVES);
        float* ssq = (float*)(ws + WS_SSQ); const int G = F.G, bx = (int)blockIdx.x;
        if (rep_ == 0) late_weight_copies(F, args, F.vcu * NWAVES + F.wave, G * NWAVES);
        { pg8::Gemm g{DSSM, DSSM, DSSM}; PlainSched S; S.init((const bf16_t*)(ws + WS_YG), DSSM, (const bf16_t*)(ws + WS_WGLU), DSSM, T, DSSM, G, bx);
          EpiGlu E{(const bf16_t*)(ws + WS_YG), args.in(20), (bf16_t*)(ws + WS_CAT), ssq + SQ_S};
          pg8::gemm_phase<EpiGlu, PlainSched>(F.lds + RING_OFF, g, S, E); }
        { pg8::Gemm g{1024, D, D}; SchedKV S{G, (bx + G - (128 % G)) % G, (const char*)(ws + WS_MN), (const char*)(ws + WS_WXK), (const char*)(ws + WS_WXV)};
          EpiF32Slab E{(float*)(ws + WS_QX)};
          pg8::gemm_phase<EpiF32Slab, SchedKV>(F.lds + RING_OFF, g, S, E); }
        } if (BOTH(3)) GRID_BAR();
    if (IN(4)) for (int rep_ = 0; rep_ < (((PROBE_MASK >> 4) & 1) ? 1 + PROBE_EXTRA : 1); ++rep_) { F.tid = mk_otid(); F.lane = F.tid & 63;
        if (rep_ == (((PROBE_MASK >> 4) & 1) ? PROBE_EXTRA : 0)) kv_finish(F, args.in(27), args.in(28), F.vcu * NWAVES + F.wave, F.G * NWAVES);
        float* ssq = (float*)(ws + WS_SSQ);
        pg8::Gemm g{D, D, D}; PlainSched S; S.init((const bf16_t*)(ws + WS_CAT), D, (const bf16_t*)(ws + WS_WOUT), D, T, D, F.G, (int)blockIdx.x);
        EpiOut E{args.in(0), (float*)(ws + WS_H1), (bf16_t*)(ws + WS_XN), ssq + SQ_S, ssq + SQ_H1, (LAS float*)(F.lds + RTAB_OFF), (LAS float*)(F.lds + EPI_TBL)};
        pg8::gemm_phase<EpiOut, PlainSched>(F.lds + RING_OFF, g, S, E);
        } if (BOTH(4)) GRID_BAR();

    if (IN(5)) for (int rep_ = 0; rep_ < (((PROBE_MASK >> 5) & 1) ? 1 + PROBE_EXTRA : 1); ++rep_) { F.tid = mk_otid(); F.lane = F.tid & 63;
        float* ssq = (float*)(ws + WS_SSQ);
        pg8::Gemm g{D, D, D}; PlainSched S; S.init((const bf16_t*)(ws + WS_XN), D, (const bf16_t*)(ws + WS_WXQ), D, T, D, F.G, (int)blockIdx.x);
        typedef EpiGen<1, 32, false, 0, false, true, 1> E5;
        E5 E{ssq + SQ_H1, 1.f / 2048.f, nullptr, nullptr, (bf16_t*)(ws + WS_QX), D, ssq + SQ_QX, (LAS float*)(F.lds + RTAB_OFF), (LAS float*)(F.lds + EPI_TBL), nullptr};
        struct S5 { PlainSched s; __device__ __forceinline__ bool next(int i, pg8::Unit& u) const { if (!s.next(i, u)) return false; u.aux1 = u.pn * 4; return true; } } S5v{S};
        pg8::gemm_phase<E5, S5>(F.lds + RING_OFF, g, S5v, E);
        } if (BOTH(5)) GRID_BAR();
    if (IN(6)) for (int rep_ = 0; rep_ < (((PROBE_MASK >> 6) & 1) ? 1 + PROBE_EXTRA : 1); ++rep_) { F.tid = mk_otid(); F.lane = F.tid & 63;
        float* ssq = (float*)(ws + WS_SSQ);
        pg8::Gemm g{512, D, D}; SchedSV S{F.G, F.vcu, (const char*)(ws + WS_QX), (const char*)(ws + WS_KX), (const char*)(ws + WS_WXO), (const char*)(ws + WS_VXT)};
        EpiSV E{ssq + SQ_QX, (bf16_t*)(ws + WS_PX), (bf16_t*)(ws + WS_OX), (LAS float*)(F.lds + RTAB_OFF), (LAS float*)(F.lds + EPI_TBL + 4096), (LAS float*)(F.lds + EPI_TBL)};
        pg8::gemm_phase<EpiSV, SchedSV>(F.lds + RING_OFF, g, S, E);
        } if (BOTH(6)) GRID_BAR();
    if (IN(8)) for (int rep_ = 0; rep_ < (((PROBE_MASK >> 8) & 1) ? 1 + PROBE_EXTRA : 1); ++rep_) { F.tid = mk_otid(); F.lane = F.tid & 63;
        float* ssq = (float*)(ws + WS_SSQ);
        pg8::Gemm g{1024, 1024, 1024}; SchedPVW S; S.o.init(T / 256, D / 256, F.G, (int)blockIdx.x); S.A = (const char*)(ws + WS_PX); S.B = (const char*)(ws + WS_OX);
        typedef EpiGen<0, 4, false, 2, false, true, 1> E8;
        E8 E{nullptr, 0.f, nullptr, nullptr, (bf16_t*)(ws + WS_H1), D, ssq + SQ_H2, (LAS float*)(F.lds + RTAB_OFF), (LAS float*)(F.lds + EPI_TBL), (const bf16_t*)(ws + WS_XN)};
        pg8::gemm_phase<E8, SchedPVW>(F.lds + RING_OFF, g, S, E);
        } if (BOTH(8)) GRID_BAR();
    if (IN(9)) for (int rep_ = 0; rep_ < (((PROBE_MASK >> 9) & 1) ? 1 + PROBE_EXTRA : 1); ++rep_) { F.tid = mk_otid(); F.lane = F.tid & 63; p9_router(F, args, rep_ == (((PROBE_MASK >> 9) & 1) ? PROBE_EXTRA : 0)); } if (BOTH(9)) GRID_BAR();
    if (IN(11)) for (int rep_ = 0; rep_ < (((PROBE_MASK >> 11) & 1) ? 1 + PROBE_EXTRA : 1); ++rep_) { F.tid = mk_otid(); F.lane = F.tid & 63;
        moe_tables(F);
        { const int nv_ = (NE * 8 - F.vcu + F.G - 1) / F.G;
          if (!(rep_ < (((PROBE_MASK >> 11) & 1) ? PROBE_EXTRA : 0) && PROBE_MODE != 0) && FG_STREAM && (int)F.MISC[MT_MAX] <= FG_ROWS && nv_ <= 2 && FG_PASS == FG_ROWS) fg_stream<true>(F, args, nv_); else
        for (int L = F.vcu; L < NE * 8; L += F.G) { const int e = L >> 3, jt = L & 7; const int row0 = (int)F.MISC[MT_START + e], n = (int)F.MISC[MT_CNT + e];
            const unsigned short* tokl = (const unsigned short*)(ws + WS_MOE + MOE_TOK) + (size_t)e * T;
            if (rep_ < (((PROBE_MASK >> 11) & 1) ? PROBE_EXTRA : 0)) fg_unit<true, PROBE_MODE>(F, (const bf16_t*)(ws + WS_XN), D, D, n, args.in(35) + (size_t)e * D * DFF + jt * 64, args.in(36) + (size_t)e * D * DFF + jt * 64, DFF,
                          (bf16_t*)(ws + WS_ACT) + (size_t)row0 * DFF + jt * 64, DFF, nullptr, tokl);
            else fg_unit<true>(F, (const bf16_t*)(ws + WS_XN), D, D, n, args.in(35) + (size_t)e * D * DFF + jt * 64, args.in(36) + (size_t)e * D * DFF + jt * 64, DFF,
                          (bf16_t*)(ws + WS_ACT) + (size_t)row0 * DFF + jt * 64, DFF, nullptr, tokl); } }
        } if (BOTH(11)) GRID_BAR();
    if (IN(12)) for (int rep_ = 0; rep_ < (((PROBE_MASK >> 12) & 1) ? 1 + PROBE_EXTRA : 1); ++rep_) { F.tid = mk_otid(); F.lane = F.tid & 63;
        moe_tables(F);
        { const int nv_ = (NE * 16 - F.vcu + F.G - 1) / F.G;
          if (!(rep_ < (((PROBE_MASK >> 12) & 1) ? PROBE_EXTRA : 0) && PROBE_MODE != 0) && FG_STREAM && (int)F.MISC[MT_MAX] <= FG_ROWS && FG_PASS == FG_ROWS) fg_stream<false>(F, args, nv_); else
        for (int L = F.vcu; L < NE * 16; L += F.G) { const int e = L >> 4, nt = L & 15; const int row0 = (int)F.MISC[MT_START + e], n = (int)F.MISC[MT_CNT + e];
            if (rep_ < (((PROBE_MASK >> 12) & 1) ? PROBE_EXTRA : 0)) fg_unit<false, PROBE_MODE>(F, (const bf16_t*)(ws + WS_ACT) + (size_t)row0 * DFF, DFF, DFF, n, args.in(37) + (size_t)e * DFF * D + nt * 128, nullptr, D,
                           (bf16_t*)(ws + WS_YS) + (size_t)row0 * D + nt * 128, D, (const float*)(ws + WS_MOE + MOE_RWL) + (size_t)e * T);
            else fg_unit<false>(F, (const bf16_t*)(ws + WS_ACT) + (size_t)row0 * DFF, DFF, DFF, n, args.in(37) + (size_t)e * DFF * D + nt * 128, nullptr, D,
                           (bf16_t*)(ws + WS_YS) + (size_t)row0 * D + nt * 128, D, (const float*)(ws + WS_MOE + MOE_RWL) + (size_t)e * T); } }
        } if (BOTH(12)) GRID_BAR();
    if (IN(13)) for (int rep_ = 0; rep_ < (((PROBE_MASK >> 13) & 1) ? 1 + PROBE_EXTRA : 1); ++rep_) { F.tid = mk_otid(); F.lane = F.tid & 63; p13_combine(F, args, rep_ == (((PROBE_MASK >> 13) & 1) ? PROBE_EXTRA : 0)); }
#ifdef PROBE_STREAM
    GRID_BAR();
    for (int rep_ = 0; rep_ < PROBE_EXTRA; ++rep_) { stream_probe(F, args); }
#endif
#undef IN
#undef BOTH
}
}

extern "C" void kernel_launch(void* const* d_in, const int* in_sizes, int n_in, void* d_out, int out_size, void* d_ws, size_t ws_size, hipStream_t stream) {
    static int grid = 0;
    if (grid == 0) {
        if (n_in != 38 || out_size != mk::T * mk::D || ws_size < mk::WS_END) { fprintf(stderr, "kernel_launch: unexpected shapes (n_in %d, out %d, ws %zu)\n", n_in, out_size, ws_size); grid = -1; return; }
        int dev = 0, cus = 0; (void)hipGetDevice(&dev); (void)hipDeviceGetAttribute(&cus, hipDeviceAttributeMultiprocessorCount, dev);
        (void)hipFuncSetAttribute((const void*)mk::mk_fwd, hipFuncAttributeMaxDynamicSharedMemorySize, mk::LDS_BYTES);
        int per_cu = 0; (void)hipOccupancyMaxActiveBlocksPerMultiprocessor(&per_cu, (const void*)mk::mk_fwd, mk::NTHR, mk::LDS_BYTES);
        (void)hipGetLastError();
        grid = cus > 0 ? cus : 256;
        if (per_cu < 1) { fprintf(stderr, "kernel_launch: occupancy query reports %d blocks per CU; nothing launched\n", per_cu); grid = -1; return; }
    }
    if (grid < 0) return;
    (void)hipMemsetAsync((char*)d_ws + mk::WS_CTL, 0, mk::CTL_ZERO_BYTES, stream);
    mk::Args a{}; for (int i = 0; i < 38; ++i) a.in[i] = (const float*)d_in[i]; a.out = (float*)d_out; a.ws = (unsigned char*)d_ws; a.ph_lo = 0; a.ph_hi = 14;
    hipLaunchKernelGGL(mk::mk_fwd, dim3(grid), dim3(mk::NTHR), mk::LDS_BYTES, stream, a);
}
```

```cpp
#include <hip/hip_runtime.h>
#include <hip/hip_bf16.h>
#include <cstdio>
#include <cstdint>
#include <cstddef>
#include <cmath>
__device__ __forceinline__ int mk_otid() { int t = threadIdx.x; asm volatile("" : "+v"(t)); return t; }

namespace pg8 {
#define PG8_LAS __attribute__((address_space(3)))
typedef unsigned short bf16_t;
typedef short bf16x8 __attribute__((ext_vector_type(8)));
typedef float f32x4 __attribute__((ext_vector_type(4)));
typedef float f32x2 __attribute__((ext_vector_type(2)));
typedef unsigned u32x4 __attribute__((ext_vector_type(4)));
typedef unsigned u32x2 __attribute__((ext_vector_type(2)));
constexpr int BM = 256, BK = 64, HALF = 128, HTB = HALF * BK * 2, STAGE_BYTES = 8 * HTB;

__host__ __device__ __forceinline__ int lds_byte(int r, int c) { const int st = (r >> 4) * 2 + (c >> 5), rr = r & 15, cc = c & 31, ob = rr * 64 + cc * 2; return st * 1024 + (ob ^ (((ob >> 9) & 1) << 5)); }
__host__ __device__ __forceinline__ void stage_rc(int b, int& R, int& C) { const int st = b / 1024, sb = b % 1024, swz = sb ^ (((sb >> 9) & 1) << 5); R = (st >> 1) * 16 + swz / 64; C = (st & 1) * 32 + (swz % 64) / 2; }
__host__ __device__ __forceinline__ int perm32(int rho) { const int n = rho >> 4, i = rho & 15; return 8 * (i >> 2) + 4 * n + (i & 3); }

struct Unit { const char* A; const char* B; int pm, pn, aux0, aux1; };
struct Gemm { int K, lda, ldb; };

__device__ __forceinline__ unsigned cvt_pk_bf16(float lo, float hi) { unsigned r; asm volatile("v_cvt_pk_bf16_f32 %0, %1, %2" : "=v"(r) : "v"(lo), "v"(hi)); return r; }
__device__ __forceinline__ float bf_lo(unsigned w) { return __uint_as_float(w << 16); }
__device__ __forceinline__ float bf_hi(unsigned w) { return __uint_as_float(w & 0xffff0000u); }

template <class Epi, class Sched, bool SP2 = true>
__device__ __forceinline__ void gemm_phase(PG8_LAS unsigned char* lds, const Gemm g, const Sched& S, const Epi& E) {
    const int tid = mk_otid(), wid = __builtin_amdgcn_readfirstlane(tid >> 6), lane = tid & 63, wr = wid >> 2, wc = wid & 3, fr = lane & 15, fq = lane >> 4;
    const int K = g.K, nt = K / BK;
    unsigned voffA[2], voffB[2];
#pragma unroll
    for (int i = 0; i < 2; ++i) { int R, C; stage_rc(tid * 16 + i * 8192, R, C); const int Rb = Epi::PERM ? ((R & ~31) + perm32(R & 31)) : R;
        voffA[i] = (unsigned)(R * g.lda + C) * 2u; voffB[i] = (unsigned)(Rb * g.ldb + C) * 2u; }
    const size_t kstep = (size_t)(BK * 2);
    const size_t hstepA = (size_t)HALF * g.lda * 2, hstepB = (size_t)HALF * g.ldb * 2;
    const unsigned ldsw = (unsigned)wid * 1024u;
    const int aoff = lds_byte(wr * 64 + fr, fq * 8), boff = lds_byte(wc * 32 + fr, fq * 8);
#define PG8_SA(b, h) (((b) * 2 + (h)) * HTB)
#define PG8_SB(b, h) ((4 + (b) * 2 + (h)) * HTB)
#define PG8_STAGE(bufoff, gbase, voff) do { _Pragma("unroll") for (int _i = 0; _i < 2; ++_i) \
        __builtin_amdgcn_global_load_lds((const unsigned*)((const char*)(gbase) + (voff)[_i]), (PG8_LAS unsigned*)(lds + (bufoff) + ldsw + _i * 8192), 16, 0, 0); } while (0)
#define PG8_LDA(dst, b, h) do { _Pragma("unroll") for (int m = 0; m < 4; ++m) _Pragma("unroll") for (int k = 0; k < 2; ++k) dst[m][k] = *(const PG8_LAS bf16x8*)(lds + PG8_SA(b, h) + aoff + m * 2048 + k * 1024); } while (0)
#define PG8_LDB(dst, b, h) do { _Pragma("unroll") for (int n = 0; n < 2; ++n) _Pragma("unroll") for (int k = 0; k < 2; ++k) dst[n][k] = *(const PG8_LAS bf16x8*)(lds + PG8_SB(b, h) + boff + n * 2048 + k * 1024); } while (0)
#define PG8_MMA(ai, bj, At, Bt) do { __builtin_amdgcn_s_setprio(1); _Pragma("unroll") for (int m = 0; m < 4; ++m) _Pragma("unroll") for (int n = 0; n < 2; ++n) _Pragma("unroll") for (int k = 0; k < 2; ++k) \
        acc[ai][bj][m][n] = __builtin_amdgcn_mfma_f32_16x16x32_bf16(Bt[n][k], At[m][k], acc[ai][bj][m][n], 0, 0, 0); __builtin_amdgcn_s_setprio(0); } while (0)
#define PG8_WAIT_V(n) asm volatile("s_waitcnt vmcnt(" #n ")" ::: "memory")
#define PG8_WAIT_L(n) asm volatile("s_waitcnt lgkmcnt(" #n ")" ::: "memory")
#define PG8_BAR __builtin_amdgcn_s_barrier()
#define PG8_SCHED __builtin_amdgcn_sched_barrier(0)
    Unit cur, nxt; int ui = 0;
    if (!S.next(0, cur)) return;
    f32x4 acc[2][2][4][2];
#pragma unroll
    for (int a = 0; a < 2; ++a)
#pragma unroll
        for (int b = 0; b < 2; ++b)
#pragma unroll
            for (int m = 0; m < 4; ++m)
#pragma unroll
                for (int n = 0; n < 2; ++n) acc[a][b][m][n] = (f32x4){0.f, 0.f, 0.f, 0.f};
    bf16x8 At[4][2], B0[2][2], B1[2][2];
    const char* cA = cur.A; const char* cB = cur.B;
    E.prep(cur);
    if constexpr (SP2) {
        PG8_STAGE(PG8_SB(0, 0), cB, voffB); PG8_STAGE(PG8_SB(0, 1), cB + hstepB, voffB); PG8_STAGE(PG8_SA(0, 0), cA, voffA); PG8_STAGE(PG8_SA(0, 1), cA + hstepA, voffA);
        if (wr == 1) PG8_BAR;
        PG8_WAIT_V(2); PG8_BAR;
        PG8_STAGE(PG8_SB(1, 0), cB + kstep, voffB); PG8_STAGE(PG8_SA(1, 0), cA + kstep, voffA); PG8_STAGE(PG8_SB(1, 1), cB + hstepB + kstep, voffB);
        PG8_WAIT_V(6); PG8_BAR;
    } else {
        PG8_STAGE(PG8_SB(0, 0), cB, voffB); PG8_STAGE(PG8_SA(0, 0), cA, voffA); PG8_STAGE(PG8_SB(0, 1), cB + hstepB, voffB); PG8_STAGE(PG8_SA(0, 1), cA + hstepA, voffA);
        if (wr == 1) PG8_BAR;
        PG8_WAIT_V(4); PG8_BAR;
        PG8_STAGE(PG8_SB(1, 0), cB + kstep, voffB); PG8_STAGE(PG8_SA(1, 0), cA + kstep, voffA); PG8_STAGE(PG8_SB(1, 1), cB + hstepB + kstep, voffB);
        PG8_WAIT_V(6); PG8_BAR;
    }
    for (;;) {
        const bool has_next = S.next(ui + 1, nxt);
        const char* nA = has_next ? nxt.A : cA; const char* nB = has_next ? nxt.B : cB;
        for (int t = 0; t < nt; t += 2) {
            const bool last = (t == nt - 2);
            const char* a1 = cA + (size_t)(t + 1) * kstep;
            const char* a2 = last ? nA : cA + (size_t)(t + 2) * kstep; const char* b2 = last ? nB : cB + (size_t)(t + 2) * kstep;
            const char* a3 = a2 + kstep; const char* b3 = b2 + kstep;
            if constexpr (Epi::MIDT >= 0) { if (t == Epi::MIDT) { int fr_ = fr, fq_ = fq; asm volatile("" : "+v"(fr_), "+v"(fq_)); E.mid(acc, cur, wr, wc, fr_, fq_); } }
            if constexpr (SP2) {
            PG8_LDB(B0, 0, 0); PG8_LDB(B1, 0, 1); PG8_SCHED; PG8_LDA(At, 0, 0); PG8_STAGE(PG8_SA(1, 1), a1 + hstepA, voffA);
            PG8_WAIT_V(8); PG8_WAIT_L(0); PG8_BAR; PG8_MMA(0, 0, At, B0); PG8_MMA(0, 1, At, B1); PG8_BAR; PG8_SCHED;
            PG8_LDA(At, 0, 1); PG8_STAGE(PG8_SB(0, 0), b2, voffB); PG8_STAGE(PG8_SB(0, 1), b2 + hstepB, voffB); PG8_STAGE(PG8_SA(0, 0), a2, voffA);
            PG8_WAIT_V(8); PG8_WAIT_L(0); PG8_BAR; PG8_MMA(1, 0, At, B0); PG8_MMA(1, 1, At, B1); PG8_BAR; PG8_SCHED;
            PG8_LDB(B0, 1, 0); PG8_LDB(B1, 1, 1); PG8_SCHED; PG8_LDA(At, 1, 0); PG8_STAGE(PG8_SA(0, 1), a2 + hstepA, voffA);
            PG8_WAIT_V(8); PG8_WAIT_L(0); PG8_BAR; PG8_MMA(0, 0, At, B0); PG8_MMA(0, 1, At, B1); PG8_BAR; PG8_SCHED;
            PG8_LDA(At, 1, 1); PG8_STAGE(PG8_SB(1, 0), b3, voffB); PG8_STAGE(PG8_SB(1, 1), b3 + hstepB, voffB); PG8_STAGE(PG8_SA(1, 0), a3, voffA);
            PG8_WAIT_V(8); PG8_WAIT_L(0); PG8_BAR; PG8_MMA(1, 0, At, B0); PG8_MMA(1, 1, At, B1); PG8_BAR; PG8_SCHED;
            } else {
            PG8_LDB(B0, 0, 0); PG8_SCHED; PG8_LDA(At, 0, 0); PG8_STAGE(PG8_SA(1, 1), a1 + hstepA, voffA);
            PG8_WAIT_L(8); PG8_BAR; PG8_WAIT_L(0); PG8_MMA(0, 0, At, B0); PG8_BAR; PG8_SCHED;
            PG8_LDB(B1, 0, 1); PG8_STAGE(PG8_SB(0, 0), b2, voffB);
            PG8_BAR; PG8_WAIT_L(0); PG8_MMA(0, 1, At, B1); PG8_BAR;
            PG8_LDA(At, 0, 1); PG8_STAGE(PG8_SA(0, 0), a2, voffA);
            PG8_BAR; PG8_WAIT_L(0); PG8_MMA(1, 0, At, B0); PG8_BAR; PG8_SCHED;
            PG8_STAGE(PG8_SB(0, 1), b2 + hstepB, voffB);
            PG8_WAIT_V(6); PG8_BAR; PG8_MMA(1, 1, At, B1); PG8_BAR;
            PG8_LDB(B0, 1, 0); PG8_SCHED; PG8_LDA(At, 1, 0); PG8_STAGE(PG8_SA(0, 1), a2 + hstepA, voffA);
            PG8_WAIT_L(8); PG8_BAR; PG8_WAIT_L(0); PG8_MMA(0, 0, At, B0); PG8_BAR; PG8_SCHED;
            PG8_LDB(B1, 1, 1); PG8_STAGE(PG8_SB(1, 0), b3, voffB);
            PG8_BAR; PG8_WAIT_L(0); PG8_MMA(0, 1, At, B1); PG8_BAR;
            PG8_LDA(At, 1, 1); PG8_STAGE(PG8_SA(1, 0), a3, voffA);
            PG8_BAR; PG8_WAIT_L(0); PG8_MMA(1, 0, At, B0); PG8_BAR; PG8_SCHED;
            PG8_STAGE(PG8_SB(1, 1), b3 + hstepB, voffB);
            PG8_WAIT_V(6); PG8_BAR; PG8_MMA(1, 1, At, B1); PG8_BAR;
            }
        }
        if (wr == 0) PG8_BAR;
        { int fr_ = fr, fq_ = fq; asm volatile("" : "+v"(fr_), "+v"(fq_));
          E(acc, cur, wr, wc, fr_, fq_); }
        if (!has_next) break;
        E.prep(nxt);
#pragma unroll
        for (int a = 0; a < 2; ++a)
#pragma unroll
            for (int b = 0; b < 2; ++b)
#pragma unroll
                for (int m = 0; m < 4; ++m)
#pragma unroll
                    for (int n = 0; n < 2; ++n) acc[a][b][m][n] = (f32x4){0.f, 0.f, 0.f, 0.f};
        cur = nxt; cA = nA; cB = nB; ++ui;
        if (wr == 1) PG8_BAR;
    }
    PG8_WAIT_V(0);
    PG8_BAR;
#undef PG8_SA
#undef PG8_SB
#undef PG8_STAGE
#undef PG8_LDA
#undef PG8_LDB
#undef PG8_MMA
#undef PG8_WAIT_V
#undef PG8_WAIT_L
#undef PG8_SCHED
}
}

namespace attn {
constexpr int D = 128;
constexpr float THR = 8.f;
constexpr bool WSKIP = false;
constexpr float SCALE = 0.08838834764831845f;
constexpr int NW = 8, QBLK = 32, KVBLK = 64, QB = NW * QBLK;
constexpr int SHM_V = KVBLK * D * 2, SHM_K = KVBLK * D * 2;
constexpr int LDS_BYTES = 2 * SHM_V + 2 * SHM_K + NW * 64 * 4;

using bf16 = __hip_bfloat16;
typedef short bf16x8 __attribute__((ext_vector_type(8)));
typedef short s16x4 __attribute__((ext_vector_type(4)));
typedef float f32x16 __attribute__((ext_vector_type(16)));
typedef float f32x4 __attribute__((ext_vector_type(4)));
typedef unsigned u32x4 __attribute__((ext_vector_type(4)));
template <class A, class Bt> struct same_t { static constexpr bool v = false; };
template <class A> struct same_t<A, A> { static constexpr bool v = true; };

#define KSWZ(row, colB) ((row) * 256 + ((colB) ^ (((row) & 7) << 4)))
#define SBAR() __builtin_amdgcn_sched_barrier(0)
__device__ __forceinline__ int v_st(int k, int c) { const int kk = (k & ~0xC) | ((k & 4) << 1) | ((k & 8) >> 1); return ((kk >> 3) * 4 + (c >> 5)) * 512 + ((kk & 7) * 32 + (c & 31)) * 2; }
__device__ __forceinline__ int v_rd_base(int lane) { return ((lane & 3) << 3) | (((lane >> 2) & 3) << 6) | (((lane >> 4) & 1) << 5) | (((lane >> 5) & 1) << 8); }
constexpr int v_rd_off(int d0, int ks, int half) { return d0 * 512 + ks * 4096 + half * 2048; }
__device__ __forceinline__ int crow(int r, int hi) { return (r & 3) + 8 * (r >> 2) + 4 * hi; }
__device__ __forceinline__ unsigned cvtpk(float lo, float hi) {
    unsigned r; asm volatile("v_cvt_pk_bf16_f32 %0, %1, %2" : "=v"(r) : "v"(lo), "v"(hi)); return r;
}
__device__ __forceinline__ bf16x8 pack8(f32x4 a, f32x4 b) {
    u32x4 w = {cvtpk(a[0], a[1]), cvtpk(a[2], a[3]), cvtpk(b[0], b[1]), cvtpk(b[2], b[3])};
    return *reinterpret_cast<bf16x8*>(&w);
}
template <class T> __device__ __forceinline__ bf16x8 load8(const T* p) {
    if constexpr (same_t<T, float>::v) { return pack8(*(const f32x4*)p, *(const f32x4*)(p + 4)); }
    else { return *reinterpret_cast<const bf16x8*>(p); }
}
__device__ __forceinline__ void mask_tile(f32x16& p0, f32x16& p1, int dq, unsigned W) {
    const float NEG = -__builtin_inff();
#pragma unroll
    for (int r = 0; r < 16; ++r) {
        const int c = (r & 3) + 8 * (r >> 2);
        if ((unsigned)(dq - c) >= W) p0[r] = NEG;
        if ((unsigned)(dq - c - 32) >= W) p1[r] = NEG;
    }
}
__device__ __forceinline__ void partialSM(f32x16& p0, f32x16& p1, float& m_reg, float& mn, float& alpha) {
    float pmax = p0[0]; for (int r = 1; r < 16; ++r) pmax = fmaxf(pmax, p0[r]); for (int r = 0; r < 16; ++r) pmax = fmaxf(pmax, p1[r]);
    { auto rr = __builtin_amdgcn_permlane32_swap(__float_as_uint(pmax), __float_as_uint(pmax), false, false);
      pmax = fmaxf(__uint_as_float(rr[0]), __uint_as_float(rr[1])); }
    constexpr float C2 = 1.4426950408889634f * SCALE;
    if (__builtin_expect(__all((pmax - m_reg) * SCALE <= THR), 1)) { mn = m_reg; alpha = 1.f; }
    else { mn = fmaxf(m_reg, pmax); alpha = __builtin_amdgcn_exp2f((m_reg - mn) * C2); m_reg = mn; }
    const float mnL = -mn * C2;
    for (int r = 0; r < 16; ++r) p0[r] = fmaf(p0[r], C2, mnL); for (int r = 0; r < 16; ++r) p1[r] = fmaf(p1[r], C2, mnL);
    for (int r = 0; r < 16; ++r) p0[r] = __builtin_amdgcn_exp2f(p0[r]);
}
__device__ __forceinline__ void finishSM(f32x16& p0, f32x16& p1, float alpha, float& l_reg, bf16x8& pa0, bf16x8& pa1, bf16x8& pa2, bf16x8& pa3) {
    for (int r = 0; r < 16; ++r) p1[r] = __builtin_amdgcn_exp2f(p1[r]);
    float ps = 0; for (int r = 0; r < 16; ++r) ps += p0[r]; for (int r = 0; r < 16; ++r) ps += p1[r];
    { auto rr = __builtin_amdgcn_permlane32_swap(__float_as_uint(ps), __float_as_uint(ps), false, false);
      ps = __uint_as_float(rr[0]) + __uint_as_float(rr[1]); }
    l_reg = l_reg * alpha + ps;
#define PK4(P, B_, OUT) do { unsigned a0 = cvtpk(P[B_+0], P[B_+1]), a1 = cvtpk(P[B_+2], P[B_+3]);                          \
        unsigned b0 = cvtpk(P[B_+4], P[B_+5]), b1 = cvtpk(P[B_+6], P[B_+7]);                                             \
        auto r0 = __builtin_amdgcn_permlane32_swap(a0, b0, false, false); auto r1 = __builtin_amdgcn_permlane32_swap(a1, b1, false, false); \
        u32x4 w = {r0[0], r1[0], r0[1], r1[1]}; OUT = *reinterpret_cast<bf16x8*>(&w); } while (0)
    PK4(p0, 0, pa0); PK4(p0, 8, pa1); PK4(p1, 0, pa2); PK4(p1, 8, pa3);
#undef PK4
}
template <int KB, bool SK>
__device__ __forceinline__ void qkt(f32x16& p0, f32x16& p1, const char* K_lds, int r32, int hi, const bf16x8* qr, bool act) {
    if (SK && !act) { const float NEG = -__builtin_inff();
#pragma unroll
        for (int r = 0; r < 16; ++r) { p0[r] = NEG; p1[r] = NEG; } return; }
    p0 = f32x16{}; p1 = f32x16{};
    const char* kb[4];
#pragma unroll
    for (int dd = 0; dd < 4; ++dd) kb[dd] = K_lds + KB * SHM_K + KSWZ(r32, (dd * 16 + hi * 8) * 2);
#pragma unroll
    for (int d0 = 0; d0 < 8; ++d0) { const char* a = kb[d0 & 3] + (d0 >> 2) * 128;
        bf16x8 b0 = *reinterpret_cast<const bf16x8*>(a);
        bf16x8 b1 = *reinterpret_cast<const bf16x8*>(a + 32 * 256);
        p0 = __builtin_amdgcn_mfma_f32_32x32x16_bf16(b0, qr[d0], p0, 0, 0, 0);
        p1 = __builtin_amdgcn_mfma_f32_32x32x16_bf16(b1, qr[d0], p1, 0, 0, 0); }
}
template <int VB, bool SK>
__device__ __forceinline__ void pv_tile(f32x16* o, int vb0, bf16x8 pa0, bf16x8 pa1, bf16x8 pa2, bf16x8 pa3, bool act) {
    if (SK && !act) return;
#define TRRD(dst, off) asm volatile("ds_read_b64_tr_b16 %0, %1 offset:%2" : "=&v"(dst) : "v"(vb0), "i"(off) : "memory")
#define PV_D0(d0) do { s16x4 l0, l1, l2, l3, h0, h1, h2, h3; constexpr int b_ = VB * SHM_V + v_rd_off(d0, 0, 0);     \
        TRRD(l0, b_); TRRD(h0, b_ + 2048); TRRD(l1, b_ + 4096); TRRD(h1, b_ + 6144); TRRD(l2, b_ + 8192); TRRD(h2, b_ + 10240); TRRD(l3, b_ + 12288); TRRD(h3, b_ + 14336); \
        asm volatile("s_waitcnt lgkmcnt(0)" ::: "memory"); SBAR();                 \
        o[d0] = __builtin_amdgcn_mfma_f32_32x32x16_bf16(pa0, (bf16x8){l0[0], l0[1], l0[2], l0[3], h0[0], h0[1], h0[2], h0[3]}, o[d0], 0, 0, 0);   \
        o[d0] = __builtin_amdgcn_mfma_f32_32x32x16_bf16(pa1, (bf16x8){l1[0], l1[1], l1[2], l1[3], h1[0], h1[1], h1[2], h1[3]}, o[d0], 0, 0, 0);   \
        o[d0] = __builtin_amdgcn_mfma_f32_32x32x16_bf16(pa2, (bf16x8){l2[0], l2[1], l2[2], l2[3], h2[0], h2[1], h2[2], h2[3]}, o[d0], 0, 0, 0);   \
        o[d0] = __builtin_amdgcn_mfma_f32_32x32x16_bf16(pa3, (bf16x8){l3[0], l3[1], l3[2], l3[3], h3[0], h3[1], h3[2], h3[3]}, o[d0], 0, 0, 0); } while (0)
    PV_D0(0); PV_D0(1); PV_D0(2); PV_D0(3);
#undef PV_D0
#undef TRRD
}

template <class TIn, class TOut> struct BlockRef { const TIn* Q; const TIn* K; const TIn* V; TOut* O; int P0; };
template <class TIn> struct Seam {
    bf16x8 qr[8];
    bf16x8 st_v0, st_v1, st_k0, st_k1; f32x4 sf0, sf1, sf2, sf3;
    f32x4 tq[16];
};
__device__ __forceinline__ int swa_jlo(int P0, int W) { const int lowk = P0 - W + 1; return lowk > 0 ? lowk / KVBLK : 0; }
#define ROW(p, k0, rr) ((p) + (size_t)((k0) + (rr)) * D + sc)
#define VMW() asm volatile("s_waitcnt vmcnt(0)" ::: "memory")
#define VMWN(n) asm volatile("s_waitcnt vmcnt(%0)" :: "i"(n) : "memory")
#define SLOAD_H(Kp, Vp, k0) do { S.st_v0 = load8<TIn>(ROW(Vp, k0, sr)); S.st_v1 = load8<TIn>(ROW(Vp, k0, 32 + sr));              \
                         S.st_k0 = load8<TIn>(ROW(Kp, k0, sr)); S.st_k1 = load8<TIn>(ROW(Kp, k0, 32 + sr)); } while (0)
#define SWRITE_HK(bf) do { *(bf16x8*)(K_lds + (bf) * SHM_K + kws) = S.st_k0; *(bf16x8*)(K_lds + (bf) * SHM_K + kws + 32 * 256) = S.st_k1; } while (0)
#define SWRITE_HV(bf) do { *(bf16x8*)(V_lds + (bf) * SHM_V + vst0) = S.st_v0; *(bf16x8*)(V_lds + (bf) * SHM_V + vst1) = S.st_v1; } while (0)
#define SWRITE_H(bf) do { SWRITE_HV(bf); SWRITE_HK(bf); } while (0)
#define SLOAD_F(p, k0) do { S.sf0 = *(const f32x4*)ROW(p, k0, sr); S.sf1 = *(const f32x4*)(ROW(p, k0, sr) + 4);                \
                            S.sf2 = *(const f32x4*)ROW(p, k0, 32 + sr); S.sf3 = *(const f32x4*)(ROW(p, k0, 32 + sr) + 4); } while (0)
#define SWRITE_KF(bf) do { *(bf16x8*)(K_lds + (bf) * SHM_K + kws) = pack8(S.sf0, S.sf1); *(bf16x8*)(K_lds + (bf) * SHM_K + kws + 32 * 256) = pack8(S.sf2, S.sf3); } while (0)
#define SWRITE_VF(bf) do { *(bf16x8*)(V_lds + (bf) * SHM_V + vst0) = pack8(S.sf0, S.sf1); *(bf16x8*)(V_lds + (bf) * SHM_V + vst1) = pack8(S.sf2, S.sf3); } while (0)
template <class TIn, class TOut>
__device__ __forceinline__ void causal_swa_prime(const BlockRef<TIn, TOut>& cur, int W, char* lds, Seam<TIn>& S) {
    constexpr bool F32 = same_t<TIn, float>::v;
    const int tid = mk_otid(), wid = __builtin_amdgcn_readfirstlane(tid >> 6), lane = tid & 63, r32 = lane & 31, hi = lane >> 5;
    const int sr = tid >> 4, sc = (tid & 15) * 8, kws = KSWZ(sr, sc * 2); char* K_lds = lds + 2 * SHM_V;
    const int kb0 = swa_jlo(cur.P0, W) * KVBLK;
    for (int d0 = 0; d0 < 8; ++d0) S.qr[d0] = load8<TIn>(cur.Q + (size_t)(wid * QBLK + r32) * D + d0 * 16 + hi * 8);
    if constexpr (F32) { SLOAD_F((const float*)cur.K, kb0); VMW(); SWRITE_KF(0); SBAR(); SLOAD_F((const float*)cur.V, kb0); }
    else { SLOAD_H(cur.K, cur.V, kb0); VMW(); SWRITE_HK(0); }
    __syncthreads();
}
template <class TIn, class TOut>
__device__ __forceinline__ void causal_swa_block(const BlockRef<TIn, TOut>& cur, const BlockRef<TIn, TOut>& nxt, int skv, int W, char* lds, Seam<TIn>& S) {
    constexpr bool F32 = same_t<TIn, float>::v;
    const int tid = mk_otid(), wid = __builtin_amdgcn_readfirstlane(tid >> 6), lane = tid & 63, r32 = lane & 31, hi = lane >> 5;
    const int j_lo = swa_jlo(cur.P0, W);
    int j_hi = (cur.P0 + QB - 1) / KVBLK + 1; if (j_hi > skv / KVBLK) j_hi = skv / KVBLK;
    const int NT = j_hi - j_lo;
    const int kbn = swa_jlo(nxt.P0, W) * KVBLK;
    const int qlo = cur.P0 + wid * QBLK, qm = qlo + r32 - 4 * hi;
    char* V_lds = lds; char* K_lds = lds + 2 * SHM_V;
    float* ws = (float*)(lds + 2 * SHM_V + 2 * SHM_K) + wid * 64; float* li_l = ws, * al_l = ws + 32;
    float m_reg = -1e30f, l_reg = 0; f32x16 o[4] = {};
    const int sr = tid >> 4, sc = (tid & 15) * 8, vst0 = v_st(sr, sc), vst1 = v_st(32 + sr, sc), kws = KSWZ(sr, sc * 2);
    const int vb0 = (int)(uintptr_t)V_lds + v_rd_base(lane);
    const TIn* Kh = cur.K; const TIn* Vh = cur.V;
#define RESC(a) do { if (__any((a) < 1.f)) { if (hi == 0) al_l[r32] = (a); asm volatile("s_waitcnt lgkmcnt(0)" ::: "memory");              \
                     for (int d_ = 0; d_ < 4; ++d_) for (int r = 0; r < 16; ++r) o[d_][r] *= al_l[crow(r, hi)]; } } while (0)
#define KBASE(t) ((j_lo + (t)) * KVBLK)
#define ACT(t) (KBASE(t) <= qlo + QBLK - 1 && KBASE(t) + KVBLK - 1 >= qlo - W + 1)
#define MASKT(P0_, P1_, t) do { const int kb_ = KBASE(t); if ((!SK || ACT(t)) && (kb_ + KVBLK - 1 > qlo || kb_ <= qlo + QBLK - 1 - W)) mask_tile(P0_, P1_, qm - kb_, (unsigned)W); } while (0)
    constexpr int NQL = F32 ? 16 : 8;
    constexpr bool SK = WSKIP && !F32;
#define SEAM_K0() do { VMWN(NQL); if constexpr (F32) { SWRITE_KF(0); SBAR(); SLOAD_F((const float*)nxt.V, kbn); } else { SWRITE_HK(0); } SBAR(); } while (0)
    f32x16 pA0, pA1, pB0, pB1; float mnA, mnB, alA, alB; bf16x8 pa0, pa1, pa2, pa3;
    if constexpr (F32) { VMW(); SWRITE_VF(0); SBAR(); } else { SWRITE_HV(0); SBAR(); }
    if (NT > 1) { if constexpr (F32) SLOAD_F((const float*)Kh, KBASE(1)); else SLOAD_H(Kh, Vh, KBASE(1)); }
    SBAR(); qkt<0, SK>(pA0, pA1, K_lds, r32, hi, S.qr, ACT(0));
    if constexpr (F32) { if (NT > 1) { VMW(); SWRITE_KF(1); SBAR(); SLOAD_F((const float*)Vh, KBASE(1)); } }
    MASKT(pA0, pA1, 0); partialSM(pA0, pA1, m_reg, mnA, alA);
    if (NT > 1) { VMW(); if constexpr (F32) { SWRITE_VF(1); SBAR(); if (NT > 2) SLOAD_F((const float*)Kh, KBASE(2)); } else SWRITE_H(1); }
    __syncthreads();
#define HALF_STEP(PX0, PX1, mnX, alX, PY0, PY1, alY, t, KB, VB, SB) do {                                                      \
        SBAR(); qkt<KB, SK>(PX0, PX1, K_lds, r32, hi, S.qr, ACT(t));                                             \
        finishSM(PY0, PY1, alY, l_reg, pa0, pa1, pa2, pa3); SBAR();                                                           \
        if ((t) + 1 < NT) { if constexpr (F32) { VMW(); SWRITE_KF(SB); SBAR(); SLOAD_F((const float*)Vh, KBASE((t) + 1)); }  \
                            else { SLOAD_H(Kh, Vh, KBASE((t) + 1)); } SBAR(); }                                               \
        pv_tile<VB, SK>(o, vb0, pa0, pa1, pa2, pa3, ACT((t) - 1)); MASKT(PX0, PX1, (t)); partialSM(PX0, PX1, m_reg, mnX, alX);                                        \
        __syncthreads();                                                                                                      \
        if ((t) + 1 < NT) { VMW(); if constexpr (F32) { SWRITE_VF(SB); SBAR(); if ((t) + 2 < NT) SLOAD_F((const float*)Kh, KBASE((t) + 2)); } \
                            else { SWRITE_H(SB); } }                                                                          \
        RESC(alX); __syncthreads(); } while (0)
    for (int t = 1; t + 1 < NT; t += 2) {
        HALF_STEP(pB0, pB1, mnB, alB, pA0, pA1, alA, t, 1, 0, 0);
        HALF_STEP(pA0, pA1, mnA, alA, pB0, pB1, alB, t + 1, 0, 1, 1);
    }
    const bool even = (NT & 1) == 0;
    if (even) { SBAR(); qkt<1, SK>(pB0, pB1, K_lds, r32, hi, S.qr, ACT(NT - 1)); SBAR(); }
#define QROW(e) (nxt.Q + (size_t)(wid * QBLK + r32) * D + ((e) >> 1) * 16 + hi * 8 + ((e) & 1) * 4)
    if constexpr (F32) { SLOAD_F((const float*)nxt.K, kbn); SBAR();
#pragma unroll
        for (int e = 0; e < 8; ++e) S.tq[e] = *(const f32x4*)QROW(e); }
    else { SLOAD_H(nxt.K, nxt.V, kbn); SBAR();
#pragma unroll
        for (int d0 = 0; d0 < 8; ++d0) S.qr[d0] = load8<TIn>(nxt.Q + (size_t)(wid * QBLK + r32) * D + d0 * 16 + hi * 8); }
    SBAR();
    finishSM(pA0, pA1, alA, l_reg, pa0, pa1, pa2, pa3); SBAR();
    if constexpr (F32) {
#pragma unroll
        for (int e = 8; e < 16; ++e) S.tq[e] = *(const f32x4*)QROW(e); SBAR(); }
#undef QROW
    pv_tile<0, SK>(o, vb0, pa0, pa1, pa2, pa3, ACT(even ? NT - 2 : NT - 1));
    if (even) { MASKT(pB0, pB1, NT - 1); partialSM(pB0, pB1, m_reg, mnB, alB); __syncthreads(); RESC(alB);
        finishSM(pB0, pB1, alB, l_reg, pa0, pa1, pa2, pa3); SBAR(); pv_tile<1, SK>(o, vb0, pa0, pa1, pa2, pa3, ACT(NT - 1)); }
    SBAR(); SEAM_K0();
    if (hi == 0) li_l[r32] = l_reg; asm volatile("s_waitcnt lgkmcnt(0)" ::: "memory");
    float rli[16];
#pragma unroll
    for (int r = 0; r < 16; ++r) rli[r] = __builtin_amdgcn_rcpf(li_l[crow(r, hi)]);
    TOut* Ow = cur.O + (size_t)(wid * QBLK) * D;
#pragma unroll
    for (int r = 0; r < 16; ++r) { const int orow = crow(r, hi);
#pragma unroll
        for (int d0 = 0; d0 < 4; ++d0) { const float v = o[d0][r] * rli[r];
            if constexpr (same_t<TOut, float>::v) { Ow[(size_t)orow * D + d0 * 32 + r32] = v; }
            else { const float vn = __shfl_xor(v, 1);
                   if ((r32 & 1) == 0) *(unsigned*)(Ow + (size_t)orow * D + d0 * 32 + r32) = cvtpk(v, vn); } } }
    if constexpr (F32) {
#pragma unroll
        for (int d0 = 0; d0 < 8; ++d0) S.qr[d0] = pack8(S.tq[2 * d0], S.tq[2 * d0 + 1]); }
    __syncthreads();
#undef RESC
#undef KBASE
#undef ACT
#undef MASKT
#undef SEAM_K0
#undef HALF_STEP
}
#undef ROW
#undef VMW
#undef VMWN
#undef SLOAD_H
#undef SWRITE_HK
#undef SWRITE_HV
#undef SWRITE_H
#undef SLOAD_F
#undef SWRITE_KF
#undef SWRITE_VF
}

namespace mk {
using pg8::bf16_t; using pg8::f32x4; using pg8::f32x2; using pg8::u32x4; using pg8::u32x2; using pg8::bf16x8; using pg8::cvt_pk_bf16; using pg8::bf_lo; using pg8::bf_hi;
#define GAS __attribute__((address_space(1)))
#define LAS __attribute__((address_space(3)))
typedef GAS unsigned gu32;
#define RLX_AGENT __ATOMIC_RELAXED, __HIP_MEMORY_SCOPE_AGENT
#define LDS_WAIT() asm volatile("s_waitcnt lgkmcnt(0)" ::: "memory")
#define VM_WAIT() asm volatile("s_waitcnt vmcnt(0)" ::: "memory")

constexpr int NWAVES = 8, NTHR = 512;
constexpr int D = 2048, NB = 4, SEQ = 2048, T = NB * SEQ, MEM = 256, TM = NB * MEM;
constexpr int DIN = 4096, DSSM = 1024, NG = 64, NP = 64, NH = 16, NE = 64, DFF = 512;
constexpr float EPS = 1e-6f;

constexpr size_t MiB = 1u << 20;
constexpr size_t WS_CTL = 0, CTL_ZERO_BYTES = 1 * MiB;
constexpr size_t WS_TAB = 1 * MiB;
constexpr size_t WS_SSQ = 2 * MiB;
constexpr size_t WS_MOE = 10 * MiB;
constexpr size_t WS_KX = 18 * MiB, WS_VXT = 22 * MiB;
constexpr size_t WS_SSMT = 26 * MiB;
constexpr size_t WS_WXO = 26 * MiB;
constexpr size_t WS_XN = 42 * MiB;
constexpr size_t WS_WXK = 42 * MiB, WS_WXV = 50 * MiB;
constexpr size_t WS_MN = 58 * MiB;
constexpr size_t WS_WGLU = 62 * MiB;
constexpr size_t WS_QH = 74 * MiB, WS_KH = 90 * MiB;
constexpr size_t WS_CAT = 74 * MiB;
constexpr size_t WS_H1 = 74 * MiB;
constexpr size_t WS_VH = 106 * MiB, WS_U = 122 * MiB;
constexpr size_t WS_QX = 106 * MiB;
constexpr size_t WS_ACT = 106 * MiB;
constexpr size_t WS_OH = 138 * MiB;
constexpr size_t WS_YG = 170 * MiB;
constexpr size_t WS_W1T = 186 * MiB;
constexpr size_t WS_WOUT = 186 * MiB;
constexpr size_t WS_WXQ = 194 * MiB;
constexpr size_t WS_PX = 138 * MiB;
constexpr size_t WS_OX = 154 * MiB;
constexpr size_t WS_YS = 138 * MiB;
constexpr size_t WS_END = 204 * MiB;
constexpr size_t SQ_S = 0;
constexpr size_t SQ_H1 = 16 * (size_t)T;
constexpr size_t SQ_QX = 48 * (size_t)T;
constexpr size_t SQ_L = 80 * (size_t)T;
constexpr size_t SQ_H2 = 96 * (size_t)T;
constexpr size_t SQ_KX = 128 * (size_t)T;
constexpr int CW_BAR = 4096;
constexpr int CW_CNT = 16384;

constexpr int RING_OFF = 0, RING_BYTES = 131072;
constexpr int EPI_TBL = 131072;
constexpr int RTAB_OFF = 157696;
constexpr int MISC_OFF = 158720;
constexpr int LDS_BYTES = 163840;

__device__ __forceinline__ unsigned f2bf(float f) { unsigned u = __builtin_bit_cast(unsigned, f); return (u + 0x7fffu + ((u >> 16) & 1u)) >> 16; }
__device__ __forceinline__ unsigned pk2(float lo, float hi) { return f2bf(lo) | (f2bf(hi) << 16); }
__device__ __forceinline__ float wave_sum(float v) {
#pragma unroll
    for (int o = 1; o < 64; o <<= 1) v += __shfl_xor(v, o);
    return v;
}

#define XB_TMO      128
#define XB_XCNT(j)  (256  + 64 * (j))
#define XB_XSUB(j)  (1280 + 64 * (j))
#define XB_XGEN(j)  (2304 + 64 * (j))
#define XB_TOP      3328
#define XB_TOPGEN   3392
#define XCD_BAR_WORDS 3456
#define XB_SPIN_CAP (1u << 20)
__device__ __forceinline__ unsigned xb_ld(unsigned* p)              { return __hip_atomic_load(p, __ATOMIC_RELAXED, __HIP_MEMORY_SCOPE_AGENT); }
__device__ __forceinline__ unsigned xb_add(unsigned* p, unsigned v) { return __hip_atomic_fetch_add(p, v, __ATOMIC_RELAXED, __HIP_MEMORY_SCOPE_AGENT); }
__device__ __forceinline__ unsigned xb_xcc_id() { return (unsigned)__builtin_amdgcn_s_getreg((3 << 11) | 20) & 0xFu; }
#define XB_SPIN(cond, bar) do { unsigned _sp = 0; while (cond) { __builtin_amdgcn_s_sleep(1); \
    if ((++_sp & 255u) == 0u) { if (xb_ld(&(bar)[XB_TMO])) break; if (_sp > XB_SPIN_CAP) { atomicAdd(&(bar)[XB_TMO], 1u); break; } } } } while (0)
#ifndef CODE_PF
#define CODE_PF 0
#endif
struct XcdBarrier { unsigned* bar; unsigned x; volatile LAS unsigned* st; const char* code; int loc; };
__device__ __forceinline__ XcdBarrier xcd_barrier_post(unsigned* bar, volatile LAS unsigned* st) {
    XcdBarrier b; b.bar = bar; b.x = xb_xcc_id(); b.st = st; b.code = nullptr; b.loc = 0;
    if (threadIdx.x == 0) (void)xb_add(&bar[XB_XCNT(b.x)], 1u);
    return b;
}
__device__ __forceinline__ void xcd_barrier_complete(unsigned* bar, unsigned x, unsigned& nloc, unsigned& nx) {
    const unsigned G = gridDim.x * gridDim.y * gridDim.z;
    unsigned sum, cnt, mine, sp = 0u;
    for (;;) {
        sum = 0u; cnt = 0u; mine = 0u;
#pragma unroll
        for (unsigned j = 0; j < 16; ++j) { const unsigned c = xb_ld(&bar[XB_XCNT(j)]); sum += c; cnt += (c > 0u) ? 1u : 0u; mine = (j == x) ? c : mine; }
        if (sum == G) break;
        __builtin_amdgcn_s_sleep(1);
        if ((++sp & 255u) == 0u) { if (xb_ld(&bar[XB_TMO])) break; if (sp > XB_SPIN_CAP) { atomicAdd(&bar[XB_TMO], 1u); break; } }
    }
    nloc = mine > 0u ? mine : 1u; nx = cnt > 0u ? cnt : 1u;
}
__device__ __forceinline__ void xcd_barrier(const XcdBarrier& b) {
    asm volatile("s_waitcnt vmcnt(0)" ::: "memory");
    __syncthreads();
    unsigned pf_ = 0; const unsigned tpf_ = threadIdx.x - 64u;
    if (CODE_PF && tpf_ < 49u) asm volatile("global_load_dword %0, %1, off" : "=v"(pf_) : "v"(b.code + (size_t)(b.loc * 49 + (int)tpf_) * 128) : "memory");
    if (threadIdx.x == 0) {
        unsigned* bar = b.bar;
        __builtin_amdgcn_s_waitcnt(0);
        unsigned nloc = b.st[0], nx = b.st[1];
        if (nloc == 0u) { xcd_barrier_complete(bar, b.x, nloc, nx); b.st[0] = nloc; b.st[1] = nx; }
        const unsigned old = xb_add(&bar[XB_XSUB(b.x)], 1u);
        const unsigned gen = old / nloc;
        if (old + 1u == (gen + 1u) * nloc) {
            __builtin_amdgcn_fence(__ATOMIC_RELEASE, "agent");
            asm volatile("s_waitcnt vmcnt(0)" ::: "memory");
            const unsigned og = xb_add(&bar[XB_TOP], 1u);
            const unsigned tg = og / nx;
            if (og + 1u == (tg + 1u) * nx) xb_add(&bar[XB_TOPGEN], 1u);
            else XB_SPIN(xb_ld(&bar[XB_TOPGEN]) == tg, bar);
            __builtin_amdgcn_fence(__ATOMIC_ACQUIRE, "agent");
            xb_add(&bar[XB_XGEN(b.x)], 1u);
            asm volatile("s_waitcnt vmcnt(0)" ::: "memory");
        } else {
            XB_SPIN(xb_ld(&bar[XB_XGEN(b.x)]) == gen, bar);
            __builtin_amdgcn_fence(__ATOMIC_ACQUIRE, "agent");
            asm volatile("s_waitcnt vmcnt(0)" ::: "memory");
        }
    }
    if (CODE_PF && tpf_ < 49u) { asm volatile("s_waitcnt vmcnt(0)" ::: "memory"); asm volatile("" :: "v"(pf_)); }
    __syncthreads();
}

struct Args { const float* in[38]; float* out; unsigned char* ws; int ph_lo, ph_hi; };
typedef const __attribute__((address_space(4))) char* kptr_t;
struct AV {
    kptr_t kp;
    __device__ __forceinline__ kptr_t base() const { kptr_t p = kp; asm volatile("" : "+s"(p)); return p; }
    __device__ __forceinline__ const float* in(int i) const { return *(const float* const __attribute__((address_space(4)))*)(base() + 8 * i); }
    __device__ __forceinline__ float* out() const { return *(float* const __attribute__((address_space(4)))*)(base() + 304); }
    __device__ __forceinline__ unsigned char* ws() const { return *(unsigned char* const __attribute__((address_space(4)))*)(base() + 312); }
    __device__ __forceinline__ int ph_lo() const { return *(const int __attribute__((address_space(4)))*)(base() + 320); }
    __device__ __forceinline__ int ph_hi() const { return *(const int __attribute__((address_space(4)))*)(base() + 324); }
};
static_assert(sizeof(Args) == 328 && offsetof(Args, out) == 304 && offsetof(Args, ws) == 312 && offsetof(Args, ph_lo) == 320, "Args layout vs AV offsets");

struct Frame {
    LAS unsigned char* lds;
    volatile LAS unsigned* MISC;
    gu32* ctl;
    int tid, lane, wave, vcu, G;
    unsigned char* ws;
};

__device__ __forceinline__ void xpose_item(const float* W, int ldw, int N, bf16_t* WT, int ldt, const float* kscale, int item, int lane) {
    const int nblk = N / 64, kb = item / nblk, nb = item % nblk, g = lane >> 4, c4 = lane & 15, k0 = 64 * kb + 16 * g, n0 = 64 * nb + 4 * c4;
    f32x4 v[16];
#pragma unroll
    for (int j = 0; j < 16; ++j) v[j] = __builtin_nontemporal_load((const f32x4*)(W + (size_t)(k0 + j) * ldw + n0));
    if (kscale) {
#pragma unroll
        for (int j = 0; j < 16; ++j) v[j] = v[j] * kscale[k0 + j]; }
#pragma unroll
    for (int c = 0; c < 4; ++c) {
        u32x4 o0, o1;
        o0.x = cvt_pk_bf16(v[0][c], v[1][c]); o0.y = cvt_pk_bf16(v[2][c], v[3][c]); o0.z = cvt_pk_bf16(v[4][c], v[5][c]); o0.w = cvt_pk_bf16(v[6][c], v[7][c]);
        o1.x = cvt_pk_bf16(v[8][c], v[9][c]); o1.y = cvt_pk_bf16(v[10][c], v[11][c]); o1.z = cvt_pk_bf16(v[12][c], v[13][c]); o1.w = cvt_pk_bf16(v[14][c], v[15][c]);
        *(u32x4*)(WT + (size_t)(n0 + c) * ldt + k0) = o0; *(u32x4*)(WT + (size_t)(n0 + c) * ldt + k0 + 8) = o1; }
}
__device__ __forceinline__ void rms_row_to_bf16(const float* xrow, const float* w, bf16_t* orow, int lane) {
    const GAS f32x4* xr = (const GAS f32x4*)xrow + lane; const GAS f32x4* wr = (const GAS f32x4*)w + lane;
    f32x4 v[8]; float s = 0.f;
#pragma unroll
    for (int j = 0; j < 8; ++j) { v[j] = __builtin_nontemporal_load(xr + 64 * j); s += (v[j].x * v[j].x + v[j].y * v[j].y) + (v[j].z * v[j].z + v[j].w * v[j].w); }
    const float r = 1.0f / sqrtf(wave_sum(s) * (1.f / D) + EPS);
    GAS u32x2* o8 = (GAS u32x2*)orow + lane;
#pragma unroll
    for (int j = 0; j < 8; ++j) { const f32x4 ww = wr[64 * j]; u32x2 o; o.x = pk2(v[j].x * r * ww.x, v[j].y * r * ww.y); o.y = pk2(v[j].z * r * ww.z, v[j].w * r * ww.w); o8[64 * j] = o; }
}
__device__ __forceinline__ void rms_row2_to_bf16(const float* xa, const float* xb, const float* w, bf16_t* oa, bf16_t* ob, int lane) {
    const GAS f32x4* pa = (const GAS f32x4*)xa + lane; const GAS f32x4* pb = (const GAS f32x4*)xb + lane; const GAS f32x4* wr = (const GAS f32x4*)w + lane;
    f32x4 va[8], vb[8]; float sa = 0.f, sb = 0.f;
#pragma unroll
    for (int j = 0; j < 8; ++j) { va[j] = __builtin_nontemporal_load(pa + 64 * j); vb[j] = __builtin_nontemporal_load(pb + 64 * j); }
#pragma unroll
    for (int j = 0; j < 8; ++j) { sa += (va[j].x * va[j].x + va[j].y * va[j].y) + (va[j].z * va[j].z + va[j].w * va[j].w); sb += (vb[j].x * vb[j].x + vb[j].y * vb[j].y) + (vb[j].z * vb[j].z + vb[j].w * vb[j].w); }
    const float ra = 1.0f / sqrtf(wave_sum(sa) * (1.f / D) + EPS), rb = 1.0f / sqrtf(wave_sum(sb) * (1.f / D) + EPS);
    GAS u32x2* qa = (GAS u32x2*)oa + lane; GAS u32x2* qb = (GAS u32x2*)ob + lane;
#pragma unroll
    for (int j = 0; j < 8; ++j) { const f32x4 ww = wr[64 * j]; u32x2 o;
        o.x = pk2(va[j].x * ra * ww.x, va[j].y * ra * ww.y); o.y = pk2(va[j].z * ra * ww.z, va[j].w * ra * ww.w); qa[64 * j] = o;
        o.x = pk2(vb[j].x * rb * ww.x, vb[j].y * rb * ww.y); o.y = pk2(vb[j].z * rb * ww.z, vb[j].w * rb * ww.w); qb[64 * j] = o; }
}

constexpr size_t TAB_RWH = 65536, TAB_RWL = 65536 + 80 * 2048 * 2;
struct TileOrder {
    int nM, nN, nwg, G, c;
    __device__ __forceinline__ void init(int nM_, int nN_, int G_, int c_) { nM = nM_; nN = nN_; nwg = nM * nN; G = G_; c = c_; }
    __device__ __forceinline__ bool map(int i, int& pm, int& pn) const {
        const long L = (long)i * G + c; if (L >= nwg) return false;
        int wgid = (int)L; { const int q = nwg / 8, r = nwg % 8, xcd = wgid % 8, off = wgid / 8; wgid = (xcd < r ? xcd * (q + 1) : r * (q + 1) + (xcd - r) * q) + off; }
        const int nig = 8 * nN, gid = wgid / nig, fm = gid * 8, gsz = (nM - fm) < 8 ? (nM - fm) : 8;
        pm = fm + ((wgid % nig) % gsz); pn = (wgid % nig) / gsz; return true;
    }
};
struct PlainSched {
    TileOrder o; const char* A; const char* B; size_t tstepA, tstepB;
    __device__ __forceinline__ void init(const bf16_t* A_, int lda, const bf16_t* B_, int ldb, int M, int N, int G, int c) {
        o.init(M / 256, N / 256, G, c); A = (const char*)A_; B = (const char*)B_; tstepA = (size_t)256 * lda * 2; tstepB = (size_t)256 * ldb * 2; }
    __device__ __forceinline__ bool next(int i, pg8::Unit& u) const {
        int pm, pn; if (!o.map(i, pm, pn)) return false;
        u.pm = pm; u.pn = pn; u.aux0 = 0; u.aux1 = 0; u.A = A + (size_t)pm * tstepA; u.B = B + (size_t)pn * tstepB; return true; }
};
#define EPI_BAR() do { asm volatile("s_waitcnt lgkmcnt(0)" ::: "memory"); __builtin_amdgcn_s_barrier(); asm volatile("" ::: "memory"); } while (0)

struct EpiG1 {
    static constexpr bool PERM = true; static constexpr int MIDT = -1;
    bf16_t *Qh, *Kh, *Vh, *U; const float *qw, *kw; LAS float* tbl;
    __device__ __forceinline__ void mid(f32x4 (&)[2][2][4][2], const pg8::Unit&, int, int, int, int) const {}
    __device__ __forceinline__ void prep(const pg8::Unit&) const {}
    __device__ __forceinline__ void operator()(f32x4 (&acc)[2][2][4][2], const pg8::Unit& u, int wr, int wc, int fr, int fq) const {
        const int pn = u.pn, pm = u.pm, b = pm >> 3, s0 = (pm & 7) * 256 + wr * 64 + fr;
        if (pn < 8) {
#pragma unroll
            for (int ai = 0; ai < 2; ++ai)
#pragma unroll
                for (int m = 0; m < 4; ++m)
#pragma unroll
                    for (int bj = 0; bj < 2; ++bj) { const f32x4 x0 = acc[ai][bj][m][0], x1 = acc[ai][bj][m][1];
                        float s = (x0[0] * x0[0] + x0[1] * x0[1]) + (x0[2] * x0[2] + x0[3] * x0[3]) + (x1[0] * x1[0] + x1[1] * x1[1]) + (x1[2] * x1[2] + x1[3] * x1[3]);
                        s += __shfl_xor(s, 16); s += __shfl_xor(s, 32);
                        if (fq == 0) tbl[((ai * 128 + wr * 64 + m * 16 + fr) * 2 + bj) * 4 + wc] = s; }
            EPI_BAR();
            const float* w = (pn < 4 ? qw : kw) + wc * 32 + fq * 8; const f32x4 w0 = *(const f32x4*)w, w1 = *(const f32x4*)(w + 4);
            bf16_t* base = (pn < 4 ? Qh : Kh);
#pragma unroll
            for (int ai = 0; ai < 2; ++ai)
#pragma unroll
                for (int m = 0; m < 4; ++m)
#pragma unroll
                    for (int bj = 0; bj < 2; ++bj) { const f32x4 p = *(const LAS f32x4*)&tbl[((ai * 128 + wr * 64 + m * 16 + fr) * 2 + bj) * 4];
                        const float r = rsqrtf(((p[0] + p[1]) + (p[2] + p[3])) * (1.f / 128.f) + EPS);
                        const f32x4 v0 = acc[ai][bj][m][0] * r * w0, v1 = acc[ai][bj][m][1] * r * w1;
                        u32x4 o; o.x = cvt_pk_bf16(v0[0], v0[1]); o.y = cvt_pk_bf16(v0[2], v0[3]); o.z = cvt_pk_bf16(v1[0], v1[1]); o.w = cvt_pk_bf16(v1[2], v1[3]);
                        *(u32x4*)(base + ((size_t)((b * 8 + (pn & 3) * 2 + bj) * SEQ + s0 + ai * 128 + m * 16)) * 128 + wc * 32 + fq * 8) = o; }
        } else {
#pragma unroll
            for (int ai = 0; ai < 2; ++ai)
#pragma unroll
                for (int m = 0; m < 4; ++m)
#pragma unroll
                    for (int bj = 0; bj < 2; ++bj) { const f32x4 v0 = acc[ai][bj][m][0], v1 = acc[ai][bj][m][1];
                        u32x4 o; o.x = cvt_pk_bf16(v0[0], v0[1]); o.y = cvt_pk_bf16(v0[2], v0[3]); o.z = cvt_pk_bf16(v1[0], v1[1]); o.w = cvt_pk_bf16(v1[2], v1[3]);
                        bf16_t* dst = (pn < 12) ? Vh + ((size_t)((b * 8 + (pn & 3) * 2 + bj) * SEQ + s0 + ai * 128 + m * 16)) * 128 + wc * 32 + fq * 8
                                                : U + (size_t)(pm * 256 + wr * 64 + fr + ai * 128 + m * 16) * DSSM + (pn - 12) * 256 + bj * 128 + wc * 32 + fq * 8;
                        *(u32x4*)dst = o; }
        }
    }
};


constexpr size_t SSMT_G = (size_t)256 * 384 + 128 * 256;
__device__ __forceinline__ void ssm_tables(Frame& F, const AV& a, int g) {
    LAS f32x2* lamp = (LAS f32x2*)(F.lds);
    LAS f32x2* Bb = lamp + 17 * 64;
    LAS f32x2* Cc = Bb + 64 * 16;
    LAS float* Kt = (LAS float*)(Cc + 16 * 64);
    const float *lre = a.in(11), *lim = a.in(12), *logdt = a.in(13), *bre = a.in(14), *bim = a.in(15), *cre = a.in(16), *cim = a.in(17), *dsk = a.in(18);
    const int tid = F.tid;
    if (tid < 64) { const int p = tid;
        const double lr = fmin((double)lre[g * 64 + p], -1e-4), li = (double)lim[g * 64 + p], dt = exp((double)logdt[g]);
        const double mag = exp(lr * dt), br = mag * cos(li * dt), bi = mag * sin(li * dt), den = lr * lr + li * li;
        const double cr = ((br - 1.0) * lr + bi * li) / den, ci = (bi * lr - (br - 1.0) * li) / den;
        double pr = 1.0, pi = 0.0;
        for (int n = 0; n <= 16; ++n) { lamp[n * 64 + p] = (f32x2){(float)pr, (float)pi}; const double nr = pr * br - pi * bi, ni = pr * bi + pi * br; pr = nr; pi = ni; }
        ((f32x2*)(F.ws + WS_TAB))[64 + g * 64 + p] = lamp[16 * 64 + p];
        for (int h = 0; h < 16; ++h) { const double r = bre[(g * 64 + p) * 16 + h], i = bim[(g * 64 + p) * 16 + h]; Bb[p * 16 + h] = (f32x2){(float)(cr * r - ci * i), (float)(cr * i + ci * r)}; }
    }
    for (int e = tid; e < 1024; e += NTHR) { const int ho = e >> 6, p = e & 63; Cc[ho * 64 + p] = (f32x2){cre[(g * 16 + ho) * 64 + p], cim[(g * 16 + ho) * 64 + p]}; }
    __syncthreads();
    if (tid < 256) { const int tau = tid >> 4, ho = tid & 15; float s[16];
#pragma unroll
        for (int hi = 0; hi < 16; ++hi) s[hi] = 0.f;
        for (int p = 0; p < 64; ++p) { const f32x2 c = Cc[ho * 64 + p], l = lamp[tau * 64 + p]; const float clr = c.x * l.x - c.y * l.y, cli = c.x * l.y + c.y * l.x;
            const LAS f32x4* bp = (const LAS f32x4*)(Bb + p * 16);
#pragma unroll
            for (int h2 = 0; h2 < 8; ++h2) { const f32x4 b2 = bp[h2]; s[2 * h2] += clr * b2[0] - cli * b2[1]; s[2 * h2 + 1] += clr * b2[2] - cli * b2[3]; } }
#pragma unroll
        for (int hi = 0; hi < 16; ++hi) Kt[(tau * 16 + ho) * 16 + hi] = s[hi] + ((tau == 0 && hi == ho) ? dsk[g * 16 + ho] : 0.f);
    }
    __syncthreads();
    bf16_t* TY = (bf16_t*)(F.ws + WS_SSMT) + (size_t)g * SSMT_G; bf16_t* WSg = TY + 256 * 384;
    for (int e = tid; e < 256 * 192; e += NTHR) { const int m = e / 192, k0 = (e % 192) * 2, i = m >> 4, ho = m & 15; float v[2];
#pragma unroll
        for (int q = 0; q < 2; ++q) { const int k = k0 + q;
            if (k < 256) { const int j = k >> 4, hi = k & 15; v[q] = (j <= i) ? Kt[((i - j) * 16 + ho) * 16 + hi] : 0.f; }
            else { const int kk = k - 256, ri = kk >> 6, p = kk & 63; const f32x2 c = Cc[ho * 64 + p], l = lamp[(i + 1) * 64 + p];
                v[q] = ri == 0 ? (c.x * l.x - c.y * l.y) : -(c.x * l.y + c.y * l.x); } }
        *(unsigned*)(TY + (size_t)m * 384 + k0) = pk2(v[0], v[1]); }
    for (int e = tid; e < 128 * 128; e += NTHR) { const int n = e >> 7, k0 = (e & 127) * 2, ri = n >> 6, p = n & 63, j = k0 >> 4, hi = k0 & 15; float v[2];
        const f32x2 l = lamp[(15 - j) * 64 + p];
#pragma unroll
        for (int q = 0; q < 2; ++q) { const f32x2 bb = Bb[p * 16 + hi + q]; v[q] = ri == 0 ? (l.x * bb.x - l.y * bb.y) : (l.x * bb.y + l.y * bb.x); }
        *(unsigned*)(WSg + (size_t)n * 256 + k0) = pk2(v[0], v[1]); }
    __syncthreads();
}
__device__ __forceinline__ float gelu_tanh(float y) { const float z2 = -2.302208198f * (y + 0.044715f * y * y * y);     return y * __builtin_amdgcn_rcpf(1.f + __builtin_amdgcn_exp2f(z2)); }
__device__ __forceinline__ float sigmoid_fast(float z) { return __builtin_amdgcn_rcpf(1.f + __builtin_amdgcn_exp2f(-1.4426950408889634f * z)); }
__device__ __forceinline__ void ssm_unit(Frame& F, int b, int g) {
    LAS unsigned char* Ul = F.lds; LAS unsigned char* Sl = F.lds + 67584;
    const bf16_t* U = (const bf16_t*)(F.ws + WS_U); bf16_t* yg = (bf16_t*)(F.ws + WS_YG);
    const int tid = F.tid, lane = F.lane, wave = F.wave, fr = lane & 15, fq = lane >> 4;
    for (int q = tid; q < 4096; q += NTHR) { const int tok = q >> 1, half = q & 1;
        const u32x4 v = *(const u32x4*)(U + (size_t)(b * SEQ + tok) * DSSM + g * 16 + half * 8);
        *(LAS u32x4*)(Ul + (tok >> 4) * 528 + ((tok & 15) * 16 + half * 8) * 2) = v; }
    __syncthreads();
    const bf16_t* TY = (const bf16_t*)(F.ws + WS_SSMT) + (size_t)g * SSMT_G; const bf16_t* WSg = TY + 256 * 384;
    {
        f32x4 acc[8]; bf16x8 bfr[8];
#pragma unroll
        for (int ks = 0; ks < 8; ++ks) bfr[ks] = *(const bf16x8*)(WSg + (size_t)(16 * wave + fr) * 256 + 32 * ks + 8 * fq);
#pragma unroll
        for (int rb = 0; rb < 8; ++rb) acc[rb] = (f32x4){0.f, 0.f, 0.f, 0.f};
#pragma unroll
        for (int ks = 0; ks < 8; ++ks) {
#pragma unroll
            for (int rb = 0; rb < 8; ++rb) { const bf16x8 afr = *(const LAS bf16x8*)(Ul + (16 * rb + fr) * 528 + (32 * ks + 8 * fq) * 2);
                acc[rb] = __builtin_amdgcn_mfma_f32_16x16x32_bf16(afr, bfr[ks], acc[rb], 0, 0, 0); } }
#pragma unroll
        for (int rb = 0; rb < 8; ++rb)
#pragma unroll
            for (int r = 0; r < 4; ++r) *(LAS float*)(Sl + (16 * rb + 4 * fq + r) * 528 + (16 * wave + fr) * 4) = acc[rb][r];
    }
    __syncthreads();
    if (wave == 0) { const int p = lane; const f32x2 l = ((const f32x2*)(F.ws + WS_TAB))[64 + g * 64 + p]; float xr = 0.f, xi = 0.f;
#pragma unroll 1
        for (int cb = 0; cb < 128; cb += 16) { float sr[16], si[16];
#pragma unroll
            for (int j = 0; j < 16; ++j) { const LAS float* row = (const LAS float*)(Sl + (cb + j) * 528); sr[j] = row[p]; si[j] = row[64 + p]; }
#pragma unroll
            for (int j = 0; j < 16; ++j) { LAS float* row = (LAS float*)(Sl + (cb + j) * 528); row[p] = xr; row[64 + p] = xi;
                const float nr = l.x * xr - l.y * xi + sr[j], ni = l.x * xi + l.y * xr + si[j]; xr = nr; xi = ni; } } }
    __syncthreads();
#pragma unroll 1
    for (int cbi = 0; cbi < 2; ++cbi) { const int cb = 2 * wave + cbi;
        f32x4 acc[8]; bf16x8 bfr[12];
#pragma unroll
        for (int ks = 0; ks < 12; ++ks) bfr[ks] = *(const bf16x8*)(TY + (size_t)(16 * cb + fr) * 384 + 32 * ks + 8 * fq);
#pragma unroll
        for (int rb = 0; rb < 8; ++rb) acc[rb] = (f32x4){0.f, 0.f, 0.f, 0.f};
#pragma unroll
        for (int ks = 0; ks < 8; ++ks) {
#pragma unroll
            for (int rb = 0; rb < 8; ++rb) { const bf16x8 afr = *(const LAS bf16x8*)(Ul + (16 * rb + fr) * 528 + (32 * ks + 8 * fq) * 2);
                acc[rb] = __builtin_amdgcn_mfma_f32_16x16x32_bf16(afr, bfr[ks], acc[rb], 0, 0, 0); } }
#pragma unroll
        for (int ks = 0; ks < 4; ++ks) {
#pragma unroll
            for (int rb = 0; rb < 8; ++rb) { const LAS f32x4* xp = (const LAS f32x4*)(Sl + (16 * rb + fr) * 528 + (32 * ks + 8 * fq) * 4); const f32x4 x0 = xp[0], x1 = xp[1];
                u32x4 w; w.x = cvt_pk_bf16(x0[0], x0[1]); w.y = cvt_pk_bf16(x0[2], x0[3]); w.z = cvt_pk_bf16(x1[0], x1[1]); w.w = cvt_pk_bf16(x1[2], x1[3]);
                acc[rb] = __builtin_amdgcn_mfma_f32_16x16x32_bf16(__builtin_bit_cast(bf16x8, w), bfr[8 + ks], acc[rb], 0, 0, 0); } }
#pragma unroll
        for (int rb = 0; rb < 8; ++rb)
#pragma unroll
            for (int r = 0; r < 4; ++r) { const int c = 16 * rb + 4 * fq + r; const float y = gelu_tanh(acc[rb][r]);
                yg[(size_t)(b * SEQ + c * 16 + cb) * DSSM + g * 16 + fr] = (bf16_t)f2bf(y); }
    }
    __syncthreads();
}


__device__ __forceinline__ u32x4 pack8(const f32x4 v0, const f32x4 v1) { u32x4 o; o.x = cvt_pk_bf16(v0[0], v0[1]); o.y = cvt_pk_bf16(v0[2], v0[3]); o.z = cvt_pk_bf16(v1[0], v1[1]); o.w = cvt_pk_bf16(v1[2], v1[3]); return o; }
__device__ __forceinline__ float ssq8(const f32x4 a, const f32x4 b) { return ((a[0] * a[0] + a[1] * a[1]) + (a[2] * a[2] + a[3] * a[3])) + ((b[0] * b[0] + b[1] * b[1]) + (b[2] * b[2] + b[3] * b[3])); }
__device__ __forceinline__ float red_fq(float s) { s += __shfl_xor(s, 16); s += __shfl_xor(s, 32); return s; }

template <int NPART, bool RSQ> __device__ __forceinline__ void prep_rtab(const float* sq, size_t nrows, int p0, int rowbase, float inv_w, LAS float* rtab, LAS float* tmp) {
    const int tid = mk_otid();
    const int row = tid & 255, half = tid >> 8; float s = 0.f;
#pragma unroll
    for (int i = 0; i < NPART / 2; ++i) s += sq[(size_t)(p0 + half * (NPART / 2) + i) * nrows + rowbase + row];
    tmp[half * 256 + row] = s; EPI_BAR();
    if (tid < 256) { s = tmp[row] + tmp[256 + row]; rtab[row] = RSQ ? rsqrtf(s * inv_w + EPS) : 1.f / s; }
    EPI_BAR();
}
struct EpiGlu {
    static constexpr bool PERM = true; static constexpr int MIDT = -1;
    const bf16_t* yg; const float* bias; bf16_t* cat; float* sq;
    __device__ __forceinline__ void mid(f32x4 (&)[2][2][4][2], const pg8::Unit&, int, int, int, int) const {}
    __device__ __forceinline__ void prep(const pg8::Unit&) const {}
    __device__ __forceinline__ void operator()(f32x4 (&acc)[2][2][4][2], const pg8::Unit& u, int wr, int wc, int fr, int fq) const {
        const int row0 = u.pm * 256 + wr * 64 + fr, col0 = u.pn * 256 + wc * 32 + fq * 8;
        f32x4 bv[2][2];
#pragma unroll
        for (int bj = 0; bj < 2; ++bj) { bv[bj][0] = *(const f32x4*)(bias + col0 + bj * 128); bv[bj][1] = *(const f32x4*)(bias + col0 + bj * 128 + 4); }
#pragma unroll
        for (int ai = 0; ai < 2; ++ai) {
            u32x4 ypre[4][2];
#pragma unroll
            for (int m = 0; m < 4; ++m)
#pragma unroll
                for (int bj = 0; bj < 2; ++bj) ypre[m][bj] = *(const u32x4*)(yg + (size_t)(row0 + ai * 128 + m * 16) * DSSM + col0 + bj * 128);
            asm volatile("" ::: "memory");
#pragma unroll
            for (int m = 0; m < 4; ++m) { const int row = row0 + ai * 128 + m * 16; float s = 0.f;
#pragma unroll
                for (int bj = 0; bj < 2; ++bj) { const u32x4 yw = ypre[m][bj];
                    const f32x4 y0 = {bf_lo(yw.x), bf_hi(yw.x), bf_lo(yw.y), bf_hi(yw.y)}, y1 = {bf_lo(yw.z), bf_hi(yw.z), bf_lo(yw.w), bf_hi(yw.w)};
                    const f32x4 z0 = acc[ai][bj][m][0] + bv[bj][0], z1 = acc[ai][bj][m][1] + bv[bj][1]; f32x4 o0, o1;
#pragma unroll
                    for (int q = 0; q < 4; ++q) { o0[q] = y0[q] * sigmoid_fast(z0[q]); o1[q] = y1[q] * sigmoid_fast(z1[q]); }
                    *(u32x4*)(cat + (size_t)row * D + col0 + bj * 128) = pack8(o0, o1); s += ssq8(o0, o1); }
                s = red_fq(s); if (fq == 0) sq[(size_t)(u.pn * 4 + wc) * T + row] = s; }
            asm volatile("" ::: "memory");
        }
    }
};
struct EpiOut {
    static constexpr bool PERM = true; static constexpr int MIDT = 16;
    const float* x; float* h1; bf16_t* a2; const float* sqs; float* sqh; LAS float* rtab; LAS float* tmp;
    __device__ __forceinline__ void prep(const pg8::Unit& u) const { prep_rtab<16, true>(sqs, T, 0, u.pm * 256, 1.f / 1024.f, rtab, tmp); }
    __device__ __forceinline__ void mid(f32x4 (&acc)[2][2][4][2], const pg8::Unit& u, int wr, int wc, int fr, int fq) const {
#pragma unroll
        for (int ai = 0; ai < 2; ++ai)
#pragma unroll
            for (int m = 0; m < 4; ++m) { const float r = rtab[ai * 128 + wr * 64 + m * 16 + fr];
#pragma unroll
                for (int bj = 0; bj < 2; ++bj) { acc[ai][bj][m][0] *= r; acc[ai][bj][m][1] *= r; } }
    }
    __device__ __forceinline__ void operator()(f32x4 (&acc)[2][2][4][2], const pg8::Unit& u, int wr, int wc, int fr, int fq) const {
        const int row0 = u.pm * 256 + wr * 64 + fr, col0 = u.pn * 256 + wc * 32 + fq * 8;
#pragma unroll
        for (int ai = 0; ai < 2; ++ai) {
            f32x4 pre[4][2][2];
#pragma unroll
            for (int m = 0; m < 4; ++m)
#pragma unroll
                for (int bj = 0; bj < 2; ++bj) { const size_t off = (size_t)(row0 + ai * 128 + m * 16) * D + col0 + bj * 128; pre[m][bj][0] = __builtin_nontemporal_load((const f32x4*)(x + off)); pre[m][bj][1] = __builtin_nontemporal_load((const f32x4*)(x + off + 4)); }
            asm volatile("" ::: "memory");
#pragma unroll
            for (int m = 0; m < 4; ++m) { const int row = row0 + ai * 128 + m * 16; float s = 0.f;
#pragma unroll
                for (int bj = 0; bj < 2; ++bj) { const size_t off = (size_t)row * D + col0 + bj * 128;
                    const f32x4 v0 = acc[ai][bj][m][0] + pre[m][bj][0], v1 = acc[ai][bj][m][1] + pre[m][bj][1];
                    *(u32x4*)(a2 + off) = pack8(v0, v1); s += ssq8(v0, v1); }
                s = red_fq(s); if (fq == 0) sqh[(size_t)(u.pn * 4 + wc) * T + row] = s; }
            asm volatile("" ::: "memory");
        }
    }
};
template <int PREP, int NPART, bool EXP2, int RES  , bool OUTF, bool OUTB, int SQM>
struct EpiGen {
    static constexpr bool PERM = true; static constexpr int MIDT = -1;
    const float* sqi; float inv_w; const float* res; float* of; bf16_t* ob; int ldo; float* sqo; LAS float* rtab; LAS float* tmp; const bf16_t* resb;
    __device__ __forceinline__ void mid(f32x4 (&)[2][2][4][2], const pg8::Unit&, int, int, int, int) const {}
    __device__ __forceinline__ void prep(const pg8::Unit& u) const { if constexpr (PREP != 0) prep_rtab<NPART, PREP == 1>(sqi, T, u.aux0, u.pm * 256, inv_w, rtab, tmp); }
    __device__ __forceinline__ void operator()(f32x4 (&acc)[2][2][4][2], const pg8::Unit& u, int wr, int wc, int fr, int fq) const {
        const int row0 = u.pm * 256 + wr * 64 + fr, col0 = u.pn * 256 + wc * 32 + fq * 8;
#pragma unroll
        for (int ai = 0; ai < 2; ++ai) {
            f32x4 pre[RES == 1 ? 4 : 1][2][2]; u32x4 preb[RES == 2 ? 4 : 1][2];
            if constexpr (RES == 1) {
#pragma unroll
                for (int m = 0; m < 4; ++m)
#pragma unroll
                    for (int bj = 0; bj < 2; ++bj) { const size_t off = (size_t)(row0 + ai * 128 + m * 16) * ldo + col0 + bj * 128; pre[m][bj][0] = *(const f32x4*)(res + off); pre[m][bj][1] = *(const f32x4*)(res + off + 4); }
                asm volatile("" ::: "memory"); }
            if constexpr (RES == 2) {
#pragma unroll
                for (int m = 0; m < 4; ++m)
#pragma unroll
                    for (int bj = 0; bj < 2; ++bj) preb[m][bj] = *(const u32x4*)(resb + (size_t)(row0 + ai * 128 + m * 16) * ldo + col0 + bj * 128);
                asm volatile("" ::: "memory"); }
#pragma unroll
            for (int m = 0; m < 4; ++m) { const int row = row0 + ai * 128 + m * 16; float s = 0.f;
                float r = 1.f; if constexpr (PREP != 0) r = rtab[ai * 128 + wr * 64 + m * 16 + fr];
#pragma unroll
                for (int bj = 0; bj < 2; ++bj) { const size_t off = (size_t)row * ldo + col0 + bj * 128;
                    f32x4 v0 = acc[ai][bj][m][0] * r, v1 = acc[ai][bj][m][1] * r;
                    if constexpr (EXP2) {
#pragma unroll
                        for (int q = 0; q < 4; ++q) { v0[q] = __builtin_amdgcn_exp2f(v0[q]); v1[q] = __builtin_amdgcn_exp2f(v1[q]); } }
                    if constexpr (RES == 1) { v0 += pre[m][bj][0]; v1 += pre[m][bj][1]; }
                    if constexpr (RES == 2) { const u32x4 w = preb[m][bj]; v0 += (f32x4){bf_lo(w.x), bf_hi(w.x), bf_lo(w.y), bf_hi(w.y)}; v1 += (f32x4){bf_lo(w.z), bf_hi(w.z), bf_lo(w.w), bf_hi(w.w)}; }
                    if constexpr (OUTF) { *(f32x4*)(of + off) = v0; *(f32x4*)(of + off + 4) = v1; }
                    if constexpr (OUTB) *(u32x4*)(ob + off) = pack8(v0, v1);
                    if constexpr (SQM == 1) s += ssq8(v0, v1);
                    if constexpr (SQM == 2) s += ((v0[0] + v0[1]) + (v0[2] + v0[3])) + ((v1[0] + v1[1]) + (v1[2] + v1[3])); }
                if constexpr (SQM != 0) { s = red_fq(s); if (fq == 0) sqo[(size_t)(u.aux1 + wc) * T + row] = s; } }
            if constexpr (RES != 0) asm volatile("" ::: "memory");
        }
    }
};

struct SchedSV {
    int G, c; const char* QX; const char* KX; const char* WO; const char* VX;
    __device__ __forceinline__ bool next(int i, pg8::Unit& u) const { const int L = i * G + c; if (L >= 256) return false;
        const int x = L & 7, h = (L >> 3) & 3, b = (L >> 5) & 3;
        if (L < 128) { u.pm = b * 8 + x; u.pn = h; u.aux0 = h * 8; u.aux1 = 0;
            u.A = QX + ((size_t)(b * SEQ + x * 256) * D + h * 512) * 2; u.B = KX + ((size_t)(b * MEM) * D + h * 512) * 2; }
        else { u.pm = b * 8 + x; u.pn = h; u.aux0 = 0; u.aux1 = 1;
            u.A = WO + ((size_t)(x * 256) * D + h * 512) * 2; u.B = VX + ((size_t)(b * MEM) * D + h * 512) * 2; }
        return true; }
};
struct EpiSV {
    static constexpr bool PERM = true; static constexpr int MIDT = -1;
    const float* sqi; bf16_t* px; bf16_t* vwt; LAS float* rtab; LAS float* tmp; LAS float* tbl;
    __device__ __forceinline__ void mid(f32x4 (&)[2][2][4][2], const pg8::Unit&, int, int, int, int) const {}
    __device__ __forceinline__ void prep(const pg8::Unit& u) const { if (u.aux1 == 0) prep_rtab<8, true>(sqi, T, u.aux0, u.pm * 256, 1.f / 512.f, rtab, tmp); }
    __device__ __forceinline__ void operator()(f32x4 (&acc)[2][2][4][2], const pg8::Unit& u, int wr, int wc, int fr, int fq) const {
        const int row0 = u.pm * 256 + wr * 64 + fr, col0 = u.pn * 256 + wc * 32 + fq * 8;
        if (u.aux1 != 0) {
#pragma unroll
            for (int ai = 0; ai < 2; ++ai)
#pragma unroll
                for (int m = 0; m < 4; ++m)
#pragma unroll
                    for (int bj = 0; bj < 2; ++bj) *(u32x4*)(vwt + (size_t)(row0 + ai * 128 + m * 16) * 1024 + col0 + bj * 128) = pack8(acc[ai][bj][m][0], acc[ai][bj][m][1]);
            return; }
#pragma unroll
        for (int ai = 0; ai < 2; ++ai)
#pragma unroll
            for (int m = 0; m < 4; ++m) { const int rl = ai * 128 + wr * 64 + m * 16 + fr; const float r = rtab[rl]; float s = 0.f;
#pragma unroll
                for (int bj = 0; bj < 2; ++bj)
#pragma unroll
                    for (int n = 0; n < 2; ++n) { f32x4 v = acc[ai][bj][m][n] * r;
#pragma unroll
                        for (int q = 0; q < 4; ++q) v[q] = __builtin_amdgcn_exp2f(v[q]);
                        acc[ai][bj][m][n] = v; s += (v[0] + v[1]) + (v[2] + v[3]); }
                s = red_fq(s); if (fq == 0) tbl[rl * 4 + wc] = s; }
        EPI_BAR();
#pragma unroll
        for (int ai = 0; ai < 2; ++ai)
#pragma unroll
            for (int m = 0; m < 4; ++m) { const int rl = ai * 128 + wr * 64 + m * 16 + fr; const f32x4 p = *(const LAS f32x4*)&tbl[rl * 4]; const float il = 1.f / ((p[0] + p[1]) + (p[2] + p[3]));
#pragma unroll
                for (int bj = 0; bj < 2; ++bj) *(u32x4*)(px + (size_t)(row0 + ai * 128 + m * 16) * 1024 + col0 + bj * 128) = pack8(acc[ai][bj][m][0] * il, acc[ai][bj][m][1] * il); }
    }
};
struct SchedPVW {
    TileOrder o; const char* A; const char* B;
    __device__ __forceinline__ bool next(int i, pg8::Unit& u) const { int pm, pn; if (!o.map(i, pm, pn)) return false;
        u.pm = pm; u.pn = pn; u.aux0 = 0; u.aux1 = pn * 4; u.A = A + (size_t)pm * 256 * 1024 * 2; u.B = B + ((size_t)(pm >> 3) * D + (size_t)pn * 256) * 1024 * 2; return true; }
};

struct SchedKV {
    int G, c; const char* MN; const char* WK; const char* WV;
    __device__ __forceinline__ bool next(int i, pg8::Unit& u) const { const int L = i * G + c; if (L >= 128) return false;
        const int pn = L & 7, pm = (L >> 3) & 3, kh = (L >> 5) & 1, wh = L >> 6;
        u.pm = pm; u.pn = pn; u.aux0 = wh * 2 + kh; u.aux1 = 0;
        u.A = MN + ((size_t)pm * 256 * D + kh * 1024) * 2; u.B = (wh ? WV : WK) + ((size_t)pn * 256 * D + kh * 1024) * 2; return true; }
};
struct EpiF32Slab {
    static constexpr bool PERM = true; static constexpr int MIDT = -1;
    float* O;
    __device__ __forceinline__ void mid(f32x4 (&)[2][2][4][2], const pg8::Unit&, int, int, int, int) const {}
    __device__ __forceinline__ void prep(const pg8::Unit&) const {}
    __device__ __forceinline__ void operator()(f32x4 (&acc)[2][2][4][2], const pg8::Unit& u, int wr, int wc, int fr, int fq) const {
        float* base = O + (size_t)u.aux0 * TM * D; const int row0 = u.pm * 256 + wr * 64 + fr, col0 = u.pn * 256 + wc * 32 + fq * 8;
#pragma unroll
        for (int ai = 0; ai < 2; ++ai)
#pragma unroll
            for (int m = 0; m < 4; ++m)
#pragma unroll
                for (int bj = 0; bj < 2; ++bj) { float* p = base + (size_t)(row0 + ai * 128 + m * 16) * D + col0 + bj * 128; *(f32x4*)p = acc[ai][bj][m][0]; *(f32x4*)(p + 4) = acc[ai][bj][m][1]; }
    }
};
__device__ __forceinline__ void kv_finish(Frame& F, const float* wq, const float* wk, int gw, int NGW) {
    const float* kf = (const float*)(F.ws + WS_QX); const float* vf = kf + (size_t)2 * TM * D;
    bf16_t* kx = (bf16_t*)(F.ws + WS_KX); bf16_t* vx = (bf16_t*)(F.ws + WS_VXT); const int lane = F.lane;
    for (int it = gw; it < TM * 4; it += NGW) { const int row = it >> 2, h = it & 3; const size_t off = (size_t)row * D + h * 512 + lane * 8;
        const f32x4 a0 = *(const f32x4*)(kf + off) + *(const f32x4*)(kf + (size_t)TM * D + off), a1 = *(const f32x4*)(kf + off + 4) + *(const f32x4*)(kf + (size_t)TM * D + off + 4);
        const f32x4 b0 = *(const f32x4*)(vf + off) + *(const f32x4*)(vf + (size_t)TM * D + off), b1 = *(const f32x4*)(vf + off + 4) + *(const f32x4*)(vf + (size_t)TM * D + off + 4);
        const float r = rsqrtf(wave_sum(ssq8(a0, a1)) * (1.f / 512.f) + EPS) * 0.04419417382415922f * 1.4426950408889634f;
        const f32x4 q0 = *(const f32x4*)(wq + lane * 8), q1 = *(const f32x4*)(wq + lane * 8 + 4), k0 = *(const f32x4*)(wk + lane * 8), k1 = *(const f32x4*)(wk + lane * 8 + 4);
        *(u32x4*)(kx + off) = pack8(a0 * r * q0 * k0, a1 * r * q1 * k1);
        *(u32x4*)(vx + off) = pack8(b0, b1); }
}

__device__ __forceinline__ void p0_prologue(Frame& F, const AV& a, int sel = 7) {
    const bool split = F.G >= 2 * NG;
    if (split) { if (F.vcu < NG) { if (sel & 1) ssm_tables(F, a, F.vcu); } } else { for (int g = F.vcu; g < NG; g += F.G) ssm_tables(F, a, g); }
    unsigned char* ws = F.ws;
    const float* w_in = a.in(3); const float* xin = a.in(0); const float* n1w = a.in(2); bf16_t* xn = (bf16_t*)(ws + WS_XN);
    if (F.vcu == F.G - 1 && F.wave == 0) {
        const int l = F.lane; float s1 = a.in(6)[l] * a.in(7)[l] + a.in(6)[l + 64] * a.in(7)[l + 64], s2 = a.in(8)[l] * a.in(9)[l] + a.in(8)[l + 64] * a.in(9)[l + 64];
        s1 = wave_sum(s1); s2 = wave_sum(s2);
        if (l == 0) ((float*)(ws + WS_TAB))[0] = (float)(exp((double)s1) - exp((double)s2) + 0.2);
    }
    unsigned* head = (unsigned*)(F.ctl + CW_CNT + 256);
    constexpr unsigned NCW = 128, NCH = NCW + T / 32;
    for (;;) {
        __syncthreads();
        if (F.tid == 0) F.MISC[16] = atomicAdd(head, 1u);
        __syncthreads();
        const unsigned c = F.MISC[16];
        if (c >= NCH) break;
        if (c < NCW) { if (sel & 2) { xpose_item(w_in, DIN, DIN, (bf16_t*)(ws + WS_W1T), D, nullptr, (int)c * 16 + F.wave * 2, F.lane); xpose_item(w_in, DIN, DIN, (bf16_t*)(ws + WS_W1T), D, nullptr, (int)c * 16 + F.wave * 2 + 1, F.lane); } }
        else if (sel & 4) { const int m = (int)(c - NCW) * 32 + F.wave * 4;
            rms_row2_to_bf16(xin + (size_t)m * D, xin + (size_t)(m + 1) * D, n1w, xn + (size_t)m * D, xn + (size_t)(m + 1) * D, F.lane);
            rms_row2_to_bf16(xin + (size_t)(m + 2) * D, xin + (size_t)(m + 3) * D, n1w, xn + (size_t)(m + 2) * D, xn + (size_t)(m + 3) * D, F.lane); }
    }
}


struct AItem { int bh, qb0, qb1; };
__device__ __forceinline__ AItem a_decode(int L) { AItem it; it.bh = L >> 2; const int x = L & 3; it.qb0 = x; it.qb1 = 7 - x; return it; }
__device__ __forceinline__ attn::BlockRef<attn::bf16, attn::bf16> a_ref(const AItem& it, int pass, unsigned char* ws) {
    const int qb = pass ? it.qb1 : it.qb0, b = it.bh >> 4, vh = it.bh & 15, h = vh >> 2, c = (vh >> 1) & 1, vhalf = vh & 1;
    attn::BlockRef<attn::bf16, attn::bf16> r;
    r.Q = (const attn::bf16*)(ws + WS_QH) + ((size_t)(b * 8 + h * 2 + c) * SEQ + (size_t)qb * 256) * 128;
    r.K = (const attn::bf16*)(ws + WS_KH) + (size_t)(b * 8 + h * 2 + c) * SEQ * 128;
    r.V = (const attn::bf16*)(ws + WS_VH) + (size_t)(b * 8 + h * 2 + vhalf) * SEQ * 128;
    r.O = (attn::bf16*)(ws + WS_OH) + ((size_t)(b * 16 + vh) * SEQ + (size_t)qb * 256) * 128;
    r.P0 = qb * 256; return r;
}
__device__ __forceinline__ void p2_attention(Frame& F, char* lds) {
    using namespace attn;
    const int total = NB * 16 * 4, stride = F.G;
    int L = F.vcu; if (L >= total) return;
    AItem it = a_decode(L); int pass = 0;
    BlockRef<bf16, bf16> cur = a_ref(it, 0, F.ws);
    Seam<bf16> S;
    causal_swa_prime<bf16, bf16>(cur, SEQ, lds, S);
    for (;;) {
        const bool more_pass = pass == 0 && it.qb1 != it.qb0, more_item = L + stride < total, last = !more_pass && !more_item;
        AItem itn = it; int passn = pass + 1, Ln = L;
        if (!more_pass) { passn = 0; Ln = more_item ? L + stride : L; itn = a_decode(Ln); }
        const BlockRef<bf16, bf16> nxt = last ? cur : a_ref(itn, passn, F.ws);
        causal_swa_block<bf16, bf16>(cur, nxt, SEQ, SEQ, lds, S);
        if (last) break;
        cur = nxt; it = itn; pass = passn; L = Ln;
    }
}
__device__ __forceinline__ void p3_combine(Frame& F, const float* subln_w, int gw, int NGW) {
    const float lam = ((const float*)(F.ws + WS_TAB))[0];
    const bf16_t* Oh = (const bf16_t*)(F.ws + WS_OH); bf16_t* cat = (bf16_t*)(F.ws + WS_CAT);
    const int lane = F.lane, vhalf = lane >> 5, d = (lane & 31) * 4;
    const f32x4 w = *(const f32x4*)(subln_w + lane * 4);
    for (int it = gw; it < T * 4; it += NGW) {
        const int t = it >> 2, h = it & 3, b = t / SEQ, s = t % SEQ;
        const u32x2 a0 = *(const u32x2*)(Oh + ((size_t)(b * 16 + h * 4 + 0 + vhalf) * SEQ + s) * 128 + d);
        const u32x2 a1 = *(const u32x2*)(Oh + ((size_t)(b * 16 + h * 4 + 2 + vhalf) * SEQ + s) * 128 + d);
        f32x4 v; v[0] = bf_lo(a0.x) - lam * bf_lo(a1.x); v[1] = bf_hi(a0.x) - lam * bf_hi(a1.x); v[2] = bf_lo(a0.y) - lam * bf_lo(a1.y); v[3] = bf_hi(a0.y) - lam * bf_hi(a1.y);
        const float ss = wave_sum((v[0] * v[0] + v[1] * v[1]) + (v[2] * v[2] + v[3] * v[3]));
        const float r = rsqrtf(ss * (1.f / 256.f) + EPS) * 0.8f;
        u32x2 o; o.x = pk2(v[0] * r * w[0], v[1] * r * w[1]); o.y = pk2(v[2] * r * w[2], v[3] * r * w[3]);
        *(u32x2*)(cat + (size_t)t * D + 1024 + h * 256 + lane * 4) = o;
    }
}

constexpr size_t MOE_REC = 0, MOE_TOK = 3 * MiB, MOE_RWL = 4 * MiB;
constexpr int MT_CNT = 64, MT_START = 128, MT_MAX = 192;

__device__ __forceinline__ void p9_router(Frame& F, const AV& a, bool commit) {
    LAS float* part = (LAS float*)F.lds;
    LAS float* logit = part + 8 * 10 * 256;
    const bf16_t* h2b = (const bf16_t*)(F.ws + WS_H1); const bf16_t* rwh = (const bf16_t*)(F.ws + WS_TAB + TAB_RWH); const bf16_t* rwl = (const bf16_t*)(F.ws + WS_TAB + TAB_RWL);
    const float* sq = (const float*)(F.ws + WS_SSQ) + SQ_H2; const float *bc = a.in(32), *bfv = a.in(34);
    unsigned* rec = (unsigned*)(F.ws + WS_MOE + MOE_REC); unsigned* cnt = (unsigned*)(F.ctl + CW_CNT);
    const int tid = F.tid, lane = tid & 63, wave = F.wave, fr = lane & 15, fq = lane >> 4;
#ifdef TLB_TOUCH
    if (commit) {
        const int loc = (F.vcu & 31) * NTHR + mk_otid();
        if (loc < 4096) { float t0_, t1_, t2_;
            asm volatile("global_load_dword %0, %1, off" : "=v"(t0_) : "v"(a.in(35) + (size_t)loc * 16384) : "memory");
            asm volatile("global_load_dword %0, %1, off" : "=v"(t1_) : "v"(a.in(36) + (size_t)loc * 16384) : "memory");
            asm volatile("global_load_dword %0, %1, off" : "=v"(t2_) : "v"(a.in(37) + (size_t)loc * 16384) : "memory");
            asm volatile("s_waitcnt vmcnt(0)" ::: "memory");
            asm volatile("" :: "v"(t0_), "v"(t1_), "v"(t2_)); } }
#endif
    for (int t0 = F.vcu * 32; t0 < T; t0 += F.G * 32) {
        f32x4 acc[2][5];
#pragma unroll
        for (int i = 0; i < 2; ++i)
#pragma unroll
            for (int c = 0; c < 5; ++c) acc[i][c] = (f32x4){0.f, 0.f, 0.f, 0.f};
#pragma unroll 2
        for (int ks = 0; ks < 8; ++ks) { const int k = wave * 256 + ks * 32 + fq * 8;
            bf16x8 xh[2];
#pragma unroll
            for (int rb = 0; rb < 2; ++rb) xh[rb] = *(const bf16x8*)(h2b + (size_t)(t0 + rb * 16 + fr) * D + k);
#pragma unroll
            for (int cb = 0; cb < 5; ++cb) { const bf16x8 wh = *(const bf16x8*)(rwh + (size_t)(cb * 16 + fr) * D + k), wl = *(const bf16x8*)(rwl + (size_t)(cb * 16 + fr) * D + k);
#pragma unroll
                for (int rb = 0; rb < 2; ++rb) { acc[rb][cb] = __builtin_amdgcn_mfma_f32_16x16x32_bf16(xh[rb], wh, acc[rb][cb], 0, 0, 0);
                    acc[rb][cb] = __builtin_amdgcn_mfma_f32_16x16x32_bf16(xh[rb], wl, acc[rb][cb], 0, 0, 0); } }
        }
        __syncthreads();
#pragma unroll
        for (int rb = 0; rb < 2; ++rb)
#pragma unroll
            for (int cb = 0; cb < 5; ++cb) *(LAS f32x4*)(part + ((wave * 10 + rb * 5 + cb) * 64 + lane) * 4) = acc[rb][cb];
        __syncthreads();
        for (int e = tid; e < 10 * 256; e += NTHR) { float s = 0.f;
#pragma unroll
            for (int w = 0; w < 8; ++w) s += part[w * 2560 + e];
            const int tile = e >> 8, ln = (e >> 2) & 63, r = e & 3, rb = tile / 5, cb = tile % 5;
            logit[(rb * 16 + 4 * (ln >> 4) + r) * 80 + cb * 16 + (ln & 15)] = s; }
        __syncthreads();
        if (tid < 32 && commit) { const int t = t0 + tid; float s = 0.f;
            for (int p = 0; p < 32; ++p) s += sq[(size_t)p * T + t];
            const float r3 = rsqrtf(s * (1.f / 2048.f) + EPS);
            const LAS float* lg = logit + tid * 80;
            int grp = 0; float lc[8];
#pragma unroll
            for (int g = 0; g < 8; ++g) { lc[g] = lg[g] * r3 + bc[g]; }
            float mx = lc[0];
#pragma unroll
            for (int g = 1; g < 8; ++g) if (lc[g] > mx) { mx = lc[g]; grp = g; }
            float se = 0.f;
#pragma unroll
            for (int g = 0; g < 8; ++g) se += __expf(lc[g] - mx);
            const float pgrp = 1.f / se;
            int j0 = 0, j1 = 0; float v0 = -3e38f, v1 = -3e38f;
            for (int j = 0; j < 8; ++j) { const float f = lg[8 + grp * 8 + j] * r3 + bfv[grp * 8 + j];
                if (f > v0) { v1 = v0; j1 = j0; v0 = f; j0 = j; } else if (f > v1) { v1 = f; j1 = j; } }
            const float e1 = __expf(v1 - v0), w0 = pgrp / (1.f + e1), w1 = pgrp * e1 / (1.f + e1);
            const int ea = grp * 8 + j0, eb = grp * 8 + j1;
            const unsigned pa = __hip_atomic_fetch_add(cnt + ea, 1u, RLX_AGENT), pb = __hip_atomic_fetch_add(cnt + eb, 1u, RLX_AGENT);
            u32x4 r0 = {(unsigned)ea, (unsigned)eb, __float_as_uint(w0), __float_as_uint(w1)}, r1 = {pa, pb, __float_as_uint(r3), 0u};
            *(u32x4*)(rec + (size_t)t * 8) = r0; *(u32x4*)(rec + (size_t)t * 8 + 4) = r1;
            { unsigned short* tokl = (unsigned short*)(F.ws + WS_MOE + MOE_TOK); float* rwl = (float*)(F.ws + WS_MOE + MOE_RWL);
              tokl[(size_t)ea * T + pa] = (unsigned short)t; tokl[(size_t)eb * T + pb] = (unsigned short)t; rwl[(size_t)ea * T + pa] = w0; rwl[(size_t)eb * T + pb] = w1; }
            logit[tid * 80 + 72] = r3; }
        __syncthreads();
        if (commit) {
            bf16_t* hn3 = (bf16_t*)(F.ws + WS_XN); const f32x4* nw = (const f32x4*)a.in(30);
            for (int q = 0; q < 4; ++q) { const int tl = wave * 4 + q, t = t0 + tl; const float r3 = logit[tl * 80 + 72]; const u32x4* src = (const u32x4*)(h2b + (size_t)t * D);
#pragma unroll
                for (int j = 0; j < 4; ++j) { const int c8 = j * 64 + lane; const u32x4 w = src[c8];
                    const f32x4 v0 = {bf_lo(w.x), bf_hi(w.x), bf_lo(w.y), bf_hi(w.y)}, v1 = {bf_lo(w.z), bf_hi(w.z), bf_lo(w.w), bf_hi(w.w)};
                    *(u32x4*)(hn3 + (size_t)t * D + c8 * 8) = pack8(v0 * r3 * nw[c8 * 2], v1 * r3 * nw[c8 * 2 + 1]); } } }
        __syncthreads();
    }
}
__device__ __forceinline__ void moe_tables(Frame& F) {
    volatile LAS unsigned* M = F.MISC; const unsigned* cnt = (const unsigned*)(F.ctl + CW_CNT);
    __syncthreads();
    if (F.tid < 64) { const unsigned c = __hip_atomic_load(cnt + F.tid, RLX_AGENT); unsigned s = c;
#pragma unroll
        for (int o = 1; o < 64; o <<= 1) { const unsigned v = __shfl_up(s, o); if ((F.tid & 63) >= o) s += v; }
        M[MT_CNT + F.tid] = c; M[MT_START + F.tid] = s - c;
        unsigned mx = c;
#pragma unroll
        for (int o = 1; o < 64; o <<= 1) { const unsigned v = __shfl_xor(mx, o); mx = v > mx ? v : mx; }
        if (F.tid == 0) M[MT_MAX] = mx; }
    __syncthreads();
}
#ifndef FG_PASS
#define FG_PASS 320
#endif
#ifndef FG_STREAM
#define FG_STREAM 0
#endif
constexpr int FG_ROWS = 320, FG_MF = 5, FG_ABUF = FG_ROWS * 128, FG_BOFF = 3 * FG_ABUF, FG_BBUF = 128 * 128;
#define FG_DMA(slot, tile) do { _Pragma("unroll") for (int i_ = 0; i_ < 10; ++i_) if (i_ < 8 || i_ < nA) \
    __builtin_amdgcn_global_load_lds((const unsigned*)(Ab + (size_t)(tile) * 128 + rowoff[i_]), (LAS unsigned*)(lds + (slot) * FG_ABUF + (i_ * 4 + wave) * 1024), 16, 0, 0); } while (0)
#define FG_BLOAD(S, tile) do { unsigned long long p_ = (unsigned long long)(bsrc + (size_t)(tile) * 64 * ldb); asm volatile("" : "+v"(p_)); _Pragma("unroll") for (int r_ = 0; r_ < 8; ++r_) \
    asm volatile("global_load_dwordx4 %0, %1, off nt" : "=v"(bst##S[r_]) : "v"(p_ + (unsigned long long)r_ * ldb * 4) : "memory"); } while (0)
#define FG_BWRITE(S, buf) do { asm volatile("" : "+v"(bst##S[0]), "+v"(bst##S[1]), "+v"(bst##S[2]), "+v"(bst##S[3]), "+v"(bst##S[4]), "+v"(bst##S[5]), "+v"(bst##S[6]), "+v"(bst##S[7])); \
    _Pragma("unroll") for (int c_ = 0; c_ < 4; ++c_) { u32x4 w_; w_.x = cvt_pk_bf16(bst##S[0][c_], bst##S[1][c_]); w_.y = cvt_pk_bf16(bst##S[2][c_], bst##S[3][c_]); \
    w_.z = cvt_pk_bf16(bst##S[4][c_], bst##S[5][c_]); w_.w = cvt_pk_bf16(bst##S[6][c_], bst##S[7][c_]); \
    *(LAS u32x4*)(lds + FG_BOFF + (buf) * FG_BBUF + (4 * nq + c_) * 128 + ((kq ^ ((4 * nq + c_) & 7)) * 16)) = w_; } } while (0)
#define FG_WAITV(n) asm volatile("s_waitcnt vmcnt(%0)" :: "n"(n) : "memory")
#define FG_WAITVA(base) do { if (nA == 10) FG_WAITV((base) + 10); else if (nA == 9) FG_WAITV((base) + 9); else FG_WAITV((base) + 8); } while (0)
#define FG_BAR() do { asm volatile("s_waitcnt lgkmcnt(0)" ::: "memory"); __builtin_amdgcn_s_barrier(); asm volatile("" ::: "memory"); } while (0)
#define FG_LSTEP(t, S0, S1) do { if ((t) < nkt) { \
    if (!(MODE & 2) && (t) + 2 < nkt) FG_DMA(((t) + 2) % 3, (t) + 2); \
    if (!(MODE & 1) && (t) + 3 < nkt) FG_BLOAD(S0, (t) + 3); \
    if ((t) + 1 < nkt) { if ((t) + 3 < nkt) { if (MODE & 2) FG_WAITV(2 * NBL); else FG_WAITVA(2 * NBL); } else if ((t) + 2 < nkt) { if (MODE & 2) FG_WAITV(NBL); else FG_WAITVA(NBL); } else FG_WAITV(0); \
        __builtin_amdgcn_sched_barrier(0); FG_BWRITE(S1, ((t) + 1) & 1); } \
    FG_BAR(); } } while (0)
template <bool ACT, int MODE = 0>
__device__ __forceinline__ void fg_unit(Frame& F, const bf16_t* A, int lda, int K, int nrows, const float* Bg, const float* Bu, int ldb, bf16_t* O, int ldo, const float* roww,
                                        const unsigned short* tokl = nullptr) {
    LAS unsigned char* lds = F.lds;
    const int nkt = K / 64;
    for (int r0 = 0; r0 < nrows; r0 += FG_PASS) {
        const int pend = (r0 + FG_PASS < nrows) ? r0 + FG_PASS : nrows;
        constexpr int NC = ACT ? 64 : 128;
        LAS unsigned short* img = (LAS unsigned short*)lds;
        if (F.wave < 4) {
            const int wave = F.wave;
            int nA = (pend - r0 - wave * 8 + 31) >> 5; nA = nA < 8 ? 8 : (nA > 10 ? 10 : nA);
#ifdef FG_NOSKIP
            nA = 10;
#endif
            const char* Ab = (const char*)A + (ACT ? (size_t)0 : (size_t)r0 * lda * 2);
            unsigned rowoff[10];
            { const int l_ = mk_otid() & 63;
#pragma unroll
              for (int i = 0; i < 10; ++i) { const int row = i * 32 + wave * 8 + (l_ >> 3); const unsigned rr = ACT ? ((r0 + row < pend) ? (unsigned)tokl[r0 + row] : 0u) : (unsigned)row;
                  rowoff[i] = (rr * (unsigned)lda + (unsigned)(((l_ & 7) ^ ((l_ >> 3) & 7)) * 8)) * 2u; } }
            const int ltid = mk_otid() & 255, kq = ltid >> 5, nq = ltid & 31;
            const float* bsrc = (ACT ? (nq < 16 ? Bg + 4 * nq : Bu + 4 * (nq - 16)) : Bg + 4 * nq) + (size_t)(8 * kq) * ldb;
            constexpr int NBL = (MODE & 1) ? 0 : 8;
            f32x4 bst0[8], bst1[8], bst2[8];
            if (!(MODE & 2)) FG_DMA(0, 0); if (!(MODE & 1)) FG_BLOAD(0, 0); if (!(MODE & 2)) FG_DMA(1, 1); if (!(MODE & 1)) { FG_BLOAD(1, 1); FG_BLOAD(2, 2); }
            if (MODE & 2) FG_WAITV(2 * NBL); else FG_WAITVA(2 * NBL);
            __builtin_amdgcn_sched_barrier(0);
            FG_BWRITE(0, 0);
            FG_BAR();
            for (int t0 = 0; t0 < nkt; t0 += 3) { FG_LSTEP(t0, 0, 1); FG_LSTEP(t0 + 1, 1, 2); FG_LSTEP(t0 + 2, 2, 0); }
        } else {
            const int cw = F.wave - 4, lane = mk_otid() & 63, fr = lane & 15, fq = lane >> 4;
            f32x4 acc[FG_MF][8];
#pragma unroll
            for (int i = 0; i < FG_MF; ++i)
#pragma unroll
                for (int j = 0; j < 8; ++j) acc[i][j] = (f32x4){0.f, 0.f, 0.f, 0.f};
            const int abase = (cw * (FG_MF * 16) + fr) * 128, bbase = FG_BOFF + fr * 128;
            const int swz0 = ((fq) ^ (fr & 7)) * 16, swz1 = ((4 + fq) ^ (fr & 7)) * 16;
            FG_BAR();
            for (int t = 0; t < nkt; ++t) {
                if (!(MODE & 4)) { LAS unsigned char* ca = lds + (t % 3) * FG_ABUF + abase; LAS unsigned char* cb = lds + (t & 1) * FG_BBUF + bbase;
#pragma unroll
                    for (int ks = 0; ks < 2; ++ks) { const int swz = ks ? swz1 : swz0; bf16x8 bf[8], af[FG_MF];
#pragma unroll
                        for (int nf = 0; nf < 8; ++nf) bf[nf] = *(const LAS bf16x8*)(cb + swz + nf * 2048);
#pragma unroll
                        for (int mf = 0; mf < FG_MF; ++mf) af[mf] = *(const LAS bf16x8*)(ca + swz + mf * 2048);
                        __builtin_amdgcn_sched_barrier(0); __builtin_amdgcn_s_setprio(1);
#pragma unroll
                        for (int mf = 0; mf < FG_MF; ++mf)
#pragma unroll
                            for (int nf = 0; nf < 8; ++nf) acc[mf][nf] = __builtin_amdgcn_mfma_f32_16x16x32_bf16(af[mf], bf[nf], acc[mf][nf], 0, 0, 0);
                        __builtin_amdgcn_s_setprio(0); __builtin_amdgcn_sched_barrier(0); } }
                FG_BAR();
            }
            if (MODE == 0) {
                constexpr int NC = ACT ? 64 : 128, RS = NC * 2 + 16, CPR = NC / 8;
                LAS unsigned char* stg = lds + FG_BOFF + FG_BBUF + cw * 4608;
#pragma unroll
                for (int mf = 0; mf < FG_MF; ++mf) {
#pragma unroll
                    for (int r = 0; r < 4; ++r) { const int rl = fq * 4 + r, row = cw * (FG_MF * 16) + mf * 16 + rl;
                        if constexpr (ACT) {
#pragma unroll
                            for (int h = 0; h < 4; ++h) { const float g = acc[mf][h][r], up = acc[mf][4 + h][r]; const float v = g * sigmoid_fast(g) * up;
                                *(LAS unsigned short*)(stg + rl * RS + (h * 16 + fr) * 2) = (unsigned short)f2bf(v); }
                        } else {
                            const float w = (r0 + row < pend) ? roww[r0 + row] : 0.f;
#pragma unroll
                            for (int nf = 0; nf < 8; ++nf) *(LAS unsigned short*)(stg + rl * RS + (nf * 16 + fr) * 2) = (unsigned short)f2bf(acc[mf][nf][r] * w);
                        }
                    }
                    asm volatile("s_waitcnt lgkmcnt(0)" ::: "memory");
#pragma unroll
                    for (int q = 0; q < (16 * CPR) / 64; ++q) { const int sidx = q * 64 + lane, rl = sidx / CPR, ch = sidx % CPR, row = cw * (FG_MF * 16) + mf * 16 + rl;
                        const u32x4 v = *(const LAS u32x4*)(stg + rl * RS + ch * 16);
                        if (r0 + row < pend) *(u32x4*)(O + (size_t)(r0 + row) * ldo + ch * 8) = v; }
                    asm volatile("s_waitcnt lgkmcnt(0)" ::: "memory");
                }
            }
        }
    }
}
template <bool ACT>
__device__ __forceinline__ void fg_stream(Frame& F, const AV& args, const int nv) {
    LAS unsigned char* lds = F.lds; unsigned char* ws = F.ws;
    constexpr int K = ACT ? D : DFF, nkt = K / 64, lda = ACT ? D : DFF, ldb = ACT ? DFF : D, ldo = ACT ? DFF : D;
    const int NT = nv * nkt, G = F.G, vcu = F.vcu;
    if (F.wave < 4) {
        const int wave = F.wave;
        const int l_ = mk_otid() & 63;
        const int ltid = mk_otid() & 255, kq = ltid >> 5, nq = ltid & 31;
        const char* Ab; unsigned rowoff[10]; unsigned rowoff1[10];
        int nA; { int nmax = 0; for (int v = 0; v < nv; ++v) { const int L = vcu + v * G, n_ = (int)F.MISC[MT_CNT + (ACT ? (L >> 3) : (L >> 4))]; nmax = n_ > nmax ? n_ : nmax; }
                  nA = (nmax - wave * 8 + 31) >> 5; nA = nA < 8 ? 8 : (nA > 10 ? 10 : nA); }
        const unsigned swz_ = (unsigned)(((l_ & 7) ^ ((l_ >> 3) & 7)) * 8);
        if constexpr (ACT) {
            Ab = (const char*)(ws + WS_XN);
            { const int e = vcu >> 3, n = (int)F.MISC[MT_CNT + e]; const unsigned short* tokl = (const unsigned short*)(ws + WS_MOE + MOE_TOK) + (size_t)e * T;
#pragma unroll
              for (int i = 0; i < 10; ++i) { const int row = i * 32 + wave * 8 + (l_ >> 3); const unsigned rr = (row < n) ? (unsigned)tokl[row] : 0u; rowoff[i] = (rr * (unsigned)lda + swz_) * 2u; } }
            if (nv > 1) { const int e = (vcu + G) >> 3, n = (int)F.MISC[MT_CNT + e]; const unsigned short* tokl = (const unsigned short*)(ws + WS_MOE + MOE_TOK) + (size_t)e * T;
#pragma unroll
              for (int i = 0; i < 10; ++i) { const int row = i * 32 + wave * 8 + (l_ >> 3); const unsigned rr = (row < n) ? (unsigned)tokl[row] : 0u; rowoff1[i] = (rr * (unsigned)lda + swz_) * 2u; } }
            else {
#pragma unroll
              for (int i = 0; i < 10; ++i) rowoff1[i] = rowoff[i]; }
        } else {
            Ab = (const char*)(ws + WS_ACT) + (size_t)F.MISC[MT_START + (vcu >> 4)] * (DFF * 2);
#pragma unroll
            for (int i = 0; i < 10; ++i) { const int row = i * 32 + wave * 8 + (l_ >> 3); rowoff[i] = ((unsigned)row * (unsigned)lda + swz_) * 2u; rowoff1[i] = 0; }
        }
#define FS_BBASE(v_) (ACT ? ((nq < 16 ? args.in(35) : args.in(36)) + (size_t)((vcu + (v_) * G) >> 3) * D * DFF + ((vcu + (v_) * G) & 7) * 64 + 4 * (nq & 15) + (size_t)(8 * kq) * ldb) \
                          : (args.in(37) + (size_t)((vcu + (v_) * G) >> 4) * DFF * D + ((vcu + (v_) * G) & 15) * 128 + 4 * nq + (size_t)(8 * kq) * ldb))
        const float* pB = FS_BBASE(0);
        int ktB = 0, vB = 0, ktA = 0, vA = 0, ktC = 0;
#define FS_BLOAD(S) do { unsigned long long p_ = (unsigned long long)pB; asm volatile("" : "+v"(p_)); _Pragma("unroll") for (int r_ = 0; r_ < 8; ++r_) \
    asm volatile("global_load_dwordx4 %0, %1, off nt" : "=v"(bst##S[r_]) : "v"(p_ + (unsigned long long)r_ * ldb * 4) : "memory"); \
    if (++ktB == nkt) { ktB = 0; ++vB; if (vB < nv) pB = FS_BBASE(vB); } else pB += (size_t)64 * ldb; } while (0)
#define FS_DMA(slot) do { FG_DMA(slot, ktA); if (++ktA == nkt) { ktA = 0; ++vA; if (vA < nv) { \
    if constexpr (ACT) { _Pragma("unroll") for (int i_ = 0; i_ < 10; ++i_) rowoff[i_] = rowoff1[i_]; } \
    else Ab = (const char*)(ws + WS_ACT) + (size_t)F.MISC[MT_START + ((vcu + vA * G) >> 4)] * (DFF * 2); } } } while (0)
#define FS_STEP(g, PH, S0, S1) do { if ((g) < NT) { \
    if ((g) + 2 < NT) FS_DMA(((PH) + 2) % 3); \
    if ((g) + 3 < NT) FS_BLOAD(S0); \
    if ((g) + 1 < NT) { if ((g) + 3 < NT) FG_WAITVA(16); else if ((g) + 2 < NT) FG_WAITVA(8); else FG_WAITV(0); \
        if (ktC == 0 && (g) > 0) FG_BAR(); \
        __builtin_amdgcn_sched_barrier(0); FG_BWRITE(S1, ((g) + 1) & 1); } \
    FG_BAR(); if (++ktC == nkt) ktC = 0; } } while (0)
        f32x4 bst0[8], bst1[8], bst2[8];
        FS_DMA(0); FS_BLOAD(0); FS_DMA(1); FS_BLOAD(1); FS_BLOAD(2);
        FG_WAITVA(16);
        __builtin_amdgcn_sched_barrier(0);
        FG_BWRITE(0, 0);
        FG_BAR();
        for (int g0 = 0; g0 < NT; g0 += 3) { FS_STEP(g0, 0, 0, 1); FS_STEP(g0 + 1, 1, 1, 2); FS_STEP(g0 + 2, 2, 2, 0); }
    } else {
        const int cw = F.wave - 4, lane = mk_otid() & 63, fr = lane & 15, fq = lane >> 4;
        const int abase = (cw * (FG_MF * 16) + fr) * 128, bbase = FG_BOFF + fr * 128;
        const int swz0 = ((fq) ^ (fr & 7)) * 16, swz1 = ((4 + fq) ^ (fr & 7)) * 16;
        int slot = 0, par = 0;
        FG_BAR();
        for (int v = 0; v < nv; ++v) {
            f32x4 acc[FG_MF][8];
#pragma unroll
            for (int i = 0; i < FG_MF; ++i)
#pragma unroll
                for (int j = 0; j < 8; ++j) acc[i][j] = (f32x4){0.f, 0.f, 0.f, 0.f};
            for (int t = 0; t < nkt; ++t) {
                { LAS unsigned char* ca = lds + slot * FG_ABUF + abase; LAS unsigned char* cb = lds + par * FG_BBUF + bbase;
#pragma unroll
                    for (int ks = 0; ks < 2; ++ks) { const int swz = ks ? swz1 : swz0; bf16x8 bf[8], af[FG_MF];
#pragma unroll
                        for (int nf = 0; nf < 8; ++nf) bf[nf] = *(const LAS bf16x8*)(cb + swz + nf * 2048);
#pragma unroll
                        for (int mf = 0; mf < FG_MF; ++mf) af[mf] = *(const LAS bf16x8*)(ca + swz + mf * 2048);
                        __builtin_amdgcn_sched_barrier(0); __builtin_amdgcn_s_setprio(1);
#pragma unroll
                        for (int mf = 0; mf < FG_MF; ++mf)
#pragma unroll
                            for (int nf = 0; nf < 8; ++nf) acc[mf][nf] = __builtin_amdgcn_mfma_f32_16x16x32_bf16(af[mf], bf[nf], acc[mf][nf], 0, 0, 0);
                        __builtin_amdgcn_s_setprio(0); __builtin_amdgcn_sched_barrier(0); } }
                FG_BAR();
                slot = (slot == 2) ? 0 : slot + 1; par ^= 1;
            }
            {
                const int lane = mk_otid() & 63, fr = lane & 15, fq = lane >> 4;
                const int L = vcu + v * G, e = ACT ? (L >> 3) : (L >> 4), ct = ACT ? (L & 7) : (L & 15);
                const int row0 = (int)F.MISC[MT_START + e], pend = (int)F.MISC[MT_CNT + e];
                bf16_t* O = ACT ? (bf16_t*)(ws + WS_ACT) + (size_t)row0 * DFF + ct * 64 : (bf16_t*)(ws + WS_YS) + (size_t)row0 * D + ct * 128;
                const float* roww = (const float*)(ws + WS_MOE + MOE_RWL) + (size_t)e * T;
                constexpr int NC = ACT ? 64 : 128, RS = NC * 2 + 16, CPR = NC / 8;
                LAS unsigned char* stg = lds + FG_BOFF + FG_BBUF + cw * 4608;
#pragma unroll
                for (int mf = 0; mf < FG_MF; ++mf) {
#pragma unroll
                    for (int r = 0; r < 4; ++r) { const int rl = fq * 4 + r, row = cw * (FG_MF * 16) + mf * 16 + rl;
                        if constexpr (ACT) {
#pragma unroll
                            for (int h = 0; h < 4; ++h) { const float g = acc[mf][h][r], up = acc[mf][4 + h][r]; const float vv = g * sigmoid_fast(g) * up;
                                *(LAS unsigned short*)(stg + rl * RS + (h * 16 + fr) * 2) = (unsigned short)f2bf(vv); }
                        } else {
                            const float w = (row < pend) ? roww[row] : 0.f;
#pragma unroll
                            for (int nf = 0; nf < 8; ++nf) *(LAS unsigned short*)(stg + rl * RS + (nf * 16 + fr) * 2) = (unsigned short)f2bf(acc[mf][nf][r] * w);
                        }
                    }
                    asm volatile("s_waitcnt lgkmcnt(0)" ::: "memory");
#pragma unroll
                    for (int q = 0; q < (16 * CPR) / 64; ++q) { const int sidx = q * 64 + lane, rl = sidx / CPR, ch = sidx % CPR, row = cw * (FG_MF * 16) + mf * 16 + rl;
                        const u32x4 vv = *(const LAS u32x4*)(stg + rl * RS + ch * 16);
                        if (row < pend) *(u32x4*)(O + (size_t)row * ldo + ch * 8) = vv; }
                    asm volatile("s_waitcnt lgkmcnt(0)" ::: "memory");
                }
            }
            if (v + 1 < nv) FG_BAR();
        }
    }
}
__device__ __forceinline__ void p13_combine(Frame& F, const AV& a, bool commit = true) {
    moe_tables(F);
    const unsigned* rec = (const unsigned*)(F.ws + WS_MOE + MOE_REC); const bf16_t* ys = (const bf16_t*)(F.ws + WS_YS);
    const int lane = F.lane;
    for (int t = F.vcu * NWAVES + F.wave; t < T; t += F.G * NWAVES) {
        const u32x4 r0 = *(const u32x4*)(rec + (size_t)t * 8), r1 = *(const u32x4*)(rec + (size_t)t * 8 + 4);
        const unsigned rowa = F.MISC[MT_START + r0.x] + r1.x, rowb = F.MISC[MT_START + r0.y] + r1.y;
        f32x4* o = (f32x4*)(a.out() + (size_t)t * D); const u32x4* hb = (const u32x4*)((const bf16_t*)(F.ws + WS_H1) + (size_t)t * D);
#pragma unroll
        for (int j = 0; j < 4; ++j) { const int c8 = j * 64 + lane;
            const u32x4 ya = *(const u32x4*)(ys + (size_t)rowa * D + c8 * 8), yb = *(const u32x4*)(ys + (size_t)rowb * D + c8 * 8), hw = hb[c8];
            f32x4 v0, v1;
            v0[0] = bf_lo(hw.x) + bf_lo(ya.x) + bf_lo(yb.x); v0[1] = bf_hi(hw.x) + bf_hi(ya.x) + bf_hi(yb.x); v0[2] = bf_lo(hw.y) + bf_lo(ya.y) + bf_lo(yb.y); v0[3] = bf_hi(hw.y) + bf_hi(ya.y) + bf_hi(yb.y);
            v1[0] = bf_lo(hw.z) + bf_lo(ya.z) + bf_lo(yb.z); v1[1] = bf_hi(hw.z) + bf_hi(ya.z) + bf_hi(yb.z); v1[2] = bf_lo(hw.w) + bf_lo(ya.w) + bf_lo(yb.w); v1[3] = bf_hi(hw.w) + bf_hi(ya.w) + bf_hi(yb.w);
            if (commit) { __builtin_nontemporal_store(v0, o + c8 * 2); __builtin_nontemporal_store(v1, o + c8 * 2 + 1); } else { asm volatile("" :: "v"(v0), "v"(v1)); } }
    }
}

__device__ __forceinline__ void mid_weight_copies(Frame& F, const AV& a, int gw, int NGW) {
    unsigned char* ws = F.ws; const float *glu_w = a.in(19), *xkv_w = a.in(26);
    constexpr int J1 = 256, J2 = J1 + 1024, J3 = J2 + 1024;
    for (int it = gw; it < J3; it += NGW) {
        if (it < J1) xpose_item(glu_w, DSSM, DSSM, (bf16_t*)(ws + WS_WGLU), DSSM, nullptr, it, F.lane);
        else if (it < J2) xpose_item(xkv_w, 4096, D, (bf16_t*)(ws + WS_WXK), D, nullptr, it - J1, F.lane);
        else xpose_item(xkv_w + 2048, 4096, D, (bf16_t*)(ws + WS_WXV), D, nullptr, it - J2, F.lane);
    }
    for (int m = gw; m < TM; m += NGW) rms_row_to_bf16(a.in(1) + (size_t)m * D, a.in(24), (bf16_t*)(ws + WS_MN) + (size_t)m * D, F.lane);
}

__device__ __forceinline__ void late_weight_copies(Frame& F, const AV& a, int gw, int NGW) {
    unsigned char* ws = F.ws; const float *ssm_out_w = a.in(21), *w_out = a.in(22), *norm2_w = a.in(23), *xq_w = a.in(25), *xo_w = a.in(29);
    constexpr int K0 = 512, K1 = K0 + 512, K2 = K1 + 1024, K3 = K2 + 1024;
    for (int it = gw; it < K3; it += NGW) {
        if (it < K0) xpose_item(w_out, D, D, (bf16_t*)(ws + WS_WOUT) + 1024, D, nullptr, it, F.lane);
        else if (it < K1) xpose_item(w_out + (size_t)1024 * D, D, D, (bf16_t*)(ws + WS_WOUT), D, ssm_out_w, it - K0, F.lane);
        else if (it < K2) xpose_item(xq_w, D, D, (bf16_t*)(ws + WS_WXQ), D, norm2_w, it - K1, F.lane);
        else xpose_item(xo_w, D, D, (bf16_t*)(ws + WS_WXO), D, nullptr, it - K2, F.lane);
    }
    const float* norm3_w = a.in(30);
    { bf16_t* rwh = (bf16_t*)(ws + WS_TAB + TAB_RWH); bf16_t* rwl = (bf16_t*)(ws + WS_TAB + TAB_RWL); const float *rc_w = a.in(31), *rf_w = a.in(33);
      for (int i = gw * 64 + F.lane; i < 80 * D; i += NGW * 64) { const int c = i / D, k = i % D; float v = c < 8 ? rc_w[k * 8 + c] : (c < 72 ? rf_w[k * 64 + c - 8] : 0.f); v *= norm3_w[k];
          const unsigned hb = f2bf(v); rwh[i] = (bf16_t)hb; rwl[i] = (bf16_t)f2bf(v - __uint_as_float(hb << 16)); } }
}


#ifdef PROBE_STREAM
__device__ __forceinline__ void stream_probe(Frame& F, const AV& args) {
    const int tid = mk_otid(), lane = tid & 63, wave = tid >> 6;
    LAS unsigned* dummy = (LAS unsigned*)(F.lds + RING_OFF + wave * 1024);
#if PROBE_STREAM == 1
    for (int L = F.vcu; L < NE * 8; L += F.G) { const int e = L >> 3, jt = L & 7;
        const char* g = (const char*)(args.in(35) + (size_t)e * D * DFF + jt * 64) + (size_t)(wave * 4 + (lane >> 4)) * (DFF * 4) + (lane & 15) * 16;
        const char* u = (const char*)(args.in(36) + (size_t)e * D * DFF + jt * 64) + (size_t)(wave * 4 + (lane >> 4)) * (DFF * 4) + (lane & 15) * 16;
        for (int kb = 0; kb < D / 32; ++kb) {
            __builtin_amdgcn_global_load_lds((const unsigned*)(g + (size_t)kb * 32 * DFF * 4), dummy, 16, 0, 0);
            __builtin_amdgcn_global_load_lds((const unsigned*)(u + (size_t)kb * 32 * DFF * 4), dummy, 16, 0, 0);
            asm volatile("s_waitcnt vmcnt(12)" ::: "memory");
        } }
#elif PROBE_STREAM == 2
    for (int L = F.vcu; L < NE * 8; L += F.G) {
        const char* g = (const char*)args.in(35) + (size_t)L * (1 << 19) + wave * 1024 + lane * 16;
        const char* u = (const char*)args.in(36) + (size_t)L * (1 << 19) + wave * 1024 + lane * 16;
        for (int kb = 0; kb < 64; ++kb) {
            __builtin_amdgcn_global_load_lds((const unsigned*)(g + (size_t)kb * 8192), dummy, 16, 0, 0);
            __builtin_amdgcn_global_load_lds((const unsigned*)(u + (size_t)kb * 8192), dummy, 16, 0, 0);
            asm volatile("s_waitcnt vmcnt(12)" ::: "memory");
        } }
#elif PROBE_STREAM == 3
    for (int L = F.vcu; L < NE * 16; L += F.G) { const int e = L >> 4, nt = L & 15;
        const char* g = (const char*)(args.in(37) + (size_t)e * DFF * D + nt * 128) + (size_t)(wave * 2 + (lane >> 5)) * (D * 4) + (lane & 31) * 16;
        for (int kb = 0; kb < DFF / 16; kb += 2) {
            __builtin_amdgcn_global_load_lds((const unsigned*)(g + (size_t)kb * 16 * D * 4), dummy, 16, 0, 0);
            __builtin_amdgcn_global_load_lds((const unsigned*)(g + (size_t)(kb + 1) * 16 * D * 4), dummy, 16, 0, 0);
            asm volatile("s_waitcnt vmcnt(12)" ::: "memory");
        } }
#elif PROBE_STREAM == 4
    for (int L = F.vcu; L < NE * 16; L += F.G) {
        const char* g = (const char*)args.in(37) + (size_t)L * (1 << 18) + wave * 1024 + lane * 16;
        for (int kb = 0; kb < 32; kb += 2) {
            __builtin_amdgcn_global_load_lds((const unsigned*)(g + (size_t)kb * 8192), dummy, 16, 0, 0);
            __builtin_amdgcn_global_load_lds((const unsigned*)(g + (size_t)(kb + 1) * 8192), dummy, 16, 0, 0);
            asm volatile("s_waitcnt vmcnt(12)" ::: "memory");
        } }
#elif PROBE_STREAM >= 5 && PROBE_STREAM <= 9
    if (wave < 4) {
    const int ltid = tid, kq = ltid >> 5, nq = ltid & 31;
    for (int L = F.vcu; L < NE * 8; L += F.G) { const int e = L >> 3, jt = L & 7;
        const float* base = (nq < 16 ? args.in(35) : args.in(36)) + (size_t)e * D * DFF + jt * 64 + (nq & 15) * 4 + (size_t)(8 * kq) * DFF;
        pg8::f32x4 s0[8], s1[8], s2[8]; pg8::f32x4 spc[8]; int spb = 0; (void)spc; (void)spb;
#define SP_LD(S, t_) { const float* bp = base + (size_t)((t_) < 32 ? (t_) : 31) * 64 * DFF; _Pragma("unroll") for (int r_ = 0; r_ < 8; ++r_) { SP_ONE(S[r_], bp + (size_t)r_ * DFF); } }
#if PROBE_STREAM == 5 || PROBE_STREAM >= 8
#define SP_ONE(v_, p_) asm volatile("global_load_dwordx4 %0, %1, off nt" : "=v"(v_) : "v"(p_) : "memory")
#elif PROBE_STREAM == 6
#define SP_ONE(v_, p_) asm volatile("global_load_dwordx4 %0, %1, off" : "=v"(v_) : "v"(p_) : "memory")
#else
#define SP_ONE(v_, p_) __builtin_amdgcn_global_load_lds((const unsigned*)(p_), dummy, 16, 0, 0)
#endif
#if PROBE_STREAM >= 9
#define SP_BAR { _Pragma("unroll") for (int c_ = 0; c_ < 4; ++c_) { u32x4 w_; w_.x = cvt_pk_bf16(spc[0][c_], spc[1][c_]); w_.y = cvt_pk_bf16(spc[2][c_], spc[3][c_]); \
    w_.z = cvt_pk_bf16(spc[4][c_], spc[5][c_]); w_.w = cvt_pk_bf16(spc[6][c_], spc[7][c_]); \
    *(LAS u32x4*)(F.lds + FG_BOFF + (spb & 1) * FG_BBUF + (4 * nq + c_) * 128 + ((kq ^ ((4 * nq + c_) & 7)) * 16)) = w_; } ++spb; \
    asm volatile("s_waitcnt lgkmcnt(0)" ::: "memory"); __builtin_amdgcn_s_barrier(); }
#elif PROBE_STREAM >= 8
#define SP_BAR __builtin_amdgcn_s_barrier();
#else
#define SP_BAR
#endif
#if PROBE_STREAM >= 9
#define SP_USE(S) { _Pragma("unroll") for (int r_ = 0; r_ < 8; ++r_) { asm volatile("" : "+v"(S[r_])); spc[r_] = S[r_]; } }
#else
#define SP_USE(S) { _Pragma("unroll") for (int r_ = 0; r_ < 8; ++r_) asm volatile("" :: "v"(S[r_])); }
#endif
        SP_LD(s0, 0) SP_LD(s1, 1)
        for (int t = 0; t < 33; t += 3) {
            SP_LD(s2, t + 2) asm volatile("s_waitcnt vmcnt(16)" ::: "memory"); SP_USE(s0) SP_BAR
            SP_LD(s0, t + 3) asm volatile("s_waitcnt vmcnt(16)" ::: "memory"); SP_USE(s1) SP_BAR
            SP_LD(s1, t + 4) asm volatile("s_waitcnt vmcnt(16)" ::: "memory"); SP_USE(s2) SP_BAR
        }
        asm volatile("s_waitcnt vmcnt(0)" ::: "memory"); SP_USE(s0) SP_USE(s1)
        }
    }
#if PROBE_STREAM >= 8
    else { for (int L = F.vcu; L < NE * 8; L += F.G) for (int t = 0; t < 33; ++t) __builtin_amdgcn_s_barrier(); }
#endif
#elif PROBE_STREAM == 10 || PROBE_STREAM == 11 || PROBE_STREAM == 12
    LAS unsigned char* lds = F.lds;
    const char* Ab = (const char*)(F.ws + WS_XN);
    constexpr int lda = D;
    if (wave < 4) {
        const int ltid = tid, kq = ltid >> 5, nq = ltid & 31;
#if PROBE_STREAM == 10 || PROBE_STREAM == 12
        unsigned rowoff[10];
#endif
        for (int L = F.vcu; L < NE * 8; L += F.G) { const int e = L >> 3, jt = L & 7;
#if PROBE_STREAM == 10 || PROBE_STREAM == 12
#pragma unroll
            for (int i = 0; i < 10; ++i) { const int row = i * 32 + wave * 8 + (lane >> 3); const unsigned rr = (unsigned)((e * 128 + row * 25) & 8191);
                rowoff[i] = (rr * (unsigned)lda + (unsigned)(((lane & 7) ^ ((lane >> 3) & 7)) * 8)) * 2u; }
#define SPA_DMA(t_) FG_DMA(((t_) % 3), ((t_) < 32 ? (t_) : 31));
#define SPA_N 10
#else
#define SPA_DMA(t_)
#define SPA_N 0
#endif
            const float* base = (nq < 16 ? args.in(35) : args.in(36)) + (size_t)e * D * DFF + jt * 64 + (nq & 15) * 4 + (size_t)(8 * kq) * DFF;
            f32x4 s0[8], s1[8], s2[8]; f32x4 spc[8]; int spb = 0;
#if PROBE_STREAM == 12
#define SQ_LD(S, t_) { _Pragma("unroll") for (int r_ = 0; r_ < 8; ++r_) S[r_] = (f32x4){0.f, 0.f, 0.f, 0.f}; }
#undef FG_WAITV
#define FG_WAITV(n) asm volatile("s_waitcnt vmcnt(10)" ::: "memory")
#else
#define SQ_LD(S, t_) { const float* bp = base + (size_t)((t_) < 32 ? (t_) : 31) * 64 * DFF; _Pragma("unroll") for (int r_ = 0; r_ < 8; ++r_) { asm volatile("global_load_dwordx4 %0, %1, off nt" : "=v"(S[r_]) : "v"(bp + (size_t)r_ * DFF) : "memory"); } }
#endif
#define SQ_USE(S) { _Pragma("unroll") for (int r_ = 0; r_ < 8; ++r_) { asm volatile("" : "+v"(S[r_])); spc[r_] = S[r_]; } }
#define SQ_BAR { _Pragma("unroll") for (int c_ = 0; c_ < 4; ++c_) { u32x4 w_; w_.x = cvt_pk_bf16(spc[0][c_], spc[1][c_]); w_.y = cvt_pk_bf16(spc[2][c_], spc[3][c_]); \
    w_.z = cvt_pk_bf16(spc[4][c_], spc[5][c_]); w_.w = cvt_pk_bf16(spc[6][c_], spc[7][c_]); \
    *(LAS u32x4*)(lds + FG_BOFF + (spb & 1) * FG_BBUF + (4 * nq + c_) * 128 + ((kq ^ ((4 * nq + c_) & 7)) * 16)) = w_; } ++spb; \
    asm volatile("s_waitcnt lgkmcnt(0)" ::: "memory"); __builtin_amdgcn_s_barrier(); }
            SPA_DMA(0) SQ_LD(s0, 0) SPA_DMA(1) SQ_LD(s1, 1)
            for (int t = 0; t < 33; t += 3) {
                SPA_DMA(t + 2) SQ_LD(s2, t + 2) FG_WAITV(16 + SPA_N); SQ_USE(s0) SQ_BAR
                SPA_DMA(t + 3) SQ_LD(s0, t + 3) FG_WAITV(16 + SPA_N); SQ_USE(s1) SQ_BAR
                SPA_DMA(t + 4) SQ_LD(s1, t + 4) FG_WAITV(16 + SPA_N); SQ_USE(s2) SQ_BAR
            }
            asm volatile("s_waitcnt vmcnt(0)" ::: "memory"); SQ_USE(s0) SQ_USE(s1)
        }
    } else {
#if PROBE_STREAM == 11
        const int wave_hi = wave;
        { const int wave = wave_hi - 4; unsigned rowoff[10];
        for (int L = F.vcu; L < NE * 8; L += F.G) { const int e = L >> 3;
#pragma unroll
            for (int i = 0; i < 10; ++i) { const int row = i * 32 + wave * 8 + (lane >> 3); const unsigned rr = (unsigned)((e * 128 + row * 25) & 8191);
                rowoff[i] = (rr * (unsigned)lda + (unsigned)(((lane & 7) ^ ((lane >> 3) & 7)) * 8)) * 2u; }
            FG_DMA(0, 0); FG_DMA(1, 1);
            for (int t = 0; t < 33; ++t) { FG_DMA(((t + 2) % 3), ((t + 2) < 32 ? (t + 2) : 31)); FG_WAITV(10); __builtin_amdgcn_s_barrier(); }
            asm volatile("s_waitcnt vmcnt(0)" ::: "memory");
        } }
#else
        for (int L = F.vcu; L < NE * 8; L += F.G) for (int t = 0; t < 33; ++t) __builtin_amdgcn_s_barrier();
#endif
    }
#endif
    asm volatile("s_waitcnt vmcnt(0)" ::: "memory");
    __syncthreads();
}
#endif

__global__ void __launch_bounds__(NTHR, 2) mk_fwd(Args args_by_value) {
    (void)args_by_value;
    AV args; args.kp = (kptr_t)__builtin_amdgcn_kernarg_segment_ptr();
    extern __shared__ __attribute__((aligned(16))) unsigned char lds[];
    Frame F;
    F.lds = (LAS unsigned char*)lds;
    F.MISC = (volatile LAS unsigned*)(F.lds + MISC_OFF);
    F.tid = threadIdx.x; F.lane = F.tid & 63; F.wave = __builtin_amdgcn_readfirstlane(F.tid >> 6);
    F.G = gridDim.x; { const int bx = blockIdx.x; F.vcu = (F.G % 8 == 0) ? (bx % 8) * (F.G / 8) + bx / 8 : bx; }
    F.ws = args.ws(); F.ctl = (gu32*)(F.ws + WS_CTL);
    for (int u = F.tid; u < (LDS_BYTES - MISC_OFF) / 4; u += NTHR) ((LAS unsigned*)(F.lds + MISC_OFF))[u] = 0u;
    __syncthreads();
    XcdBarrier bar = xcd_barrier_post((unsigned*)(F.ctl + CW_BAR), F.MISC + 8);
    { unsigned long long pc0; asm volatile("s_getpc_b64 %0" : "=s"(pc0)); bar.code = (const char*)(pc0 & ~127ull); bar.loc = F.vcu & 31; }
    const int lo = args.ph_lo(), hi = args.ph_hi();
#ifndef PROBE_MASK
#define PROBE_MASK 0
#define PROBE_EXTRA 0
#endif
#ifndef PROBE_MODE
#define PROBE_MODE 0
#endif
#define IN(k) (lo <= (k) && (k) < hi)
#define BOTH(k) (IN(k) && IN((k) + 1))
#define GRID_BAR() xcd_barrier(bar)
    unsigned char* ws = F.ws;
#ifdef TS_A
    unsigned long long ts_a = 0, ts_b = 0;
#define TSREC(k) if ((k) == TS_A) ts_a = __builtin_amdgcn_s_memrealtime(); if ((k) == TS_B) ts_b = __builtin_amdgcn_s_memrealtime();
#else
#define TSREC(k)
#endif
    TSREC(0) if (IN(0)) for (int rep_ = 0; rep_ < (((PROBE_MASK >> 0) & 1) ? 1 + PROBE_EXTRA : 1); ++rep_) { F.tid = mk_otid(); F.lane = F.tid & 63; p0_prologue(F, args, (rep_ < (((PROBE_MASK >> 0) & 1) ? PROBE_EXTRA : 0)) ? PROBE_MODE : 7); } if (BOTH(0)) GRID_BAR();
    TSREC(1) if (IN(1)) for (int rep_ = 0; rep_ < (((PROBE_MASK >> 1) & 1) ? 1 + PROBE_EXTRA : 1); ++rep_) { F.tid = mk_otid(); F.lane = F.tid & 63;
        pg8::Gemm g{D, D, D}; PlainSched S; S.init((const bf16_t*)(ws + WS_XN), D, (const bf16_t*)(ws + WS_W1T), D, T, DIN, F.G, (int)blockIdx.x);
        EpiG1 E{(bf16_t*)(ws + WS_QH), (bf16_t*)(ws + WS_KH), (bf16_t*)(ws + WS_VH), (bf16_t*)(ws + WS_U), args.in(4), args.in(5), (LAS float*)(F.lds + EPI_TBL)};
        pg8::gemm_phase<EpiG1, PlainSched>(F.lds + RING_OFF, g, S, E);
    } if (BOTH(1)) GRID_BAR();
#ifdef PROBE_XBAR
    for (int xb_ = 0; xb_ < PROBE_XBAR; ++xb_) GRID_BAR();
#endif
    TSREC(2) if (IN(2)) for (int rep_ = 0; rep_ < (((PROBE_MASK >> 2) & 1) ? 1 + PROBE_EXTRA : 1); ++rep_) { F.tid = mk_otid(); F.lane = F.tid & 63; if (rep_ == 0 || PROBE_MODE != 9) p2_attention(F, (char*)lds + RING_OFF);
        if (rep_ == 0 || PROBE_MODE != 8) for (int L = F.vcu; L < NB * NG; L += F.G) ssm_unit(F, L & 3, L >> 2);
        if (rep_ == 0) mid_weight_copies(F, args, F.vcu * NWAVES + F.wave, F.G * NWAVES);
        } if (BOTH(2)) GRID_BAR();
    TSREC(3) if (IN(3)) for (int rep_ = 0; rep_ < (((PROBE_MASK >> 3) & 1) ? 1 + PROBE_EXTRA : 1); ++rep_) { F.tid = mk_otid(); F.lane = F.tid & 63;
        p3_combine(F, args.in(10), F.vcu * NWAVES + F.wave, F.G * NWAVES);
        float* ssq = (float*)(ws + WS_SSQ); const int G = F.G, bx = (int)blockIdx.x;
        if (rep_ == 0) late_weight_copies(F, args, F.vcu * NWAVES + F.wave, G * NWAVES);
        { pg8::Gemm g{DSSM, DSSM, DSSM}; PlainSched S; S.init((const bf16_t*)(ws + WS_YG), DSSM, (const bf16_t*)(ws + WS_WGLU), DSSM, T, DSSM, G, bx);
          EpiGlu E{(const bf16_t*)(ws + WS_YG), args.in(20), (bf16_t*)(ws + WS_CAT), ssq + SQ_S};
          pg8::gemm_phase<EpiGlu, PlainSched>(F.lds + RING_OFF, g, S, E); }
        { pg8::Gemm g{1024, D, D}; SchedKV S{G, (bx + G - (128 % G)) % G, (const char*)(ws + WS_MN), (const char*)(ws + WS_WXK), (const char*)(ws + WS_WXV)};
          EpiF32Slab E{(float*)(ws + WS_QX)};
          pg8::gemm_phase<EpiF32Slab, SchedKV>(F.lds + RING_OFF, g, S, E); }
        } if (BOTH(3)) GRID_BAR();
    TSREC(4) if (IN(4)) for (int rep_ = 0; rep_ < (((PROBE_MASK >> 4) & 1) ? 1 + PROBE_EXTRA : 1); ++rep_) { F.tid = mk_otid(); F.lane = F.tid & 63;
        if (rep_ == (((PROBE_MASK >> 4) & 1) ? PROBE_EXTRA : 0)) kv_finish(F, args.in(27), args.in(28), F.vcu * NWAVES + F.wave, F.G * NWAVES);
        float* ssq = (float*)(ws + WS_SSQ);
        pg8::Gemm g{D, D, D}; PlainSched S; S.init((const bf16_t*)(ws + WS_CAT), D, (const bf16_t*)(ws + WS_WOUT), D, T, D, F.G, (int)blockIdx.x);
        EpiOut E{args.in(0), (float*)(ws + WS_H1), (bf16_t*)(ws + WS_XN), ssq + SQ_S, ssq + SQ_H1, (LAS float*)(F.lds + RTAB_OFF), (LAS float*)(F.lds + EPI_TBL)};
        pg8::gemm_phase<EpiOut, PlainSched>(F.lds + RING_OFF, g, S, E);
        } if (BOTH(4)) GRID_BAR();

    TSREC(5) if (IN(5)) for (int rep_ = 0; rep_ < (((PROBE_MASK >> 5) & 1) ? 1 + PROBE_EXTRA : 1); ++rep_) { F.tid = mk_otid(); F.lane = F.tid & 63;
        float* ssq = (float*)(ws + WS_SSQ);
        pg8::Gemm g{D, D, D}; PlainSched S; S.init((const bf16_t*)(ws + WS_XN), D, (const bf16_t*)(ws + WS_WXQ), D, T, D, F.G, (int)blockIdx.x);
        typedef EpiGen<1, 32, false, 0, false, true, 1> E5;
        E5 E{ssq + SQ_H1, 1.f / 2048.f, nullptr, nullptr, (bf16_t*)(ws + WS_QX), D, ssq + SQ_QX, (LAS float*)(F.lds + RTAB_OFF), (LAS float*)(F.lds + EPI_TBL), nullptr};
        struct S5 { PlainSched s; __device__ __forceinline__ bool next(int i, pg8::Unit& u) const { if (!s.next(i, u)) return false; u.aux1 = u.pn * 4; return true; } } S5v{S};
        pg8::gemm_phase<E5, S5>(F.lds + RING_OFF, g, S5v, E);
        } if (BOTH(5)) GRID_BAR();
    TSREC(6) if (IN(6)) for (int rep_ = 0; rep_ < (((PROBE_MASK >> 6) & 1) ? 1 + PROBE_EXTRA : 1); ++rep_) { F.tid = mk_otid(); F.lane = F.tid & 63;
        float* ssq = (float*)(ws + WS_SSQ);
        pg8::Gemm g{512, D, D}; SchedSV S{F.G, F.vcu, (const char*)(ws + WS_QX), (const char*)(ws + WS_KX), (const char*)(ws + WS_WXO), (const char*)(ws + WS_VXT)};
        EpiSV E{ssq + SQ_QX, (bf16_t*)(ws + WS_PX), (bf16_t*)(ws + WS_OX), (LAS float*)(F.lds + RTAB_OFF), (LAS float*)(F.lds + EPI_TBL + 4096), (LAS float*)(F.lds + EPI_TBL)};
        pg8::gemm_phase<EpiSV, SchedSV>(F.lds + RING_OFF, g, S, E);
        } if (BOTH(6)) GRID_BAR();
    TSREC(8) if (IN(8)) for (int rep_ = 0; rep_ < (((PROBE_MASK >> 8) & 1) ? 1 + PROBE_EXTRA : 1); ++rep_) { F.tid = mk_otid(); F.lane = F.tid & 63;
        float* ssq = (float*)(ws + WS_SSQ);
        pg8::Gemm g{1024, 1024, 1024}; SchedPVW S; S.o.init(T / 256, D / 256, F.G, (int)blockIdx.x); S.A = (const char*)(ws + WS_PX); S.B = (const char*)(ws + WS_OX);
        typedef EpiGen<0, 4, false, 2, false, true, 1> E8;
        E8 E{nullptr, 0.f, nullptr, nullptr, (bf16_t*)(ws + WS_H1), D, ssq + SQ_H2, (LAS float*)(F.lds + RTAB_OFF), (LAS float*)(F.lds + EPI_TBL), (const bf16_t*)(ws + WS_XN)};
        pg8::gemm_phase<E8, SchedPVW>(F.lds + RING_OFF, g, S, E);
        } if (BOTH(8)) GRID_BAR();
    TSREC(9) if (IN(9)) for (int rep_ = 0; rep_ < (((PROBE_MASK >> 9) & 1) ? 1 + PROBE_EXTRA : 1); ++rep_) { F.tid = mk_otid(); F.lane = F.tid & 63; p9_router(F, args, rep_ == (((PROBE_MASK >> 9) & 1) ? PROBE_EXTRA : 0)); } if (BOTH(9)) GRID_BAR();
    TSREC(11) if (IN(11)) for (int rep_ = 0; rep_ < (((PROBE_MASK >> 11) & 1) ? 1 + PROBE_EXTRA : 1); ++rep_) { F.tid = mk_otid(); F.lane = F.tid & 63;
        moe_tables(F);
        { const int nv_ = (NE * 8 - F.vcu + F.G - 1) / F.G;
          if (!(rep_ < (((PROBE_MASK >> 11) & 1) ? PROBE_EXTRA : 0) && PROBE_MODE != 0) && FG_STREAM && (int)F.MISC[MT_MAX] <= FG_ROWS && nv_ <= 2 && FG_PASS == FG_ROWS) fg_stream<true>(F, args, nv_); else
        for (int L = F.vcu; L < NE * 8; L += F.G) { const int e = L >> 3, jt = L & 7; const int row0 = (int)F.MISC[MT_START + e], n = (int)F.MISC[MT_CNT + e];
            const unsigned short* tokl = (const unsigned short*)(ws + WS_MOE + MOE_TOK) + (size_t)e * T;
            if (rep_ < (((PROBE_MASK >> 11) & 1) ? PROBE_EXTRA : 0)) fg_unit<true, PROBE_MODE>(F, (const bf16_t*)(ws + WS_XN), D, D, n, args.in(35) + (size_t)e * D * DFF + jt * 64, args.in(36) + (size_t)e * D * DFF + jt * 64, DFF,
                          (bf16_t*)(ws + WS_ACT) + (size_t)row0 * DFF + jt * 64, DFF, nullptr, tokl);
            else fg_unit<true>(F, (const bf16_t*)(ws + WS_XN), D, D, n, args.in(35) + (size_t)e * D * DFF + jt * 64, args.in(36) + (size_t)e * D * DFF + jt * 64, DFF,
                          (bf16_t*)(ws + WS_ACT) + (size_t)row0 * DFF + jt * 64, DFF, nullptr, tokl); } }
        } if (BOTH(11)) GRID_BAR();
    TSREC(12) if (IN(12)) for (int rep_ = 0; rep_ < (((PROBE_MASK >> 12) & 1) ? 1 + PROBE_EXTRA : 1); ++rep_) { F.tid = mk_otid(); F.lane = F.tid & 63;
        moe_tables(F);
        { const int nv_ = (NE * 16 - F.vcu + F.G - 1) / F.G;
          if (!(rep_ < (((PROBE_MASK >> 12) & 1) ? PROBE_EXTRA : 0) && PROBE_MODE != 0) && FG_STREAM && (int)F.MISC[MT_MAX] <= FG_ROWS && FG_PASS == FG_ROWS) fg_stream<false>(F, args, nv_); else
        for (int L = F.vcu; L < NE * 16; L += F.G) { const int e = L >> 4, nt = L & 15; const int row0 = (int)F.MISC[MT_START + e], n = (int)F.MISC[MT_CNT + e];
            if (rep_ < (((PROBE_MASK >> 12) & 1) ? PROBE_EXTRA : 0)) fg_unit<false, PROBE_MODE>(F, (const bf16_t*)(ws + WS_ACT) + (size_t)row0 * DFF, DFF, DFF, n, args.in(37) + (size_t)e * DFF * D + nt * 128, nullptr, D,
                           (bf16_t*)(ws + WS_YS) + (size_t)row0 * D + nt * 128, D, (const float*)(ws + WS_MOE + MOE_RWL) + (size_t)e * T);
            else fg_unit<false>(F, (const bf16_t*)(ws + WS_ACT) + (size_t)row0 * DFF, DFF, DFF, n, args.in(37) + (size_t)e * DFF * D + nt * 128, nullptr, D,
                           (bf16_t*)(ws + WS_YS) + (size_t)row0 * D + nt * 128, D, (const float*)(ws + WS_MOE + MOE_RWL) + (size_t)e * T); } }
        } if (BOTH(12)) GRID_BAR();
    TSREC(13) if (IN(13)) for (int rep_ = 0; rep_ < (((PROBE_MASK >> 13) & 1) ? 1 + PROBE_EXTRA : 1); ++rep_) { F.tid = mk_otid(); F.lane = F.tid & 63; p13_combine(F, args, rep_ == (((PROBE_MASK >> 13) & 1) ? PROBE_EXTRA : 0)); }
#ifdef TS_A
    TSREC(14)
    { const unsigned long long dl = (ts_b - ts_a) * TS_MULT, t0 = __builtin_amdgcn_s_memrealtime();
      while (__builtin_amdgcn_s_memrealtime() - t0 < dl) __builtin_amdgcn_s_sleep(8); }
#endif
#ifdef PROBE_STREAM
    GRID_BAR();
    for (int rep_ = 0; rep_ < PROBE_EXTRA; ++rep_) { stream_probe(F, args); }
#endif
#undef IN
#undef BOTH
}
}

extern "C" void kernel_launch(void* const* d_in, const int* in_sizes, int n_in, void* d_out, int out_size, void* d_ws, size_t ws_size, hipStream_t stream) {
    static int grid = 0;
    if (grid == 0) {
        if (n_in != 38 || out_size != mk::T * mk::D || ws_size < mk::WS_END) { fprintf(stderr, "kernel_launch: unexpected shapes (n_in %d, out %d, ws %zu)\n", n_in, out_size, ws_size); grid = -1; return; }
        int dev = 0, cus = 0; (void)hipGetDevice(&dev); (void)hipDeviceGetAttribute(&cus, hipDeviceAttributeMultiprocessorCount, dev);
        (void)hipFuncSetAttribute((const void*)mk::mk_fwd, hipFuncAttributeMaxDynamicSharedMemorySize, mk::LDS_BYTES);
        int per_cu = 0; (void)hipOccupancyMaxActiveBlocksPerMultiprocessor(&per_cu, (const void*)mk::mk_fwd, mk::NTHR, mk::LDS_BYTES);
        (void)hipGetLastError();
        grid = cus > 0 ? cus : 256;
        if (per_cu < 1) { fprintf(stderr, "kernel_launch: occupancy query reports %d blocks per CU; nothing launched\n", per_cu); grid = -1; return; }
    }
    if (grid < 0) return;
    (void)hipMemsetAsync((char*)d_ws + mk::WS_CTL, 0, mk::CTL_ZERO_BYTES, stream);
    mk::Args a{}; for (int i = 0; i < 38; ++i) a.in[i] = (const float*)d_in[i]; a.out = (float*)d_out; a.ws = (unsigned char*)d_ws; a.ph_lo = 0; a.ph_hi = 14;
    hipLaunchKernelGGL(mk::mk_fwd, dim3(grid), dim3(mk::NTHR), mk::LDS_BYTES, stream, a);
}
```

```cpp
#include <hip/hip_runtime.h>
#include <hip/hip_bf16.h>
#include <cstdio>
#include <cstdint>
#include <cstddef>
#include <cmath>
__device__ __forceinline__ int mk_otid() { int t = threadIdx.x; asm volatile("" : "+v"(t)); return t; }

namespace pg8 {
#define PG8_LAS __attribute__((address_space(3)))
typedef unsigned short bf16_t;
typedef short bf16x8 __attribute__((ext_vector_type(8)));
typedef float f32x4 __attribute__((ext_vector_type(4)));
typedef float f32x2 __attribute__((ext_vector_type(2)));
typedef unsigned u32x4 __attribute__((ext_vector_type(4)));
typedef unsigned u32x2 __attribute__((ext_vector_type(2)));
constexpr int BM = 256, BK = 64, HALF = 128, HTB = HALF * BK * 2, STAGE_BYTES = 8 * HTB;

__host__ __device__ __forceinline__ int lds_byte(int r, int c) { const int st = (r >> 4) * 2 + (c >> 5), rr = r & 15, cc = c & 31, ob = rr * 64 + cc * 2; return st * 1024 + (ob ^ (((ob >> 9) & 1) << 5)); }
__host__ __device__ __forceinline__ void stage_rc(int b, int& R, int& C) { const int st = b / 1024, sb = b % 1024, swz = sb ^ (((sb >> 9) & 1) << 5); R = (st >> 1) * 16 + swz / 64; C = (st & 1) * 32 + (swz % 64) / 2; }
__host__ __device__ __forceinline__ int perm32(int rho) { const int n = rho >> 4, i = rho & 15; return 8 * (i >> 2) + 4 * n + (i & 3); }

struct Unit { const char* A; const char* B; int pm, pn, aux0, aux1; };
struct Gemm { int K, lda, ldb; };

__device__ __forceinline__ unsigned cvt_pk_bf16(float lo, float hi) { unsigned r; asm volatile("v_cvt_pk_bf16_f32 %0, %1, %2" : "=v"(r) : "v"(lo), "v"(hi)); return r; }
__device__ __forceinline__ float bf_lo(unsigned w) { return __uint_as_float(w << 16); }
__device__ __forceinline__ float bf_hi(unsigned w) { return __uint_as_float(w & 0xffff0000u); }

template <class Epi, class Sched, bool SP2 = true>
__device__ __forceinline__ void gemm_phase(PG8_LAS unsigned char* lds, const Gemm g, const Sched& S, const Epi& E) {
    const int tid = mk_otid(), wid = __builtin_amdgcn_readfirstlane(tid >> 6), lane = tid & 63, wr = wid >> 2, wc = wid & 3, fr = lane & 15, fq = lane >> 4;
    const int K = g.K, nt = K / BK;
    unsigned voffA[2], voffB[2];
#pragma unroll
    for (int i = 0; i < 2; ++i) { int R, C; stage_rc(tid * 16 + i * 8192, R, C); const int Rb = Epi::PERM ? ((R & ~31) + perm32(R & 31)) : R;
        voffA[i] = (unsigned)(R * g.lda + C) * 2u; voffB[i] = (unsigned)(Rb * g.ldb + C) * 2u; }
    const size_t kstep = (size_t)(BK * 2);
    const size_t hstepA = (size_t)HALF * g.lda * 2, hstepB = (size_t)HALF * g.ldb * 2;
    const unsigned ldsw = (unsigned)wid * 1024u;
    const int aoff = lds_byte(wr * 64 + fr, fq * 8), boff = lds_byte(wc * 32 + fr, fq * 8);
#define PG8_SA(b, h) (((b) * 2 + (h)) * HTB)
#define PG8_SB(b, h) ((4 + (b) * 2 + (h)) * HTB)
#define PG8_STAGE(bufoff, gbase, voff) do { _Pragma("unroll") for (int _i = 0; _i < 2; ++_i) \
        __builtin_amdgcn_global_load_lds((const unsigned*)((const char*)(gbase) + (voff)[_i]), (PG8_LAS unsigned*)(lds + (bufoff) + ldsw + _i * 8192), 16, 0, 0); } while (0)
#define PG8_LDA(dst, b, h) do { _Pragma("unroll") for (int m = 0; m < 4; ++m) _Pragma("unroll") for (int k = 0; k < 2; ++k) dst[m][k] = *(const PG8_LAS bf16x8*)(lds + PG8_SA(b, h) + aoff + m * 2048 + k * 1024); } while (0)
#define PG8_LDB(dst, b, h) do { _Pragma("unroll") for (int n = 0; n < 2; ++n) _Pragma("unroll") for (int k = 0; k < 2; ++k) dst[n][k] = *(const PG8_LAS bf16x8*)(lds + PG8_SB(b, h) + boff + n * 2048 + k * 1024); } while (0)
#define PG8_MMA(ai, bj, At, Bt) do { __builtin_amdgcn_s_setprio(1); _Pragma("unroll") for (int m = 0; m < 4; ++m) _Pragma("unroll") for (int n = 0; n < 2; ++n) _Pragma("unroll") for (int k = 0; k < 2; ++k) \
        acc[ai][bj][m][n] = __builtin_amdgcn_mfma_f32_16x16x32_bf16(Bt[n][k], At[m][k], acc[ai][bj][m][n], 0, 0, 0); __builtin_amdgcn_s_setprio(0); } while (0)
#define PG8_WAIT_V(n) asm volatile("s_waitcnt vmcnt(" #n ")" ::: "memory")
#define PG8_WAIT_L(n) asm volatile("s_waitcnt lgkmcnt(" #n ")" ::: "memory")
#define PG8_BAR __builtin_amdgcn_s_barrier()
#define PG8_SCHED __builtin_amdgcn_sched_barrier(0)
    Unit cur, nxt; int ui = 0;
    if (!S.next(0, cur)) return;
    f32x4 acc[2][2][4][2];
#pragma unroll
    for (int a = 0; a < 2; ++a)
#pragma unroll
        for (int b = 0; b < 2; ++b)
#pragma unroll
            for (int m = 0; m < 4; ++m)
#pragma unroll
                for (int n = 0; n < 2; ++n) acc[a][b][m][n] = (f32x4){0.f, 0.f, 0.f, 0.f};
    bf16x8 At[4][2], B0[2][2], B1[2][2];
    const char* cA = cur.A; const char* cB = cur.B;
    E.prep(cur);
    if constexpr (SP2) {
        PG8_STAGE(PG8_SB(0, 0), cB, voffB); PG8_STAGE(PG8_SB(0, 1), cB + hstepB, voffB); PG8_STAGE(PG8_SA(0, 0), cA, voffA); PG8_STAGE(PG8_SA(0, 1), cA + hstepA, voffA);
        if (wr == 1) PG8_BAR;
        PG8_WAIT_V(2); PG8_BAR;
        PG8_STAGE(PG8_SB(1, 0), cB + kstep, voffB); PG8_STAGE(PG8_SA(1, 0), cA + kstep, voffA); PG8_STAGE(PG8_SB(1, 1), cB + hstepB + kstep, voffB);
        PG8_WAIT_V(6); PG8_BAR;
    } else {
        PG8_STAGE(PG8_SB(0, 0), cB, voffB); PG8_STAGE(PG8_SA(0, 0), cA, voffA); PG8_STAGE(PG8_SB(0, 1), cB + hstepB, voffB); PG8_STAGE(PG8_SA(0, 1), cA + hstepA, voffA);
        if (wr == 1) PG8_BAR;
        PG8_WAIT_V(4); PG8_BAR;
        PG8_STAGE(PG8_SB(1, 0), cB + kstep, voffB); PG8_STAGE(PG8_SA(1, 0), cA + kstep, voffA); PG8_STAGE(PG8_SB(1, 1), cB + hstepB + kstep, voffB);
        PG8_WAIT_V(6); PG8_BAR;
    }
    for (;;) {
        const bool has_next = S.next(ui + 1, nxt);
        const char* nA = has_next ? nxt.A : cA; const char* nB = has_next ? nxt.B : cB;
        for (int t = 0; t < nt; t += 2) {
            const bool last = (t == nt - 2);
            const char* a1 = cA + (size_t)(t + 1) * kstep;
            const char* a2 = last ? nA : cA + (size_t)(t + 2) * kstep; const char* b2 = last ? nB : cB + (size_t)(t + 2) * kstep;
            const char* a3 = a2 + kstep; const char* b3 = b2 + kstep;
            if constexpr (Epi::MIDT >= 0) { if (t == Epi::MIDT) { int fr_ = fr, fq_ = fq; asm volatile("" : "+v"(fr_), "+v"(fq_)); E.mid(acc, cur, wr, wc, fr_, fq_); } }
            if constexpr (SP2) {
            PG8_LDB(B0, 0, 0); PG8_LDB(B1, 0, 1); PG8_SCHED; PG8_LDA(At, 0, 0); PG8_STAGE(PG8_SA(1, 1), a1 + hstepA, voffA);
            PG8_WAIT_V(8); PG8_WAIT_L(0); PG8_BAR; PG8_MMA(0, 0, At, B0); PG8_MMA(0, 1, At, B1); PG8_BAR; PG8_SCHED;
            PG8_LDA(At, 0, 1); PG8_STAGE(PG8_SB(0, 0), b2, voffB); PG8_STAGE(PG8_SB(0, 1), b2 + hstepB, voffB); PG8_STAGE(PG8_SA(0, 0), a2, voffA);
            PG8_WAIT_V(8); PG8_WAIT_L(0); PG8_BAR; PG8_MMA(1, 0, At, B0); PG8_MMA(1, 1, At, B1); PG8_BAR; PG8_SCHED;
            PG8_LDB(B0, 1, 0); PG8_LDB(B1, 1, 1); PG8_SCHED; PG8_LDA(At, 1, 0); PG8_STAGE(PG8_SA(0, 1), a2 + hstepA, voffA);
            PG8_WAIT_V(8); PG8_WAIT_L(0); PG8_BAR; PG8_MMA(0, 0, At, B0); PG8_MMA(0, 1, At, B1); PG8_BAR; PG8_SCHED;
            PG8_LDA(At, 1, 1); PG8_STAGE(PG8_SB(1, 0), b3, voffB); PG8_STAGE(PG8_SB(1, 1), b3 + hstepB, voffB); PG8_STAGE(PG8_SA(1, 0), a3, voffA);
            PG8_WAIT_V(8); PG8_WAIT_L(0); PG8_BAR; PG8_MMA(1, 0, At, B0); PG8_MMA(1, 1, At, B1); PG8_BAR; PG8_SCHED;
            } else {
            PG8_LDB(B0, 0, 0); PG8_SCHED; PG8_LDA(At, 0, 0); PG8_STAGE(PG8_SA(1, 1), a1 + hstepA, voffA);
            PG8_WAIT_L(8); PG8_BAR; PG8_WAIT_L(0); PG8_MMA(0, 0, At, B0); PG8_BAR; PG8_SCHED;
            PG8_LDB(B1, 0, 1); PG8_STAGE(PG8_SB(0, 0), b2, voffB);
            PG8_BAR; PG8_WAIT_L(0); PG8_MMA(0, 1, At, B1); PG8_BAR;
            PG8_LDA(At, 0, 1); PG8_STAGE(PG8_SA(0, 0), a2, voffA);
            PG8_BAR; PG8_WAIT_L(0); PG8_MMA(1, 0, At, B0); PG8_BAR; PG8_SCHED;
            PG8_STAGE(PG8_SB(0, 1), b2 + hstepB, voffB);
            PG8_WAIT_V(6); PG8_BAR; PG8_MMA(1, 1, At, B1); PG8_BAR;
            PG8_LDB(B0, 1, 0); PG8_SCHED; PG8_LDA(At, 1, 0); PG8_STAGE(PG8_SA(0, 1), a2 + hstepA, voffA);
            PG8_WAIT_L(8); PG8_BAR; PG8_WAIT_L(0); PG8_MMA(0, 0, At, B0); PG8_BAR; PG8_SCHED;
            PG8_LDB(B1, 1, 1); PG8_STAGE(PG8_SB(1, 0), b3, voffB);
            PG8_BAR; PG8_WAIT_L(0); PG8_MMA(0, 1, At, B1); PG8_BAR;
            PG8_LDA(At, 1, 1); PG8_STAGE(PG8_SA(1, 0), a3, voffA);
            PG8_BAR; PG8_WAIT_L(0); PG8_MMA(1, 0, At, B0); PG8_BAR; PG8_SCHED;
            PG8_STAGE(PG8_SB(1, 1), b3 + hstepB, voffB);
            PG8_WAIT_V(6); PG8_BAR; PG8_MMA(1, 1, At, B1); PG8_BAR;
            }
        }
        if (wr == 0) PG8_BAR;
        { int fr_ = fr, fq_ = fq; asm volatile("" : "+v"(fr_), "+v"(fq_));
          E(acc, cur, wr, wc, fr_, fq_); }
        if (!has_next) break;
        E.prep(nxt);
#pragma unroll
        for (int a = 0; a < 2; ++a)
#pragma unroll
            for (int b = 0; b < 2; ++b)
#pragma unroll
                for (int m = 0; m < 4; ++m)
#pragma unroll
                    for (int n = 0; n < 2; ++n) acc[a][b][m][n] = (f32x4){0.f, 0.f, 0.f, 0.f};
        cur = nxt; cA = nA; cB = nB; ++ui;
        if (wr == 1) PG8_BAR;
    }
    PG8_WAIT_V(0);
    PG8_BAR;
#undef PG8_SA
#undef PG8_SB
#undef PG8_STAGE
#undef PG8_LDA
#undef PG8_LDB
#undef PG8_MMA
#undef PG8_WAIT_V
#undef PG8_WAIT_L
#undef PG8_SCHED
}
}

namespace attn {
constexpr int D = 128;
constexpr float THR = 8.f;
constexpr bool WSKIP = false;
constexpr float SCALE = 0.08838834764831845f;
constexpr int NW = 8, QBLK = 32, KVBLK = 64, QB = NW * QBLK;
constexpr int SHM_V = KVBLK * D * 2, SHM_K = KVBLK * D * 2;
constexpr int LDS_BYTES = 2 * SHM_V + 2 * SHM_K + NW * 64 * 4;

using bf16 = __hip_bfloat16;
typedef short bf16x8 __attribute__((ext_vector_type(8)));
typedef short s16x4 __attribute__((ext_vector_type(4)));
typedef float f32x16 __attribute__((ext_vector_type(16)));
typedef float f32x4 __attribute__((ext_vector_type(4)));
typedef unsigned u32x4 __attribute__((ext_vector_type(4)));
template <class A, class Bt> struct same_t { static constexpr bool v = false; };
template <class A> struct same_t<A, A> { static constexpr bool v = true; };

#define KSWZ(row, colB) ((row) * 256 + ((colB) ^ (((row) & 7) << 4)))
#define SBAR() __builtin_amdgcn_sched_barrier(0)
__device__ __forceinline__ int v_st(int k, int c) { const int kk = (k & ~0xC) | ((k & 4) << 1) | ((k & 8) >> 1); return ((kk >> 3) * 4 + (c >> 5)) * 512 + ((kk & 7) * 32 + (c & 31)) * 2; }
__device__ __forceinline__ int v_rd_base(int lane) { return ((lane & 3) << 3) | (((lane >> 2) & 3) << 6) | (((lane >> 4) & 1) << 5) | (((lane >> 5) & 1) << 8); }
constexpr int v_rd_off(int d0, int ks, int half) { return d0 * 512 + ks * 4096 + half * 2048; }
__device__ __forceinline__ int crow(int r, int hi) { return (r & 3) + 8 * (r >> 2) + 4 * hi; }
__device__ __forceinline__ unsigned cvtpk(float lo, float hi) {
    unsigned r; asm volatile("v_cvt_pk_bf16_f32 %0, %1, %2" : "=v"(r) : "v"(lo), "v"(hi)); return r;
}
__device__ __forceinline__ bf16x8 pack8(f32x4 a, f32x4 b) {
    u32x4 w = {cvtpk(a[0], a[1]), cvtpk(a[2], a[3]), cvtpk(b[0], b[1]), cvtpk(b[2], b[3])};
    return *reinterpret_cast<bf16x8*>(&w);
}
template <class T> __device__ __forceinline__ bf16x8 load8(const T* p) {
    if constexpr (same_t<T, float>::v) { return pack8(*(const f32x4*)p, *(const f32x4*)(p + 4)); }
    else { return *reinterpret_cast<const bf16x8*>(p); }
}
__device__ __forceinline__ void mask_tile(f32x16& p0, f32x16& p1, int dq, unsigned W) {
    const float NEG = -__builtin_inff();
#pragma unroll
    for (int r = 0; r < 16; ++r) {
        const int c = (r & 3) + 8 * (r >> 2);
        if ((unsigned)(dq - c) >= W) p0[r] = NEG;
        if ((unsigned)(dq - c - 32) >= W) p1[r] = NEG;
    }
}
__device__ __forceinline__ void partialSM(f32x16& p0, f32x16& p1, float& m_reg, float& mn, float& alpha) {
    float pmax = p0[0]; for (int r = 1; r < 16; ++r) pmax = fmaxf(pmax, p0[r]); for (int r = 0; r < 16; ++r) pmax = fmaxf(pmax, p1[r]);
    { auto rr = __builtin_amdgcn_permlane32_swap(__float_as_uint(pmax), __float_as_uint(pmax), false, false);
      pmax = fmaxf(__uint_as_float(rr[0]), __uint_as_float(rr[1])); }
    constexpr float C2 = 1.4426950408889634f * SCALE;
    if (__builtin_expect(__all((pmax - m_reg) * SCALE <= THR), 1)) { mn = m_reg; alpha = 1.f; }
    else { mn = fmaxf(m_reg, pmax); alpha = __builtin_amdgcn_exp2f((m_reg - mn) * C2); m_reg = mn; }
    const float mnL = -mn * C2;
    for (int r = 0; r < 16; ++r) p0[r] = fmaf(p0[r], C2, mnL); for (int r = 0; r < 16; ++r) p1[r] = fmaf(p1[r], C2, mnL);
    for (int r = 0; r < 16; ++r) p0[r] = __builtin_amdgcn_exp2f(p0[r]);
}
__device__ __forceinline__ void finishSM(f32x16& p0, f32x16& p1, float alpha, float& l_reg, bf16x8& pa0, bf16x8& pa1, bf16x8& pa2, bf16x8& pa3) {
    for (int r = 0; r < 16; ++r) p1[r] = __builtin_amdgcn_exp2f(p1[r]);
    float ps = 0; for (int r = 0; r < 16; ++r) ps += p0[r]; for (int r = 0; r < 16; ++r) ps += p1[r];
    { auto rr = __builtin_amdgcn_permlane32_swap(__float_as_uint(ps), __float_as_uint(ps), false, false);
      ps = __uint_as_float(rr[0]) + __uint_as_float(rr[1]); }
    l_reg = l_reg * alpha + ps;
#define PK4(P, B_, OUT) do { unsigned a0 = cvtpk(P[B_+0], P[B_+1]), a1 = cvtpk(P[B_+2], P[B_+3]);                          \
        unsigned b0 = cvtpk(P[B_+4], P[B_+5]), b1 = cvtpk(P[B_+6], P[B_+7]);                                             \
        auto r0 = __builtin_amdgcn_permlane32_swap(a0, b0, false, false); auto r1 = __builtin_amdgcn_permlane32_swap(a1, b1, false, false); \
        u32x4 w = {r0[0], r1[0], r0[1], r1[1]}; OUT = *reinterpret_cast<bf16x8*>(&w); } while (0)
    PK4(p0, 0, pa0); PK4(p0, 8, pa1); PK4(p1, 0, pa2); PK4(p1, 8, pa3);
#undef PK4
}
template <int KB, bool SK>
__device__ __forceinline__ void qkt(f32x16& p0, f32x16& p1, const char* K_lds, int r32, int hi, const bf16x8* qr, bool act) {
    if (SK && !act) { const float NEG = -__builtin_inff();
#pragma unroll
        for (int r = 0; r < 16; ++r) { p0[r] = NEG; p1[r] = NEG; } return; }
    p0 = f32x16{}; p1 = f32x16{};
    const char* kb[4];
#pragma unroll
    for (int dd = 0; dd < 4; ++dd) kb[dd] = K_lds + KB * SHM_K + KSWZ(r32, (dd * 16 + hi * 8) * 2);
#pragma unroll
    for (int d0 = 0; d0 < 8; ++d0) { const char* a = kb[d0 & 3] + (d0 >> 2) * 128;
        bf16x8 b0 = *reinterpret_cast<const bf16x8*>(a);
        bf16x8 b1 = *reinterpret_cast<const bf16x8*>(a + 32 * 256);
        p0 = __builtin_amdgcn_mfma_f32_32x32x16_bf16(b0, qr[d0], p0, 0, 0, 0);
        p1 = __builtin_amdgcn_mfma_f32_32x32x16_bf16(b1, qr[d0], p1, 0, 0, 0); }
}
template <int VB, bool SK>
__device__ __forceinline__ void pv_tile(f32x16* o, int vb0, bf16x8 pa0, bf16x8 pa1, bf16x8 pa2, bf16x8 pa3, bool act) {
    if (SK && !act) return;
#define TRRD(dst, off) asm volatile("ds_read_b64_tr_b16 %0, %1 offset:%2" : "=&v"(dst) : "v"(vb0), "i"(off) : "memory")
#define PV_D0(d0) do { s16x4 l0, l1, l2, l3, h0, h1, h2, h3; constexpr int b_ = VB * SHM_V + v_rd_off(d0, 0, 0);     \
        TRRD(l0, b_); TRRD(h0, b_ + 2048); TRRD(l1, b_ + 4096); TRRD(h1, b_ + 6144); TRRD(l2, b_ + 8192); TRRD(h2, b_ + 10240); TRRD(l3, b_ + 12288); TRRD(h3, b_ + 14336); \
        asm volatile("s_waitcnt lgkmcnt(0)" ::: "memory"); SBAR();                 \
        o[d0] = __builtin_amdgcn_mfma_f32_32x32x16_bf16(pa0, (bf16x8){l0[0], l0[1], l0[2], l0[3], h0[0], h0[1], h0[2], h0[3]}, o[d0], 0, 0, 0);   \
        o[d0] = __builtin_amdgcn_mfma_f32_32x32x16_bf16(pa1, (bf16x8){l1[0], l1[1], l1[2], l1[3], h1[0], h1[1], h1[2], h1[3]}, o[d0], 0, 0, 0);   \
        o[d0] = __builtin_amdgcn_mfma_f32_32x32x16_bf16(pa2, (bf16x8){l2[0], l2[1], l2[2], l2[3], h2[0], h2[1], h2[2], h2[3]}, o[d0], 0, 0, 0);   \
        o[d0] = __builtin_amdgcn_mfma_f32_32x32x16_bf16(pa3, (bf16x8){l3[0], l3[1], l3[2], l3[3], h3[0], h3[1], h3[2], h3[3]}, o[d0], 0, 0, 0); } while (0)
    PV_D0(0); PV_D0(1); PV_D0(2); PV_D0(3);
#undef PV_D0
#undef TRRD
}

template <class TIn, class TOut> struct BlockRef { const TIn* Q; const TIn* K; const TIn* V; TOut* O; int P0; };
template <class TIn> struct Seam {
    bf16x8 qr[8];
    bf16x8 st_v0, st_v1, st_k0, st_k1; f32x4 sf0, sf1, sf2, sf3;
    f32x4 tq[16];
};
__device__ __forceinline__ int swa_jlo(int P0, int W) { const int lowk = P0 - W + 1; return lowk > 0 ? lowk / KVBLK : 0; }
#define ROW(p, k0, rr) ((p) + (size_t)((k0) + (rr)) * D + sc)
#define VMW() asm volatile("s_waitcnt vmcnt(0)" ::: "memory")
#define VMWN(n) asm volatile("s_waitcnt vmcnt(%0)" :: "i"(n) : "memory")
#define SLOAD_H(Kp, Vp, k0) do { S.st_v0 = load8<TIn>(ROW(Vp, k0, sr)); S.st_v1 = load8<TIn>(ROW(Vp, k0, 32 + sr));              \
                         S.st_k0 = load8<TIn>(ROW(Kp, k0, sr)); S.st_k1 = load8<TIn>(ROW(Kp, k0, 32 + sr)); } while (0)
#define SWRITE_HK(bf) do { *(bf16x8*)(K_lds + (bf) * SHM_K + kws) = S.st_k0; *(bf16x8*)(K_lds + (bf) * SHM_K + kws + 32 * 256) = S.st_k1; } while (0)
#define SWRITE_HV(bf) do { *(bf16x8*)(V_lds + (bf) * SHM_V + vst0) = S.st_v0; *(bf16x8*)(V_lds + (bf) * SHM_V + vst1) = S.st_v1; } while (0)
#define SWRITE_H(bf) do { SWRITE_HV(bf); SWRITE_HK(bf); } while (0)
#define SLOAD_F(p, k0) do { S.sf0 = *(const f32x4*)ROW(p, k0, sr); S.sf1 = *(const f32x4*)(ROW(p, k0, sr) + 4);                \
                            S.sf2 = *(const f32x4*)ROW(p, k0, 32 + sr); S.sf3 = *(const f32x4*)(ROW(p, k0, 32 + sr) + 4); } while (0)
#define SWRITE_KF(bf) do { *(bf16x8*)(K_lds + (bf) * SHM_K + kws) = pack8(S.sf0, S.sf1); *(bf16x8*)(K_lds + (bf) * SHM_K + kws + 32 * 256) = pack8(S.sf2, S.sf3); } while (0)
#define SWRITE_VF(bf) do { *(bf16x8*)(V_lds + (bf) * SHM_V + vst0) = pack8(S.sf0, S.sf1); *(bf16x8*)(V_lds + (bf) * SHM_V + vst1) = pack8(S.sf2, S.sf3); } while (0)
template <class TIn, class TOut>
__device__ __forceinline__ void causal_swa_prime(const BlockRef<TIn, TOut>& cur, int W, char* lds, Seam<TIn>& S) {
    constexpr bool F32 = same_t<TIn, float>::v;
    const int tid = mk_otid(), wid = __builtin_amdgcn_readfirstlane(tid >> 6), lane = tid & 63, r32 = lane & 31, hi = lane >> 5;
    const int sr = tid >> 4, sc = (tid & 15) * 8, kws = KSWZ(sr, sc * 2); char* K_lds = lds + 2 * SHM_V;
    const int kb0 = swa_jlo(cur.P0, W) * KVBLK;
    for (int d0 = 0; d0 < 8; ++d0) S.qr[d0] = load8<TIn>(cur.Q + (size_t)(wid * QBLK + r32) * D + d0 * 16 + hi * 8);
    if constexpr (F32) { SLOAD_F((const float*)cur.K, kb0); VMW(); SWRITE_KF(0); SBAR(); SLOAD_F((const float*)cur.V, kb0); }
    else { SLOAD_H(cur.K, cur.V, kb0); VMW(); SWRITE_HK(0); }
    __syncthreads();
}
template <class TIn, class TOut>
__device__ __forceinline__ void causal_swa_block(const BlockRef<TIn, TOut>& cur, const BlockRef<TIn, TOut>& nxt, int skv, int W, char* lds, Seam<TIn>& S) {
    constexpr bool F32 = same_t<TIn, float>::v;
    const int tid = mk_otid(), wid = __builtin_amdgcn_readfirstlane(tid >> 6), lane = tid & 63, r32 = lane & 31, hi = lane >> 5;
    const int j_lo = swa_jlo(cur.P0, W);
    int j_hi = (cur.P0 + QB - 1) / KVBLK + 1; if (j_hi > skv / KVBLK) j_hi = skv / KVBLK;
    const int NT = j_hi - j_lo;
    const int kbn = swa_jlo(nxt.P0, W) * KVBLK;
    const int qlo = cur.P0 + wid * QBLK, qm = qlo + r32 - 4 * hi;
    char* V_lds = lds; char* K_lds = lds + 2 * SHM_V;
    float* ws = (float*)(lds + 2 * SHM_V + 2 * SHM_K) + wid * 64; float* li_l = ws, * al_l = ws + 32;
    float m_reg = -1e30f, l_reg = 0; f32x16 o[4] = {};
    const int sr = tid >> 4, sc = (tid & 15) * 8, vst0 = v_st(sr, sc), vst1 = v_st(32 + sr, sc), kws = KSWZ(sr, sc * 2);
    const int vb0 = (int)(uintptr_t)V_lds + v_rd_base(lane);
    const TIn* Kh = cur.K; const TIn* Vh = cur.V;
#define RESC(a) do { if (__any((a) < 1.f)) { if (hi == 0) al_l[r32] = (a); asm volatile("s_waitcnt lgkmcnt(0)" ::: "memory");              \
                     for (int d_ = 0; d_ < 4; ++d_) for (int r = 0; r < 16; ++r) o[d_][r] *= al_l[crow(r, hi)]; } } while (0)
#define KBASE(t) ((j_lo + (t)) * KVBLK)
#define ACT(t) (KBASE(t) <= qlo + QBLK - 1 && KBASE(t) + KVBLK - 1 >= qlo - W + 1)
#define MASKT(P0_, P1_, t) do { const int kb_ = KBASE(t); if ((!SK || ACT(t)) && (kb_ + KVBLK - 1 > qlo || kb_ <= qlo + QBLK - 1 - W)) mask_tile(P0_, P1_, qm - kb_, (unsigned)W); } while (0)
    constexpr int NQL = F32 ? 16 : 8;
    constexpr bool SK = WSKIP && !F32;
#define SEAM_K0() do { VMWN(NQL); if constexpr (F32) { SWRITE_KF(0); SBAR(); SLOAD_F((const float*)nxt.V, kbn); } else { SWRITE_HK(0); } SBAR(); } while (0)
    f32x16 pA0, pA1, pB0, pB1; float mnA, mnB, alA, alB; bf16x8 pa0, pa1, pa2, pa3;
    if constexpr (F32) { VMW(); SWRITE_VF(0); SBAR(); } else { SWRITE_HV(0); SBAR(); }
    if (NT > 1) { if constexpr (F32) SLOAD_F((const float*)Kh, KBASE(1)); else SLOAD_H(Kh, Vh, KBASE(1)); }
    SBAR(); qkt<0, SK>(pA0, pA1, K_lds, r32, hi, S.qr, ACT(0));
    if constexpr (F32) { if (NT > 1) { VMW(); SWRITE_KF(1); SBAR(); SLOAD_F((const float*)Vh, KBASE(1)); } }
    MASKT(pA0, pA1, 0); partialSM(pA0, pA1, m_reg, mnA, alA);
    if (NT > 1) { VMW(); if constexpr (F32) { SWRITE_VF(1); SBAR(); if (NT > 2) SLOAD_F((const float*)Kh, KBASE(2)); } else SWRITE_H(1); }
    __syncthreads();
#define HALF_STEP(PX0, PX1, mnX, alX, PY0, PY1, alY, t, KB, VB, SB) do {                                                      \
        SBAR(); qkt<KB, SK>(PX0, PX1, K_lds, r32, hi, S.qr, ACT(t));                                             \
        finishSM(PY0, PY1, alY, l_reg, pa0, pa1, pa2, pa3); SBAR();                                                           \
        if ((t) + 1 < NT) { if constexpr (F32) { VMW(); SWRITE_KF(SB); SBAR(); SLOAD_F((const float*)Vh, KBASE((t) + 1)); }  \
                            else { SLOAD_H(Kh, Vh, KBASE((t) + 1)); } SBAR(); }                                               \
        pv_tile<VB, SK>(o, vb0, pa0, pa1, pa2, pa3, ACT((t) - 1)); MASKT(PX0, PX1, (t)); partialSM(PX0, PX1, m_reg, mnX, alX);                                        \
        __syncthreads();                                                                                                      \
        if ((t) + 1 < NT) { VMW(); if constexpr (F32) { SWRITE_VF(SB); SBAR(); if ((t) + 2 < NT) SLOAD_F((const float*)Kh, KBASE((t) + 2)); } \
                            else { SWRITE_H(SB); } }                                                                          \
        RESC(alX); __syncthreads(); } while (0)
    for (int t = 1; t + 1 < NT; t += 2) {
        HALF_STEP(pB0, pB1, mnB, alB, pA0, pA1, alA, t, 1, 0, 0);
        HALF_STEP(pA0, pA1, mnA, alA, pB0, pB1, alB, t + 1, 0, 1, 1);
    }
    const bool even = (NT & 1) == 0;
    if (even) { SBAR(); qkt<1, SK>(pB0, pB1, K_lds, r32, hi, S.qr, ACT(NT - 1)); SBAR(); }
#define QROW(e) (nxt.Q + (size_t)(wid * QBLK + r32) * D + ((e) >> 1) * 16 + hi * 8 + ((e) & 1) * 4)
    if constexpr (F32) { SLOAD_F((const float*)nxt.K, kbn); SBAR();
#pragma unroll
        for (int e = 0; e < 8; ++e) S.tq[e] = *(const f32x4*)QROW(e); }
    else { SLOAD_H(nxt.K, nxt.V, kbn); SBAR();
#pragma unroll
        for (int d0 = 0; d0 < 8; ++d0) S.qr[d0] = load8<TIn>(nxt.Q + (size_t)(wid * QBLK + r32) * D + d0 * 16 + hi * 8); }
    SBAR();
    finishSM(pA0, pA1, alA, l_reg, pa0, pa1, pa2, pa3); SBAR();
    if constexpr (F32) {
#pragma unroll
        for (int e = 8; e < 16; ++e) S.tq[e] = *(const f32x4*)QROW(e); SBAR(); }
#undef QROW
    pv_tile<0, SK>(o, vb0, pa0, pa1, pa2, pa3, ACT(even ? NT - 2 : NT - 1));
    if (even) { MASKT(pB0, pB1, NT - 1); partialSM(pB0, pB1, m_reg, mnB, alB); __syncthreads(); RESC(alB);
        finishSM(pB0, pB1, alB, l_reg, pa0, pa1, pa2, pa3); SBAR(); pv_tile<1, SK>(o, vb0, pa0, pa1, pa2, pa3, ACT(NT - 1)); }
    SBAR(); SEAM_K0();
    if (hi == 0) li_l[r32] = l_reg; asm volatile("s_waitcnt lgkmcnt(0)" ::: "memory");
    float rli[16];
#pragma unroll
    for (int r = 0; r < 16; ++r) rli[r] = __builtin_amdgcn_rcpf(li_l[crow(r, hi)]);
    TOut* Ow = cur.O + (size_t)(wid * QBLK) * D;
#pragma unroll
    for (int r = 0; r < 16; ++r) { const int orow = crow(r, hi);
#pragma unroll
        for (int d0 = 0; d0 < 4; ++d0) { const float v = o[d0][r] * rli[r];
            if constexpr (same_t<TOut, float>::v) { Ow[(size_t)orow * D + d0 * 32 + r32] = v; }
            else { const float vn = __shfl_xor(v, 1);
                   if ((r32 & 1) == 0) *(unsigned*)(Ow + (size_t)orow * D + d0 * 32 + r32) = cvtpk(v, vn); } } }
    if constexpr (F32) {
#pragma unroll
        for (int d0 = 0; d0 < 8; ++d0) S.qr[d0] = pack8(S.tq[2 * d0], S.tq[2 * d0 + 1]); }
    __syncthreads();
#undef RESC
#undef KBASE
#undef ACT
#undef MASKT
#undef SEAM_K0
#undef HALF_STEP
}
#undef ROW
#undef VMW
#undef VMWN
#undef SLOAD_H
#undef SWRITE_HK
#undef SWRITE_HV
#undef SWRITE_H
#undef SLOAD_F
#undef SWRITE_KF
#undef SWRITE_VF
}

namespace mk {
using pg8::bf16_t; using pg8::f32x4; using pg8::f32x2; using pg8::u32x4; using pg8::u32x2; using pg8::bf16x8; using pg8::cvt_pk_bf16; using pg8::bf_lo; using pg8::bf_hi;
#define GAS __attribute__((address_space(1)))
#define LAS __attribute__((address_space(3)))
typedef GAS unsigned gu32;
#define RLX_AGENT __ATOMIC_RELAXED, __HIP_MEMORY_SCOPE_AGENT
#define LDS_WAIT() asm volatile("s_waitcnt lgkmcnt(0)" ::: "memory")
#define VM_WAIT() asm volatile("s_waitcnt vmcnt(0)" ::: "memory")

constexpr int NWAVES = 8, NTHR = 512;
constexpr int D = 2048, NB = 4, SEQ = 2048, T = NB * SEQ, MEM = 256, TM = NB * MEM;
constexpr int DIN = 4096, DSSM = 1024, NG = 64, NP = 64, NH = 16, NE = 64, DFF = 512;
constexpr float EPS = 1e-6f;

constexpr size_t MiB = 1u << 20;
constexpr size_t WS_CTL = 0, CTL_ZERO_BYTES = 1 * MiB;
constexpr size_t WS_TAB = 1 * MiB;
constexpr size_t WS_SSQ = 2 * MiB;
constexpr size_t WS_MOE = 10 * MiB;
constexpr size_t WS_KX = 18 * MiB, WS_VXT = 22 * MiB;
constexpr size_t WS_SSMT = 26 * MiB;
constexpr size_t WS_WXO = 26 * MiB;
constexpr size_t WS_XN = 42 * MiB;
constexpr size_t WS_WXK = 42 * MiB, WS_WXV = 50 * MiB;
constexpr size_t WS_MN = 58 * MiB;
constexpr size_t WS_WGLU = 62 * MiB;
constexpr size_t WS_QH = 74 * MiB, WS_KH = 90 * MiB;
constexpr size_t WS_CAT = 74 * MiB;
constexpr size_t WS_H1 = 74 * MiB;
constexpr size_t WS_VH = 106 * MiB, WS_U = 122 * MiB;
constexpr size_t WS_QX = 106 * MiB;
constexpr size_t WS_ACT = 106 * MiB;
constexpr size_t WS_OH = 138 * MiB;
constexpr size_t WS_YG = 170 * MiB;
constexpr size_t WS_W1T = 186 * MiB;
constexpr size_t WS_WOUT = 186 * MiB;
constexpr size_t WS_WXQ = 194 * MiB;
constexpr size_t WS_PX = 138 * MiB;
constexpr size_t WS_OX = 154 * MiB;
constexpr size_t WS_YS = 138 * MiB;
constexpr size_t WS_END = 204 * MiB;
constexpr size_t SQ_S = 0;
constexpr size_t SQ_H1 = 16 * (size_t)T;
constexpr size_t SQ_QX = 48 * (size_t)T;
constexpr size_t SQ_L = 80 * (size_t)T;
constexpr size_t SQ_H2 = 96 * (size_t)T;
constexpr size_t SQ_KX = 128 * (size_t)T;
constexpr int CW_BAR = 4096;
constexpr int CW_CNT = 16384;

constexpr int RING_OFF = 0, RING_BYTES = 131072;
constexpr int EPI_TBL = 131072;
constexpr int RTAB_OFF = 157696;
constexpr int MISC_OFF = 158720;
constexpr int LDS_BYTES = 163840;

__device__ __forceinline__ unsigned f2bf(float f) { unsigned u = __builtin_bit_cast(unsigned, f); return (u + 0x7fffu + ((u >> 16) & 1u)) >> 16; }
__device__ __forceinline__ unsigned pk2(float lo, float hi) { return f2bf(lo) | (f2bf(hi) << 16); }
__device__ __forceinline__ float wave_sum(float v) {
#pragma unroll
    for (int o = 1; o < 64; o <<= 1) v += __shfl_xor(v, o);
    return v;
}

#define XB_TMO      128
#define XB_XCNT(j)  (256  + 64 * (j))
#define XB_XSUB(j)  (1280 + 64 * (j))
#define XB_XGEN(j)  (2304 + 64 * (j))
#define XB_TOP      3328
#define XB_TOPGEN   3392
#define XCD_BAR_WORDS 3456
#define XB_SPIN_CAP (1u << 20)
__device__ __forceinline__ unsigned xb_ld(unsigned* p)              { return __hip_atomic_load(p, __ATOMIC_RELAXED, __HIP_MEMORY_SCOPE_AGENT); }
__device__ __forceinline__ unsigned xb_add(unsigned* p, unsigned v) { return __hip_atomic_fetch_add(p, v, __ATOMIC_RELAXED, __HIP_MEMORY_SCOPE_AGENT); }
__device__ __forceinline__ unsigned xb_xcc_id() { return (unsigned)__builtin_amdgcn_s_getreg((3 << 11) | 20) & 0xFu; }
#define XB_SPIN(cond, bar) do { unsigned _sp = 0; while (cond) { __builtin_amdgcn_s_sleep(1); \
    if ((++_sp & 255u) == 0u) { if (xb_ld(&(bar)[XB_TMO])) break; if (_sp > XB_SPIN_CAP) { atomicAdd(&(bar)[XB_TMO], 1u); break; } } } } while (0)
#ifndef CODE_PF
#define CODE_PF 0
#endif
struct XcdBarrier { unsigned* bar; unsigned x; volatile LAS unsigned* st; const char* code; int loc; };
__device__ __forceinline__ XcdBarrier xcd_barrier_post(unsigned* bar, volatile LAS unsigned* st) {
    XcdBarrier b; b.bar = bar; b.x = xb_xcc_id(); b.st = st; b.code = nullptr; b.loc = 0;
    if (threadIdx.x == 0) (void)xb_add(&bar[XB_XCNT(b.x)], 1u);
    return b;
}
__device__ __forceinline__ void xcd_barrier_complete(unsigned* bar, unsigned x, unsigned& nloc, unsigned& nx) {
    const unsigned G = gridDim.x * gridDim.y * gridDim.z;
    unsigned sum, cnt, mine, sp = 0u;
    for (;;) {
        sum = 0u; cnt = 0u; mine = 0u;
#pragma unroll
        for (unsigned j = 0; j < 16; ++j) { const unsigned c = xb_ld(&bar[XB_XCNT(j)]); sum += c; cnt += (c > 0u) ? 1u : 0u; mine = (j == x) ? c : mine; }
        if (sum == G) break;
        __builtin_amdgcn_s_sleep(1);
        if ((++sp & 255u) == 0u) { if (xb_ld(&bar[XB_TMO])) break; if (sp > XB_SPIN_CAP) { atomicAdd(&bar[XB_TMO], 1u); break; } }
    }
    nloc = mine > 0u ? mine : 1u; nx = cnt > 0u ? cnt : 1u;
}
__device__ __forceinline__ void xcd_barrier(const XcdBarrier& b) {
    asm volatile("s_waitcnt vmcnt(0)" ::: "memory");
    __syncthreads();
    unsigned pf_ = 0; const unsigned tpf_ = threadIdx.x - 64u;
    if (CODE_PF && tpf_ < 49u) asm volatile("global_load_dword %0, %1, off" : "=v"(pf_) : "v"(b.code + (size_t)(b.loc * 49 + (int)tpf_) * 128) : "memory");
    if (threadIdx.x == 0) {
        unsigned* bar = b.bar;
        __builtin_amdgcn_s_waitcnt(0);
        unsigned nloc = b.st[0], nx = b.st[1];
        if (nloc == 0u) { xcd_barrier_complete(bar, b.x, nloc, nx); b.st[0] = nloc; b.st[1] = nx; }
        const unsigned old = xb_add(&bar[XB_XSUB(b.x)], 1u);
        const unsigned gen = old / nloc;
        if (old + 1u == (gen + 1u) * nloc) {
            __builtin_amdgcn_fence(__ATOMIC_RELEASE, "agent");
            asm volatile("s_waitcnt vmcnt(0)" ::: "memory");
            const unsigned og = xb_add(&bar[XB_TOP], 1u);
            const unsigned tg = og / nx;
            if (og + 1u == (tg + 1u) * nx) xb_add(&bar[XB_TOPGEN], 1u);
            else XB_SPIN(xb_ld(&bar[XB_TOPGEN]) == tg, bar);
            __builtin_amdgcn_fence(__ATOMIC_ACQUIRE, "agent");
            xb_add(&bar[XB_XGEN(b.x)], 1u);
            asm volatile("s_waitcnt vmcnt(0)" ::: "memory");
        } else {
            XB_SPIN(xb_ld(&bar[XB_XGEN(b.x)]) == gen, bar);
            __builtin_amdgcn_fence(__ATOMIC_ACQUIRE, "agent");
            asm volatile("s_waitcnt vmcnt(0)" ::: "memory");
        }
    }
    if (CODE_PF && tpf_ < 49u) { asm volatile("s_waitcnt vmcnt(0)" ::: "memory"); asm volatile("" :: "v"(pf_)); }
    __syncthreads();
}

struct Args { const float* in[38]; float* out; unsigned char* ws; int ph_lo, ph_hi; };
typedef const __attribute__((address_space(4))) char* kptr_t;
struct AV {
    kptr_t kp;
    __device__ __forceinline__ kptr_t base() const { kptr_t p = kp; asm volatile("" : "+s"(p)); return p; }
    __device__ __forceinline__ const float* in(int i) const { return *(const float* const __attribute__((address_space(4)))*)(base() + 8 * i); }
    __device__ __forceinline__ float* out() const { return *(float* const __attribute__((address_space(4)))*)(base() + 304); }
    __device__ __forceinline__ unsigned char* ws() const { return *(unsigned char* const __attribute__((address_space(4)))*)(base() + 312); }
    __device__ __forceinline__ int ph_lo() const { return *(const int __attribute__((address_space(4)))*)(base() + 320); }
    __device__ __forceinline__ int ph_hi() const { return *(const int __attribute__((address_space(4)))*)(base() + 324); }
};
static_assert(sizeof(Args) == 328 && offsetof(Args, out) == 304 && offsetof(Args, ws) == 312 && offsetof(Args, ph_lo) == 320, "Args layout vs AV offsets");

struct Frame {
    LAS unsigned char* lds;
    volatile LAS unsigned* MISC;
    gu32* ctl;
    int tid, lane, wave, vcu, G;
    unsigned char* ws;
};

__device__ __forceinline__ void xpose_item(const float* W, int ldw, int N, bf16_t* WT, int ldt, const float* kscale, int item, int lane) {
    const int nblk = N / 64, kb = item / nblk, nb = item % nblk, g = lane >> 4, c4 = lane & 15, k0 = 64 * kb + 16 * g, n0 = 64 * nb + 4 * c4;
    f32x4 v[16];
#pragma unroll
    for (int j = 0; j < 16; ++j) v[j] = __builtin_nontemporal_load((const f32x4*)(W + (size_t)(k0 + j) * ldw + n0));
    if (kscale) {
#pragma unroll
        for (int j = 0; j < 16; ++j) v[j] = v[j] * kscale[k0 + j]; }
#pragma unroll
    for (int c = 0; c < 4; ++c) {
        u32x4 o0, o1;
        o0.x = cvt_pk_bf16(v[0][c], v[1][c]); o0.y = cvt_pk_bf16(v[2][c], v[3][c]); o0.z = cvt_pk_bf16(v[4][c], v[5][c]); o0.w = cvt_pk_bf16(v[6][c], v[7][c]);
        o1.x = cvt_pk_bf16(v[8][c], v[9][c]); o1.y = cvt_pk_bf16(v[10][c], v[11][c]); o1.z = cvt_pk_bf16(v[12][c], v[13][c]); o1.w = cvt_pk_bf16(v[14][c], v[15][c]);
        *(u32x4*)(WT + (size_t)(n0 + c) * ldt + k0) = o0; *(u32x4*)(WT + (size_t)(n0 + c) * ldt + k0 + 8) = o1; }
}
__device__ __forceinline__ void rms_row_to_bf16(const float* xrow, const float* w, bf16_t* orow, int lane) {
    const GAS f32x4* xr = (const GAS f32x4*)xrow + lane; const GAS f32x4* wr = (const GAS f32x4*)w + lane;
    f32x4 v[8]; float s = 0.f;
#pragma unroll
    for (int j = 0; j < 8; ++j) { v[j] = __builtin_nontemporal_load(xr + 64 * j); s += (v[j].x * v[j].x + v[j].y * v[j].y) + (v[j].z * v[j].z + v[j].w * v[j].w); }
    const float r = 1.0f / sqrtf(wave_sum(s) * (1.f / D) + EPS);
    GAS u32x2* o8 = (GAS u32x2*)orow + lane;
#pragma unroll
    for (int j = 0; j < 8; ++j) { const f32x4 ww = wr[64 * j]; u32x2 o; o.x = pk2(v[j].x * r * ww.x, v[j].y * r * ww.y); o.y = pk2(v[j].z * r * ww.z, v[j].w * r * ww.w); o8[64 * j] = o; }
}
__device__ __forceinline__ void rms_row2_to_bf16(const float* xa, const float* xb, const float* w, bf16_t* oa, bf16_t* ob, int lane) {
    const GAS f32x4* pa = (const GAS f32x4*)xa + lane; const GAS f32x4* pb = (const GAS f32x4*)xb + lane; const GAS f32x4* wr = (const GAS f32x4*)w + lane;
    f32x4 va[8], vb[8]; float sa = 0.f, sb = 0.f;
#pragma unroll
    for (int j = 0; j < 8; ++j) { va[j] = __builtin_nontemporal_load(pa + 64 * j); vb[j] = __builtin_nontemporal_load(pb + 64 * j); }
#pragma unroll
    for (int j = 0; j < 8; ++j) { sa += (va[j].x * va[j].x + va[j].y * va[j].y) + (va[j].z * va[j].z + va[j].w * va[j].w); sb += (vb[j].x * vb[j].x + vb[j].y * vb[j].y) + (vb[j].z * vb[j].z + vb[j].w * vb[j].w); }
    const float ra = 1.0f / sqrtf(wave_sum(sa) * (1.f / D) + EPS), rb = 1.0f / sqrtf(wave_sum(sb) * (1.f / D) + EPS);
    GAS u32x2* qa = (GAS u32x2*)oa + lane; GAS u32x2* qb = (GAS u32x2*)ob + lane;
#pragma unroll
    for (int j = 0; j < 8; ++j) { const f32x4 ww = wr[64 * j]; u32x2 o;
        o.x = pk2(va[j].x * ra * ww.x, va[j].y * ra * ww.y); o.y = pk2(va[j].z * ra * ww.z, va[j].w * ra * ww.w); qa[64 * j] = o;
        o.x = pk2(vb[j].x * rb * ww.x, vb[j].y * rb * ww.y); o.y = pk2(vb[j].z * rb * ww.z, vb[j].w * rb * ww.w); qb[64 * j] = o; }
}

constexpr size_t TAB_RWH = 65536, TAB_RWL = 65536 + 80 * 2048 * 2;
struct TileOrder {
    int nM, nN, nwg, G, c;
    __device__ __forceinline__ void init(int nM_, int nN_, int G_, int c_) { nM = nM_; nN = nN_; nwg = nM * nN; G = G_; c = c_; }
    __device__ __forceinline__ bool map(int i, int& pm, int& pn) const {
        const long L = (long)i * G + c; if (L >= nwg) return false;
        int wgid = (int)L; { const int q = nwg / 8, r = nwg % 8, xcd = wgid % 8, off = wgid / 8; wgid = (xcd < r ? xcd * (q + 1) : r * (q + 1) + (xcd - r) * q) + off; }
        const int nig = 8 * nN, gid = wgid / nig, fm = gid * 8, gsz = (nM - fm) < 8 ? (nM - fm) : 8;
        pm = fm + ((wgid % nig) % gsz); pn = (wgid % nig) / gsz; return true;
    }
};
struct PlainSched {
    TileOrder o; const char* A; const char* B; size_t tstepA, tstepB;
    __device__ __forceinline__ void init(const bf16_t* A_, int lda, const bf16_t* B_, int ldb, int M, int N, int G, int c) {
        o.init(M / 256, N / 256, G, c); A = (const char*)A_; B = (const char*)B_; tstepA = (size_t)256 * lda * 2; tstepB = (size_t)256 * ldb * 2; }
    __device__ __forceinline__ bool next(int i, pg8::Unit& u) const {
        int pm, pn; if (!o.map(i, pm, pn)) return false;
        u.pm = pm; u.pn = pn; u.aux0 = 0; u.aux1 = 0; u.A = A + (size_t)pm * tstepA; u.B = B + (size_t)pn * tstepB; return true; }
};
#define EPI_BAR() do { asm volatile("s_waitcnt lgkmcnt(0)" ::: "memory"); __builtin_amdgcn_s_barrier(); asm volatile("" ::: "memory"); } while (0)

struct EpiG1 {
    static constexpr bool PERM = true; static constexpr int MIDT = -1;
    bf16_t *Qh, *Kh, *Vh, *U; const float *qw, *kw; LAS float* tbl;
    __device__ __forceinline__ void mid(f32x4 (&)[2][2][4][2], const pg8::Unit&, int, int, int, int) const {}
    __device__ __forceinline__ void prep(const pg8::Unit&) const {}
    __device__ __forceinline__ void operator()(f32x4 (&acc)[2][2][4][2], const pg8::Unit& u, int wr, int wc, int fr, int fq) const {
        const int pn = u.pn, pm = u.pm, b = pm >> 3, s0 = (pm & 7) * 256 + wr * 64 + fr;
        if (pn < 8) {
#pragma unroll
            for (int ai = 0; ai < 2; ++ai)
#pragma unroll
                for (int m = 0; m < 4; ++m)
#pragma unroll
                    for (int bj = 0; bj < 2; ++bj) { const f32x4 x0 = acc[ai][bj][m][0], x1 = acc[ai][bj][m][1];
                        float s = (x0[0] * x0[0] + x0[1] * x0[1]) + (x0[2] * x0[2] + x0[3] * x0[3]) + (x1[0] * x1[0] + x1[1] * x1[1]) + (x1[2] * x1[2] + x1[3] * x1[3]);
                        s += __shfl_xor(s, 16); s += __shfl_xor(s, 32);
                        if (fq == 0) tbl[((ai * 128 + wr * 64 + m * 16 + fr) * 2 + bj) * 4 + wc] = s; }
            EPI_BAR();
            const float* w = (pn < 4 ? qw : kw) + wc * 32 + fq * 8; const f32x4 w0 = *(const f32x4*)w, w1 = *(const f32x4*)(w + 4);
            bf16_t* base = (pn < 4 ? Qh : Kh);
#pragma unroll
            for (int ai = 0; ai < 2; ++ai)
#pragma unroll
                for (int m = 0; m < 4; ++m)
#pragma unroll
                    for (int bj = 0; bj < 2; ++bj) { const f32x4 p = *(const LAS f32x4*)&tbl[((ai * 128 + wr * 64 + m * 16 + fr) * 2 + bj) * 4];
                        const float r = rsqrtf(((p[0] + p[1]) + (p[2] + p[3])) * (1.f / 128.f) + EPS);
                        const f32x4 v0 = acc[ai][bj][m][0] * r * w0, v1 = acc[ai][bj][m][1] * r * w1;
                        u32x4 o; o.x = cvt_pk_bf16(v0[0], v0[1]); o.y = cvt_pk_bf16(v0[2], v0[3]); o.z = cvt_pk_bf16(v1[0], v1[1]); o.w = cvt_pk_bf16(v1[2], v1[3]);
                        *(u32x4*)(base + ((size_t)((b * 8 + (pn & 3) * 2 + bj) * SEQ + s0 + ai * 128 + m * 16)) * 128 + wc * 32 + fq * 8) = o; }
        } else {
#pragma unroll
            for (int ai = 0; ai < 2; ++ai)
#pragma unroll
                for (int m = 0; m < 4; ++m)
#pragma unroll
                    for (int bj = 0; bj < 2; ++bj) { const f32x4 v0 = acc[ai][bj][m][0], v1 = acc[ai][bj][m][1];
                        u32x4 o; o.x = cvt_pk_bf16(v0[0], v0[1]); o.y = cvt_pk_bf16(v0[2], v0[3]); o.z = cvt_pk_bf16(v1[0], v1[1]); o.w = cvt_pk_bf16(v1[2], v1[3]);
                        bf16_t* dst = (pn < 12) ? Vh + ((size_t)((b * 8 + (pn & 3) * 2 + bj) * SEQ + s0 + ai * 128 + m * 16)) * 128 + wc * 32 + fq * 8
                                                : U + (size_t)(pm * 256 + wr * 64 + fr + ai * 128 + m * 16) * DSSM + (pn - 12) * 256 + bj * 128 + wc * 32 + fq * 8;
                        *(u32x4*)dst = o; }
        }
    }
};


constexpr size_t SSMT_G = (size_t)256 * 384 + 128 * 256;
#ifdef TS_A
#define TSP9(k) if ((k) == TS_A) ts_a = __builtin_amdgcn_s_memrealtime(); if ((k) == TS_B) ts_b = __builtin_amdgcn_s_memrealtime();
#else
#define TSP9(k)
#endif
__device__ __forceinline__ void ssm_tables(Frame& F, const AV& a, int g, unsigned long long& ts_a, unsigned long long& ts_b) {
    LAS f32x2* lamp = (LAS f32x2*)(F.lds);
    LAS f32x2* Bb = lamp + 17 * 64;
    LAS f32x2* Cc = Bb + 64 * 16;
    LAS float* Kt = (LAS float*)(Cc + 16 * 64);
    const float *lre = a.in(11), *lim = a.in(12), *logdt = a.in(13), *bre = a.in(14), *bim = a.in(15), *cre = a.in(16), *cim = a.in(17), *dsk = a.in(18);
    const int tid = F.tid;
    if (tid < 64) { const int p = tid;
        const float lre_ = lre[g * 64 + p], lim_ = lim[g * 64 + p], ldt_ = logdt[g];
        f32x4 br4[4], bi4[4];
#pragma unroll
        for (int j = 0; j < 4; ++j) { br4[j] = ((const f32x4*)(bre + (size_t)(g * 64 + p) * 16))[j]; bi4[j] = ((const f32x4*)(bim + (size_t)(g * 64 + p) * 16))[j]; }
        const double lr = fmin((double)lre_, -1e-4), li = (double)lim_, dt = exp((double)ldt_);
        const double mag = exp(lr * dt), br = mag * cos(li * dt), bi = mag * sin(li * dt), den = lr * lr + li * li;
        const double cr = ((br - 1.0) * lr + bi * li) / den, ci = (bi * lr - (br - 1.0) * li) / den;
        double pr = 1.0, pi = 0.0;
        for (int n = 0; n <= 16; ++n) { lamp[n * 64 + p] = (f32x2){(float)pr, (float)pi}; const double nr = pr * br - pi * bi, ni = pr * bi + pi * br; pr = nr; pi = ni; }
        ((f32x2*)(F.ws + WS_TAB))[64 + g * 64 + p] = lamp[16 * 64 + p];
#pragma unroll
        for (int h = 0; h < 16; ++h) { const double r = br4[h >> 2][h & 3], i = bi4[h >> 2][h & 3]; Bb[p * 16 + h] = (f32x2){(float)(cr * r - ci * i), (float)(cr * i + ci * r)}; }
    }
    for (int e = tid; e < 1024; e += NTHR) { const int ho = e >> 6, p = e & 63; Cc[ho * 64 + p] = (f32x2){cre[(g * 16 + ho) * 64 + p], cim[(g * 16 + ho) * 64 + p]}; }
    __syncthreads(); TSP9(122)
    const float dskv = dsk[g * 16 + ((tid >> 1) & 15)];
    { const int tau = tid >> 5, ho = (tid >> 1) & 15, hh = tid & 1; float s[8];
#pragma unroll
        for (int j = 0; j < 8; ++j) s[j] = 0.f;
#pragma unroll 4
        for (int p = 0; p < 64; ++p) { const f32x2 c = Cc[ho * 64 + p], l = lamp[tau * 64 + p]; const float clr = c.x * l.x - c.y * l.y, cli = c.x * l.y + c.y * l.x;
            const LAS f32x4* bp = (const LAS f32x4*)(Bb + p * 16 + hh * 8);
#pragma unroll
            for (int h2 = 0; h2 < 4; ++h2) { const f32x4 b2 = bp[h2]; s[2 * h2] += clr * b2[0] - cli * b2[1]; s[2 * h2 + 1] += clr * b2[2] - cli * b2[3]; } }
#pragma unroll
        for (int j = 0; j < 8; ++j) { const int hi = hh * 8 + j; Kt[(tau * 16 + ho) * 16 + hi] = s[j] + ((tau == 0 && hi == ho) ? dskv : 0.f); }
    }
    __syncthreads(); TSP9(123)
    bf16_t* TY = (bf16_t*)(F.ws + WS_SSMT) + (size_t)g * SSMT_G; bf16_t* WSg = TY + 256 * 384;
    for (int c = tid; c < 256 * 48; c += NTHR) { const int m = c / 48, k0 = (c % 48) * 8, i = m >> 4, ho = m & 15; float v[8];
        if (k0 < 256) { const int j = k0 >> 4, hi0 = k0 & 15;
            if (j <= i) { const LAS f32x4* kp = (const LAS f32x4*)(Kt + ((i - j) * 16 + ho) * 16 + hi0); const f32x4 x0 = kp[0], x1 = kp[1];
                v[0] = x0[0]; v[1] = x0[1]; v[2] = x0[2]; v[3] = x0[3]; v[4] = x1[0]; v[5] = x1[1]; v[6] = x1[2]; v[7] = x1[3]; }
            else {
#pragma unroll
                for (int q = 0; q < 8; ++q) v[q] = 0.f; } }
        else { const int kk = k0 - 256, ri = kk >> 6, p0 = kk & 63; const LAS f32x4* cp = (const LAS f32x4*)(Cc + ho * 64 + p0); const LAS f32x4* lp = (const LAS f32x4*)(lamp + (i + 1) * 64 + p0);
#pragma unroll
            for (int q2 = 0; q2 < 4; ++q2) { const f32x4 cc = cp[q2], ll = lp[q2];
                v[2 * q2] = ri == 0 ? (cc[0] * ll[0] - cc[1] * ll[1]) : -(cc[0] * ll[1] + cc[1] * ll[0]);
                v[2 * q2 + 1] = ri == 0 ? (cc[2] * ll[2] - cc[3] * ll[3]) : -(cc[2] * ll[3] + cc[3] * ll[2]); } }
        u32x4 o; o.x = pk2(v[0], v[1]); o.y = pk2(v[2], v[3]); o.z = pk2(v[4], v[5]); o.w = pk2(v[6], v[7]);
        *(u32x4*)(TY + (size_t)m * 384 + k0) = o; }
    for (int c = tid; c < 128 * 32; c += NTHR) { const int n = c >> 5, k0 = (c & 31) * 8, ri = n >> 6, p = n & 63, j = k0 >> 4, hi0 = k0 & 15; float v[8];
        const f32x2 l = lamp[(15 - j) * 64 + p]; const LAS f32x4* bp = (const LAS f32x4*)(Bb + p * 16 + hi0);
#pragma unroll
        for (int q2 = 0; q2 < 4; ++q2) { const f32x4 bb = bp[q2];
            v[2 * q2] = ri == 0 ? (l.x * bb[0] - l.y * bb[1]) : (l.x * bb[1] + l.y * bb[0]);
            v[2 * q2 + 1] = ri == 0 ? (l.x * bb[2] - l.y * bb[3]) : (l.x * bb[3] + l.y * bb[2]); }
        u32x4 o; o.x = pk2(v[0], v[1]); o.y = pk2(v[2], v[3]); o.z = pk2(v[4], v[5]); o.w = pk2(v[6], v[7]);
        *(u32x4*)(WSg + (size_t)n * 256 + k0) = o; }
    __syncthreads();
}
__device__ __forceinline__ float gelu_tanh(float y) { const float z2 = -2.302208198f * (y + 0.044715f * y * y * y);     return y * __builtin_amdgcn_rcpf(1.f + __builtin_amdgcn_exp2f(z2)); }
__device__ __forceinline__ float sigmoid_fast(float z) { return __builtin_amdgcn_rcpf(1.f + __builtin_amdgcn_exp2f(-1.4426950408889634f * z)); }
__device__ __forceinline__ void ssm_unit(Frame& F, int b, int g) {
    LAS unsigned char* Ul = F.lds; LAS unsigned char* Sl = F.lds + 67584;
    const bf16_t* U = (const bf16_t*)(F.ws + WS_U); bf16_t* yg = (bf16_t*)(F.ws + WS_YG);
    const int tid = F.tid, lane = F.lane, wave = F.wave, fr = lane & 15, fq = lane >> 4;
    for (int q = tid; q < 4096; q += NTHR) { const int tok = q >> 1, half = q & 1;
        const u32x4 v = *(const u32x4*)(U + (size_t)(b * SEQ + tok) * DSSM + g * 16 + half * 8);
        *(LAS u32x4*)(Ul + (tok >> 4) * 528 + ((tok & 15) * 16 + half * 8) * 2) = v; }
    __syncthreads();
    const bf16_t* TY = (const bf16_t*)(F.ws + WS_SSMT) + (size_t)g * SSMT_G; const bf16_t* WSg = TY + 256 * 384;
    {
        f32x4 acc[8]; bf16x8 bfr[8];
#pragma unroll
        for (int ks = 0; ks < 8; ++ks) bfr[ks] = *(const bf16x8*)(WSg + (size_t)(16 * wave + fr) * 256 + 32 * ks + 8 * fq);
#pragma unroll
        for (int rb = 0; rb < 8; ++rb) acc[rb] = (f32x4){0.f, 0.f, 0.f, 0.f};
#pragma unroll
        for (int ks = 0; ks < 8; ++ks) {
#pragma unroll
            for (int rb = 0; rb < 8; ++rb) { const bf16x8 afr = *(const LAS bf16x8*)(Ul + (16 * rb + fr) * 528 + (32 * ks + 8 * fq) * 2);
                acc[rb] = __builtin_amdgcn_mfma_f32_16x16x32_bf16(afr, bfr[ks], acc[rb], 0, 0, 0); } }
#pragma unroll
        for (int rb = 0; rb < 8; ++rb)
#pragma unroll
            for (int r = 0; r < 4; ++r) *(LAS float*)(Sl + (16 * rb + 4 * fq + r) * 528 + (16 * wave + fr) * 4) = acc[rb][r];
    }
    __syncthreads();
    if (wave == 0) { const int p = lane; const f32x2 l = ((const f32x2*)(F.ws + WS_TAB))[64 + g * 64 + p]; float xr = 0.f, xi = 0.f;
#pragma unroll 1
        for (int cb = 0; cb < 128; cb += 16) { float sr[16], si[16];
#pragma unroll
            for (int j = 0; j < 16; ++j) { const LAS float* row = (const LAS float*)(Sl + (cb + j) * 528); sr[j] = row[p]; si[j] = row[64 + p]; }
#pragma unroll
            for (int j = 0; j < 16; ++j) { LAS float* row = (LAS float*)(Sl + (cb + j) * 528); row[p] = xr; row[64 + p] = xi;
                const float nr = l.x * xr - l.y * xi + sr[j], ni = l.x * xi + l.y * xr + si[j]; xr = nr; xi = ni; } } }
    __syncthreads();
#pragma unroll 1
    for (int cbi = 0; cbi < 2; ++cbi) { const int cb = 2 * wave + cbi;
        f32x4 acc[8]; bf16x8 bfr[12];
#pragma unroll
        for (int ks = 0; ks < 12; ++ks) bfr[ks] = *(const bf16x8*)(TY + (size_t)(16 * cb + fr) * 384 + 32 * ks + 8 * fq);
#pragma unroll
        for (int rb = 0; rb < 8; ++rb) acc[rb] = (f32x4){0.f, 0.f, 0.f, 0.f};
#pragma unroll
        for (int ks = 0; ks < 8; ++ks) {
#pragma unroll
            for (int rb = 0; rb < 8; ++rb) { const bf16x8 afr = *(const LAS bf16x8*)(Ul + (16 * rb + fr) * 528 + (32 * ks + 8 * fq) * 2);
                acc[rb] = __builtin_amdgcn_mfma_f32_16x16x32_bf16(afr, bfr[ks], acc[rb], 0, 0, 0); } }
#pragma unroll
        for (int ks = 0; ks < 4; ++ks) {
#pragma unroll
            for (int rb = 0; rb < 8; ++rb) { const LAS f32x4* xp = (const LAS f32x4*)(Sl + (16 * rb + fr) * 528 + (32 * ks + 8 * fq) * 4); const f32x4 x0 = xp[0], x1 = xp[1];
                u32x4 w; w.x = cvt_pk_bf16(x0[0], x0[1]); w.y = cvt_pk_bf16(x0[2], x0[3]); w.z = cvt_pk_bf16(x1[0], x1[1]); w.w = cvt_pk_bf16(x1[2], x1[3]);
                acc[rb] = __builtin_amdgcn_mfma_f32_16x16x32_bf16(__builtin_bit_cast(bf16x8, w), bfr[8 + ks], acc[rb], 0, 0, 0); } }
#pragma unroll
        for (int rb = 0; rb < 8; ++rb)
#pragma unroll
            for (int r = 0; r < 4; ++r) { const int c = 16 * rb + 4 * fq + r; const float y = gelu_tanh(acc[rb][r]);
                yg[(size_t)(b * SEQ + c * 16 + cb) * DSSM + g * 16 + fr] = (bf16_t)f2bf(y); }
    }
    __syncthreads();
}


__device__ __forceinline__ u32x4 pack8(const f32x4 v0, const f32x4 v1) { u32x4 o; o.x = cvt_pk_bf16(v0[0], v0[1]); o.y = cvt_pk_bf16(v0[2], v0[3]); o.z = cvt_pk_bf16(v1[0], v1[1]); o.w = cvt_pk_bf16(v1[2], v1[3]); return o; }
__device__ __forceinline__ float ssq8(const f32x4 a, const f32x4 b) { return ((a[0] * a[0] + a[1] * a[1]) + (a[2] * a[2] + a[3] * a[3])) + ((b[0] * b[0] + b[1] * b[1]) + (b[2] * b[2] + b[3] * b[3])); }
__device__ __forceinline__ float red_fq(float s) { s += __shfl_xor(s, 16); s += __shfl_xor(s, 32); return s; }

template <int NPART, bool RSQ> __device__ __forceinline__ void prep_rtab(const float* sq, size_t nrows, int p0, int rowbase, float inv_w, LAS float* rtab, LAS float* tmp) {
    const int tid = mk_otid();
    const int row = tid & 255, half = tid >> 8; float s = 0.f;
#pragma unroll
    for (int i = 0; i < NPART / 2; ++i) s += sq[(size_t)(p0 + half * (NPART / 2) + i) * nrows + rowbase + row];
    tmp[half * 256 + row] = s; EPI_BAR();
    if (tid < 256) { s = tmp[row] + tmp[256 + row]; rtab[row] = RSQ ? rsqrtf(s * inv_w + EPS) : 1.f / s; }
    EPI_BAR();
}
struct EpiGlu {
    static constexpr bool PERM = true; static constexpr int MIDT = -1;
    const bf16_t* yg; const float* bias; bf16_t* cat; float* sq;
    __device__ __forceinline__ void mid(f32x4 (&)[2][2][4][2], const pg8::Unit&, int, int, int, int) const {}
    __device__ __forceinline__ void prep(const pg8::Unit&) const {}
    __device__ __forceinline__ void operator()(f32x4 (&acc)[2][2][4][2], const pg8::Unit& u, int wr, int wc, int fr, int fq) const {
        const int row0 = u.pm * 256 + wr * 64 + fr, col0 = u.pn * 256 + wc * 32 + fq * 8;
        f32x4 bv[2][2];
#pragma unroll
        for (int bj = 0; bj < 2; ++bj) { bv[bj][0] = *(const f32x4*)(bias + col0 + bj * 128); bv[bj][1] = *(const f32x4*)(bias + col0 + bj * 128 + 4); }
#pragma unroll
        for (int ai = 0; ai < 2; ++ai) {
            u32x4 ypre[4][2];
#pragma unroll
            for (int m = 0; m < 4; ++m)
#pragma unroll
                for (int bj = 0; bj < 2; ++bj) ypre[m][bj] = *(const u32x4*)(yg + (size_t)(row0 + ai * 128 + m * 16) * DSSM + col0 + bj * 128);
            asm volatile("" ::: "memory");
#pragma unroll
            for (int m = 0; m < 4; ++m) { const int row = row0 + ai * 128 + m * 16; float s = 0.f;
#pragma unroll
                for (int bj = 0; bj < 2; ++bj) { const u32x4 yw = ypre[m][bj];
                    const f32x4 y0 = {bf_lo(yw.x), bf_hi(yw.x), bf_lo(yw.y), bf_hi(yw.y)}, y1 = {bf_lo(yw.z), bf_hi(yw.z), bf_lo(yw.w), bf_hi(yw.w)};
                    const f32x4 z0 = acc[ai][bj][m][0] + bv[bj][0], z1 = acc[ai][bj][m][1] + bv[bj][1]; f32x4 o0, o1;
#pragma unroll
                    for (int q = 0; q < 4; ++q) { o0[q] = y0[q] * sigmoid_fast(z0[q]); o1[q] = y1[q] * sigmoid_fast(z1[q]); }
                    *(u32x4*)(cat + (size_t)row * D + col0 + bj * 128) = pack8(o0, o1); s += ssq8(o0, o1); }
                s = red_fq(s); if (fq == 0) sq[(size_t)(u.pn * 4 + wc) * T + row] = s; }
            asm volatile("" ::: "memory");
        }
    }
};
struct EpiOut {
    static constexpr bool PERM = true; static constexpr int MIDT = 16;
    const float* x; float* h1; bf16_t* a2; const float* sqs; float* sqh; LAS float* rtab; LAS float* tmp;
    __device__ __forceinline__ void prep(const pg8::Unit& u) const { prep_rtab<16, true>(sqs, T, 0, u.pm * 256, 1.f / 1024.f, rtab, tmp); }
    __device__ __forceinline__ void mid(f32x4 (&acc)[2][2][4][2], const pg8::Unit& u, int wr, int wc, int fr, int fq) const {
#pragma unroll
        for (int ai = 0; ai < 2; ++ai)
#pragma unroll
            for (int m = 0; m < 4; ++m) { const float r = rtab[ai * 128 + wr * 64 + m * 16 + fr];
#pragma unroll
                for (int bj = 0; bj < 2; ++bj) { acc[ai][bj][m][0] *= r; acc[ai][bj][m][1] *= r; } }
    }
    __device__ __forceinline__ void operator()(f32x4 (&acc)[2][2][4][2], const pg8::Unit& u, int wr, int wc, int fr, int fq) const {
        const int row0 = u.pm * 256 + wr * 64 + fr, col0 = u.pn * 256 + wc * 32 + fq * 8;
#pragma unroll
        for (int ai = 0; ai < 2; ++ai) {
            f32x4 pre[4][2][2];
#pragma unroll
            for (int m = 0; m < 4; ++m)
#pragma unroll
                for (int bj = 0; bj < 2; ++bj) { const size_t off = (size_t)(row0 + ai * 128 + m * 16) * D + col0 + bj * 128; pre[m][bj][0] = __builtin_nontemporal_load((const f32x4*)(x + off)); pre[m][bj][1] = __builtin_nontemporal_load((const f32x4*)(x + off + 4)); }
            asm volatile("" ::: "memory");
#pragma unroll
            for (int m = 0; m < 4; ++m) { const int row = row0 + ai * 128 + m * 16; float s = 0.f;
#pragma unroll
                for (int bj = 0; bj < 2; ++bj) { const size_t off = (size_t)row * D + col0 + bj * 128;
                    const f32x4 v0 = acc[ai][bj][m][0] + pre[m][bj][0], v1 = acc[ai][bj][m][1] + pre[m][bj][1];
                    *(u32x4*)(a2 + off) = pack8(v0, v1); s += ssq8(v0, v1); }
                s = red_fq(s); if (fq == 0) sqh[(size_t)(u.pn * 4 + wc) * T + row] = s; }
            asm volatile("" ::: "memory");
        }
    }
};
template <int PREP, int NPART, bool EXP2, int RES  , bool OUTF, bool OUTB, int SQM>
struct EpiGen {
    static constexpr bool PERM = true; static constexpr int MIDT = -1;
    const float* sqi; float inv_w; const float* res; float* of; bf16_t* ob; int ldo; float* sqo; LAS float* rtab; LAS float* tmp; const bf16_t* resb;
    __device__ __forceinline__ void mid(f32x4 (&)[2][2][4][2], const pg8::Unit&, int, int, int, int) const {}
    __device__ __forceinline__ void prep(const pg8::Unit& u) const { if constexpr (PREP != 0) prep_rtab<NPART, PREP == 1>(sqi, T, u.aux0, u.pm * 256, inv_w, rtab, tmp); }
    __device__ __forceinline__ void operator()(f32x4 (&acc)[2][2][4][2], const pg8::Unit& u, int wr, int wc, int fr, int fq) const {
        const int row0 = u.pm * 256 + wr * 64 + fr, col0 = u.pn * 256 + wc * 32 + fq * 8;
#pragma unroll
        for (int ai = 0; ai < 2; ++ai) {
            f32x4 pre[RES == 1 ? 4 : 1][2][2]; u32x4 preb[RES == 2 ? 4 : 1][2];
            if constexpr (RES == 1) {
#pragma unroll
                for (int m = 0; m < 4; ++m)
#pragma unroll
                    for (int bj = 0; bj < 2; ++bj) { const size_t off = (size_t)(row0 + ai * 128 + m * 16) * ldo + col0 + bj * 128; pre[m][bj][0] = *(const f32x4*)(res + off); pre[m][bj][1] = *(const f32x4*)(res + off + 4); }
                asm volatile("" ::: "memory"); }
            if constexpr (RES == 2) {
#pragma unroll
                for (int m = 0; m < 4; ++m)
#pragma unroll
                    for (int bj = 0; bj < 2; ++bj) preb[m][bj] = *(const u32x4*)(resb + (size_t)(row0 + ai * 128 + m * 16) * ldo + col0 + bj * 128);
                asm volatile("" ::: "memory"); }
#pragma unroll
            for (int m = 0; m < 4; ++m) { const int row = row0 + ai * 128 + m * 16; float s = 0.f;
                float r = 1.f; if constexpr (PREP != 0) r = rtab[ai * 128 + wr * 64 + m * 16 + fr];
#pragma unroll
                for (int bj = 0; bj < 2; ++bj) { const size_t off = (size_t)row * ldo + col0 + bj * 128;
                    f32x4 v0 = acc[ai][bj][m][0] * r, v1 = acc[ai][bj][m][1] * r;
                    if constexpr (EXP2) {
#pragma unroll
                        for (int q = 0; q < 4; ++q) { v0[q] = __builtin_amdgcn_exp2f(v0[q]); v1[q] = __builtin_amdgcn_exp2f(v1[q]); } }
                    if constexpr (RES == 1) { v0 += pre[m][bj][0]; v1 += pre[m][bj][1]; }
                    if constexpr (RES == 2) { const u32x4 w = preb[m][bj]; v0 += (f32x4){bf_lo(w.x), bf_hi(w.x), bf_lo(w.y), bf_hi(w.y)}; v1 += (f32x4){bf_lo(w.z), bf_hi(w.z), bf_lo(w.w), bf_hi(w.w)}; }
                    if constexpr (OUTF) { *(f32x4*)(of + off) = v0; *(f32x4*)(of + off + 4) = v1; }
                    if constexpr (OUTB) *(u32x4*)(ob + off) = pack8(v0, v1);
                    if constexpr (SQM == 1) s += ssq8(v0, v1);
                    if constexpr (SQM == 2) s += ((v0[0] + v0[1]) + (v0[2] + v0[3])) + ((v1[0] + v1[1]) + (v1[2] + v1[3])); }
                if constexpr (SQM != 0) { s = red_fq(s); if (fq == 0) sqo[(size_t)(u.aux1 + wc) * T + row] = s; } }
            if constexpr (RES != 0) asm volatile("" ::: "memory");
        }
    }
};

struct SchedSV {
    int G, c; const char* QX; const char* KX; const char* WO; const char* VX;
    __device__ __forceinline__ bool next(int i, pg8::Unit& u) const { const int L = i * G + c; if (L >= 256) return false;
        const int x = L & 7, h = (L >> 3) & 3, b = (L >> 5) & 3;
        if (L < 128) { u.pm = b * 8 + x; u.pn = h; u.aux0 = h * 8; u.aux1 = 0;
            u.A = QX + ((size_t)(b * SEQ + x * 256) * D + h * 512) * 2; u.B = KX + ((size_t)(b * MEM) * D + h * 512) * 2; }
        else { u.pm = b * 8 + x; u.pn = h; u.aux0 = 0; u.aux1 = 1;
            u.A = WO + ((size_t)(x * 256) * D + h * 512) * 2; u.B = VX + ((size_t)(b * MEM) * D + h * 512) * 2; }
        return true; }
};
struct EpiSV {
    static constexpr bool PERM = true; static constexpr int MIDT = -1;
    const float* sqi; bf16_t* px; bf16_t* vwt; LAS float* rtab; LAS float* tmp; LAS float* tbl;
    __device__ __forceinline__ void mid(f32x4 (&)[2][2][4][2], const pg8::Unit&, int, int, int, int) const {}
    __device__ __forceinline__ void prep(const pg8::Unit& u) const { if (u.aux1 == 0) prep_rtab<8, true>(sqi, T, u.aux0, u.pm * 256, 1.f / 512.f, rtab, tmp); }
    __device__ __forceinline__ void operator()(f32x4 (&acc)[2][2][4][2], const pg8::Unit& u, int wr, int wc, int fr, int fq) const {
        const int row0 = u.pm * 256 + wr * 64 + fr, col0 = u.pn * 256 + wc * 32 + fq * 8;
        if (u.aux1 != 0) {
#pragma unroll
            for (int ai = 0; ai < 2; ++ai)
#pragma unroll
                for (int m = 0; m < 4; ++m)
#pragma unroll
                    for (int bj = 0; bj < 2; ++bj) *(u32x4*)(vwt + (size_t)(row0 + ai * 128 + m * 16) * 1024 + col0 + bj * 128) = pack8(acc[ai][bj][m][0], acc[ai][bj][m][1]);
            return; }
#pragma unroll
        for (int ai = 0; ai < 2; ++ai)
#pragma unroll
            for (int m = 0; m < 4; ++m) { const int rl = ai * 128 + wr * 64 + m * 16 + fr; const float r = rtab[rl]; float s = 0.f;
#pragma unroll
                for (int bj = 0; bj < 2; ++bj)
#pragma unroll
                    for (int n = 0; n < 2; ++n) { f32x4 v = acc[ai][bj][m][n] * r;
#pragma unroll
                        for (int q = 0; q < 4; ++q) v[q] = __builtin_amdgcn_exp2f(v[q]);
                        acc[ai][bj][m][n] = v; s += (v[0] + v[1]) + (v[2] + v[3]); }
                s = red_fq(s); if (fq == 0) tbl[rl * 4 + wc] = s; }
        EPI_BAR();
#pragma unroll
        for (int ai = 0; ai < 2; ++ai)
#pragma unroll
            for (int m = 0; m < 4; ++m) { const int rl = ai * 128 + wr * 64 + m * 16 + fr; const f32x4 p = *(const LAS f32x4*)&tbl[rl * 4]; const float il = 1.f / ((p[0] + p[1]) + (p[2] + p[3]));
#pragma unroll
                for (int bj = 0; bj < 2; ++bj) *(u32x4*)(px + (size_t)(row0 + ai * 128 + m * 16) * 1024 + col0 + bj * 128) = pack8(acc[ai][bj][m][0] * il, acc[ai][bj][m][1] * il); }
    }
};
struct SchedPVW {
    TileOrder o; const char* A; const char* B;
    __device__ __forceinline__ bool next(int i, pg8::Unit& u) const { int pm, pn; if (!o.map(i, pm, pn)) return false;
        u.pm = pm; u.pn = pn; u.aux0 = 0; u.aux1 = pn * 4; u.A = A + (size_t)pm * 256 * 1024 * 2; u.B = B + ((size_t)(pm >> 3) * D + (size_t)pn * 256) * 1024 * 2; return true; }
};

struct SchedKV {
    int G, c; const char* MN; const char* WK; const char* WV;
    __device__ __forceinline__ bool next(int i, pg8::Unit& u) const { const int L = i * G + c; if (L >= 128) return false;
        const int pn = L & 7, pm = (L >> 3) & 3, kh = (L >> 5) & 1, wh = L >> 6;
        u.pm = pm; u.pn = pn; u.aux0 = wh * 2 + kh; u.aux1 = 0;
        u.A = MN + ((size_t)pm * 256 * D + kh * 1024) * 2; u.B = (wh ? WV : WK) + ((size_t)pn * 256 * D + kh * 1024) * 2; return true; }
};
struct EpiF32Slab {
    static constexpr bool PERM = true; static constexpr int MIDT = -1;
    float* O;
    __device__ __forceinline__ void mid(f32x4 (&)[2][2][4][2], const pg8::Unit&, int, int, int, int) const {}
    __device__ __forceinline__ void prep(const pg8::Unit&) const {}
    __device__ __forceinline__ void operator()(f32x4 (&acc)[2][2][4][2], const pg8::Unit& u, int wr, int wc, int fr, int fq) const {
        float* base = O + (size_t)u.aux0 * TM * D; const int row0 = u.pm * 256 + wr * 64 + fr, col0 = u.pn * 256 + wc * 32 + fq * 8;
#pragma unroll
        for (int ai = 0; ai < 2; ++ai)
#pragma unroll
            for (int m = 0; m < 4; ++m)
#pragma unroll
                for (int bj = 0; bj < 2; ++bj) { float* p = base + (size_t)(row0 + ai * 128 + m * 16) * D + col0 + bj * 128; *(f32x4*)p = acc[ai][bj][m][0]; *(f32x4*)(p + 4) = acc[ai][bj][m][1]; }
    }
};
__device__ __forceinline__ void kv_finish(Frame& F, const float* wq, const float* wk, int gw, int NGW) {
    const float* kf = (const float*)(F.ws + WS_QX); const float* vf = kf + (size_t)2 * TM * D;
    bf16_t* kx = (bf16_t*)(F.ws + WS_KX); bf16_t* vx = (bf16_t*)(F.ws + WS_VXT); const int lane = F.lane;
    for (int it = gw; it < TM * 4; it += NGW) { const int row = it >> 2, h = it & 3; const size_t off = (size_t)row * D + h * 512 + lane * 8;
        const f32x4 a0 = *(const f32x4*)(kf + off) + *(const f32x4*)(kf + (size_t)TM * D + off), a1 = *(const f32x4*)(kf + off + 4) + *(const f32x4*)(kf + (size_t)TM * D + off + 4);
        const f32x4 b0 = *(const f32x4*)(vf + off) + *(const f32x4*)(vf + (size_t)TM * D + off), b1 = *(const f32x4*)(vf + off + 4) + *(const f32x4*)(vf + (size_t)TM * D + off + 4);
        const float r = rsqrtf(wave_sum(ssq8(a0, a1)) * (1.f / 512.f) + EPS) * 0.04419417382415922f * 1.4426950408889634f;
        const f32x4 q0 = *(const f32x4*)(wq + lane * 8), q1 = *(const f32x4*)(wq + lane * 8 + 4), k0 = *(const f32x4*)(wk + lane * 8), k1 = *(const f32x4*)(wk + lane * 8 + 4);
        *(u32x4*)(kx + off) = pack8(a0 * r * q0 * k0, a1 * r * q1 * k1);
        *(u32x4*)(vx + off) = pack8(b0, b1); }
}

__device__ __forceinline__ void p0_prologue(Frame& F, const AV& a, int sel, unsigned long long& ts_a, unsigned long long& ts_b) {
    TSP9(120)
    const bool split = F.G >= 2 * NG;
    if (split) { if (F.vcu < NG) { if (sel & 1) ssm_tables(F, a, F.vcu, ts_a, ts_b); } } else { for (int g = F.vcu; g < NG; g += F.G) ssm_tables(F, a, g, ts_a, ts_b); }
    TSP9(121)
    unsigned char* ws = F.ws;
    const float* w_in = a.in(3); const float* xin = a.in(0); const float* n1w = a.in(2); bf16_t* xn = (bf16_t*)(ws + WS_XN);
    if (F.vcu == F.G - 1 && F.wave == 0) {
        const int l = F.lane; float s1 = a.in(6)[l] * a.in(7)[l] + a.in(6)[l + 64] * a.in(7)[l + 64], s2 = a.in(8)[l] * a.in(9)[l] + a.in(8)[l + 64] * a.in(9)[l + 64];
        s1 = wave_sum(s1); s2 = wave_sum(s2);
        if (l == 0) ((float*)(ws + WS_TAB))[0] = (float)(exp((double)s1) - exp((double)s2) + 0.2);
    }
    unsigned* head = (unsigned*)(F.ctl + CW_CNT + 8192);
    constexpr unsigned NCW = 128, NCH = NCW + T / 32;
    for (;;) {
        __syncthreads();
        if (F.tid == 0) F.MISC[16] = atomicAdd(head, 1u);
        __syncthreads();
        const unsigned c = F.MISC[16];
        if (c >= NCH) break;
        if (c < NCW) { if (sel & 2) { xpose_item(w_in, DIN, DIN, (bf16_t*)(ws + WS_W1T), D, nullptr, (int)c * 16 + F.wave * 2, F.lane); xpose_item(w_in, DIN, DIN, (bf16_t*)(ws + WS_W1T), D, nullptr, (int)c * 16 + F.wave * 2 + 1, F.lane); } }
        else if (sel & 4) { const int m = (int)(c - NCW) * 32 + F.wave * 4;
            rms_row2_to_bf16(xin + (size_t)m * D, xin + (size_t)(m + 1) * D, n1w, xn + (size_t)m * D, xn + (size_t)(m + 1) * D, F.lane);
            rms_row2_to_bf16(xin + (size_t)(m + 2) * D, xin + (size_t)(m + 3) * D, n1w, xn + (size_t)(m + 2) * D, xn + (size_t)(m + 3) * D, F.lane); }
    }
    TSP9(124)
}


struct AItem { int bh, qb0, qb1; };
__device__ __forceinline__ AItem a_decode(int L) { AItem it; it.bh = L >> 2; const int x = L & 3; it.qb0 = x; it.qb1 = 7 - x; return it; }
__device__ __forceinline__ attn::BlockRef<attn::bf16, attn::bf16> a_ref(const AItem& it, int pass, unsigned char* ws) {
    const int qb = pass ? it.qb1 : it.qb0, b = it.bh >> 4, vh = it.bh & 15, h = vh >> 2, c = (vh >> 1) & 1, vhalf = vh & 1;
    attn::BlockRef<attn::bf16, attn::bf16> r;
    r.Q = (const attn::bf16*)(ws + WS_QH) + ((size_t)(b * 8 + h * 2 + c) * SEQ + (size_t)qb * 256) * 128;
    r.K = (const attn::bf16*)(ws + WS_KH) + (size_t)(b * 8 + h * 2 + c) * SEQ * 128;
    r.V = (const attn::bf16*)(ws + WS_VH) + (size_t)(b * 8 + h * 2 + vhalf) * SEQ * 128;
    r.O = (attn::bf16*)(ws + WS_OH) + ((size_t)(b * 16 + vh) * SEQ + (size_t)qb * 256) * 128;
    r.P0 = qb * 256; return r;
}
__device__ __forceinline__ void p2_attention(Frame& F, char* lds) {
    using namespace attn;
    const int total = NB * 16 * 4, stride = F.G;
    int L = F.vcu; if (L >= total) return;
    AItem it = a_decode(L); int pass = 0;
    BlockRef<bf16, bf16> cur = a_ref(it, 0, F.ws);
    Seam<bf16> S;
    causal_swa_prime<bf16, bf16>(cur, SEQ, lds, S);
    for (;;) {
        const bool more_pass = pass == 0 && it.qb1 != it.qb0, more_item = L + stride < total, last = !more_pass && !more_item;
        AItem itn = it; int passn = pass + 1, Ln = L;
        if (!more_pass) { passn = 0; Ln = more_item ? L + stride : L; itn = a_decode(Ln); }
        const BlockRef<bf16, bf16> nxt = last ? cur : a_ref(itn, passn, F.ws);
        causal_swa_block<bf16, bf16>(cur, nxt, SEQ, SEQ, lds, S);
        if (last) break;
        cur = nxt; it = itn; pass = passn; L = Ln;
    }
}
__device__ __forceinline__ void p3_combine(Frame& F, const float* subln_w, int gw, int NGW) {
    const float lam = ((const float*)(F.ws + WS_TAB))[0];
    const bf16_t* Oh = (const bf16_t*)(F.ws + WS_OH); bf16_t* cat = (bf16_t*)(F.ws + WS_CAT);
    const int lane = F.lane, vhalf = lane >> 5, d = (lane & 31) * 4;
    const f32x4 w = *(const f32x4*)(subln_w + lane * 4);
    for (int it0 = gw; it0 < T * 4; it0 += 4 * NGW) {
        u32x2 a0[4], a1[4];
#pragma unroll
        for (int q = 0; q < 4; ++q) { const int it = it0 + q * NGW; if (it < T * 4) { const int t = it >> 2, h = it & 3, b = t / SEQ, s = t % SEQ;
            a0[q] = *(const u32x2*)(Oh + ((size_t)(b * 16 + h * 4 + 0 + vhalf) * SEQ + s) * 128 + d);
            a1[q] = *(const u32x2*)(Oh + ((size_t)(b * 16 + h * 4 + 2 + vhalf) * SEQ + s) * 128 + d); } else { a0[q] = (u32x2){0u, 0u}; a1[q] = (u32x2){0u, 0u}; } }
#pragma unroll
        for (int q = 0; q < 4; ++q) { const int it = it0 + q * NGW; if (it < T * 4) { const int t = it >> 2, h = it & 3;
            f32x4 v; v[0] = bf_lo(a0[q].x) - lam * bf_lo(a1[q].x); v[1] = bf_hi(a0[q].x) - lam * bf_hi(a1[q].x); v[2] = bf_lo(a0[q].y) - lam * bf_lo(a1[q].y); v[3] = bf_hi(a0[q].y) - lam * bf_hi(a1[q].y);
            const float ss = wave_sum((v[0] * v[0] + v[1] * v[1]) + (v[2] * v[2] + v[3] * v[3]));
            const float r = rsqrtf(ss * (1.f / 256.f) + EPS) * 0.8f;
            u32x2 o; o.x = pk2(v[0] * r * w[0], v[1] * r * w[1]); o.y = pk2(v[2] * r * w[2], v[3] * r * w[3]);
            *(u32x2*)(cat + (size_t)t * D + 1024 + h * 256 + lane * 4) = o; } }
    }
}

constexpr size_t MOE_REC = 0, MOE_TOK = 3 * MiB, MOE_RWL = 4 * MiB;
constexpr int CNT_STRIDE = 64;
constexpr int MT_CNT = 64, MT_START = 128, MT_MAX = 192;

__device__ __forceinline__ void p9_router(Frame& F, const AV& a, bool commit, unsigned long long& ts_a, unsigned long long& ts_b) {
    TSP9(100)
    LAS float* part = (LAS float*)F.lds;
    LAS float* logit = part + 8 * 10 * 256;
    const bf16_t* h2b = (const bf16_t*)(F.ws + WS_H1); const bf16_t* rwh = (const bf16_t*)(F.ws + WS_TAB + TAB_RWH); const bf16_t* rwl = (const bf16_t*)(F.ws + WS_TAB + TAB_RWL);
    const float* sq = (const float*)(F.ws + WS_SSQ) + SQ_H2; const float *bc = a.in(32), *bfv = a.in(34);
    unsigned* rec = (unsigned*)(F.ws + WS_MOE + MOE_REC); unsigned* cnt = (unsigned*)(F.ctl + CW_CNT);
    const int tid = F.tid, lane = tid & 63, wave = F.wave, fr = lane & 15, fq = lane >> 4;
#ifdef TLB_TOUCH
    if (commit) {
        const int loc = (F.vcu & 31) * NTHR + mk_otid();
        if (loc < 4096) { float t0_, t1_, t2_;
            asm volatile("global_load_dword %0, %1, off" : "=v"(t0_) : "v"(a.in(35) + (size_t)loc * 16384) : "memory");
            asm volatile("global_load_dword %0, %1, off" : "=v"(t1_) : "v"(a.in(36) + (size_t)loc * 16384) : "memory");
            asm volatile("global_load_dword %0, %1, off" : "=v"(t2_) : "v"(a.in(37) + (size_t)loc * 16384) : "memory");
            asm volatile("s_waitcnt vmcnt(0)" ::: "memory");
            asm volatile("" :: "v"(t0_), "v"(t1_), "v"(t2_)); } }
#endif
    for (int t0 = F.vcu * 32; t0 < T; t0 += F.G * 32) {
        f32x4 acc[2][5];
#pragma unroll
        for (int i = 0; i < 2; ++i)
#pragma unroll
            for (int c = 0; c < 5; ++c) acc[i][c] = (f32x4){0.f, 0.f, 0.f, 0.f};
#pragma unroll 2
        for (int ks = 0; ks < 8; ++ks) { const int k = wave * 256 + ks * 32 + fq * 8;
            bf16x8 xh[2];
#pragma unroll
            for (int rb = 0; rb < 2; ++rb) xh[rb] = *(const bf16x8*)(h2b + (size_t)(t0 + rb * 16 + fr) * D + k);
#pragma unroll
            for (int cb = 0; cb < 5; ++cb) { const bf16x8 wh = *(const bf16x8*)(rwh + (size_t)(cb * 16 + fr) * D + k), wl = *(const bf16x8*)(rwl + (size_t)(cb * 16 + fr) * D + k);
#pragma unroll
                for (int rb = 0; rb < 2; ++rb) { acc[rb][cb] = __builtin_amdgcn_mfma_f32_16x16x32_bf16(xh[rb], wh, acc[rb][cb], 0, 0, 0);
                    acc[rb][cb] = __builtin_amdgcn_mfma_f32_16x16x32_bf16(xh[rb], wl, acc[rb][cb], 0, 0, 0); } }
        }
        asm volatile("s_waitcnt vmcnt(0)" ::: "memory"); TSP9(101)
        __syncthreads();
#pragma unroll
        for (int rb = 0; rb < 2; ++rb)
#pragma unroll
            for (int cb = 0; cb < 5; ++cb) *(LAS f32x4*)(part + ((wave * 10 + rb * 5 + cb) * 64 + lane) * 4) = acc[rb][cb];
        __syncthreads();
        for (int e = tid; e < 10 * 256; e += NTHR) { float s = 0.f;
#pragma unroll
            for (int w = 0; w < 8; ++w) s += part[w * 2560 + e];
            const int tile = e >> 8, ln = (e >> 2) & 63, r = e & 3, rb = tile / 5, cb = tile % 5;
            logit[(rb * 16 + 4 * (ln >> 4) + r) * 80 + cb * 16 + (ln & 15)] = s; }
        __syncthreads();
        TSP9(102)
        if (tid < 32 && commit) { const int t = t0 + tid; float s = 0.f;
            for (int p = 0; p < 32; ++p) s += sq[(size_t)p * T + t];
            const float r3 = rsqrtf(s * (1.f / 2048.f) + EPS);
            const LAS float* lg = logit + tid * 80;
            int grp = 0; float lc[8];
#pragma unroll
            for (int g = 0; g < 8; ++g) { lc[g] = lg[g] * r3 + bc[g]; }
            float mx = lc[0];
#pragma unroll
            for (int g = 1; g < 8; ++g) if (lc[g] > mx) { mx = lc[g]; grp = g; }
            float se = 0.f;
#pragma unroll
            for (int g = 0; g < 8; ++g) se += __expf(lc[g] - mx);
            const float pgrp = 1.f / se;
            int j0 = 0, j1 = 0; float v0 = -3e38f, v1 = -3e38f;
            for (int j = 0; j < 8; ++j) { const float f = lg[8 + grp * 8 + j] * r3 + bfv[grp * 8 + j];
                if (f > v0) { v1 = v0; j1 = j0; v0 = f; j0 = j; } else if (f > v1) { v1 = f; j1 = j; } }
            const float e1 = __expf(v1 - v0), w0 = pgrp / (1.f + e1), w1 = pgrp * e1 / (1.f + e1);
            const int ea = grp * 8 + j0, eb = grp * 8 + j1;
            const unsigned pa = __hip_atomic_fetch_add(cnt + ea * CNT_STRIDE, 1u, RLX_AGENT), pb = __hip_atomic_fetch_add(cnt + eb * CNT_STRIDE, 1u, RLX_AGENT);
            u32x4 r0 = {(unsigned)ea, (unsigned)eb, __float_as_uint(w0), __float_as_uint(w1)}, r1 = {pa, pb, __float_as_uint(r3), 0u};
            *(u32x4*)(rec + (size_t)t * 8) = r0; *(u32x4*)(rec + (size_t)t * 8 + 4) = r1;
            { unsigned short* tokl = (unsigned short*)(F.ws + WS_MOE + MOE_TOK); float* rwl = (float*)(F.ws + WS_MOE + MOE_RWL);
              tokl[(size_t)ea * T + pa] = (unsigned short)t; tokl[(size_t)eb * T + pb] = (unsigned short)t; rwl[(size_t)ea * T + pa] = w0; rwl[(size_t)eb * T + pb] = w1; }
            logit[tid * 80 + 72] = r3; }
        __syncthreads(); TSP9(103)
        if (commit) {
            bf16_t* hn3 = (bf16_t*)(F.ws + WS_XN); const f32x4* nw = (const f32x4*)a.in(30);
            u32x4 wv[4][4];
#pragma unroll
            for (int q = 0; q < 4; ++q) { const u32x4* src = (const u32x4*)(h2b + (size_t)(t0 + wave * 4 + q) * D);
#pragma unroll
                for (int j = 0; j < 4; ++j) wv[q][j] = src[j * 64 + lane]; }
#pragma unroll
            for (int q = 0; q < 4; ++q) { const int tl = wave * 4 + q, t = t0 + tl; const float r3 = logit[tl * 80 + 72];
#pragma unroll
                for (int j = 0; j < 4; ++j) { const int c8 = j * 64 + lane; const u32x4 w = wv[q][j];
                    const f32x4 v0 = {bf_lo(w.x), bf_hi(w.x), bf_lo(w.y), bf_hi(w.y)}, v1 = {bf_lo(w.z), bf_hi(w.z), bf_lo(w.w), bf_hi(w.w)};
                    *(u32x4*)(hn3 + (size_t)t * D + c8 * 8) = pack8(v0 * r3 * nw[c8 * 2], v1 * r3 * nw[c8 * 2 + 1]); } } }
        __syncthreads(); TSP9(104)
    }
}
__device__ __forceinline__ void moe_tables(Frame& F) {
    volatile LAS unsigned* M = F.MISC; const unsigned* cnt = (const unsigned*)(F.ctl + CW_CNT);
    __syncthreads();
    if (F.tid < 64) { const unsigned c = __hip_atomic_load(cnt + F.tid * CNT_STRIDE, RLX_AGENT); unsigned s = c;
#pragma unroll
        for (int o = 1; o < 64; o <<= 1) { const unsigned v = __shfl_up(s, o); if ((F.tid & 63) >= o) s += v; }
        M[MT_CNT + F.tid] = c; M[MT_START + F.tid] = s - c;
        unsigned mx = c;
#pragma unroll
        for (int o = 1; o < 64; o <<= 1) { const unsigned v = __shfl_xor(mx, o); mx = v > mx ? v : mx; }
        if (F.tid == 0) M[MT_MAX] = mx; }
    __syncthreads();
}
#ifndef FG_PASS
#define FG_PASS 320
#endif
#ifndef FG_STREAM
#define FG_STREAM 0
#endif
#ifndef FG_ROT11
#define FG_ROT11 (jt * 4)
#endif
#ifndef FG_ROT12
#define FG_ROT12 0
#endif
#ifndef SIBSYNC
#define SIBSYNC 0
#endif
constexpr int FG_ROWS = 320, FG_MF = 5, FG_ABUF = FG_ROWS * 128, FG_BOFF = 3 * FG_ABUF, FG_BBUF = 128 * 128;
#define FG_DMA(slot, tile) do { _Pragma("unroll") for (int i_ = 0; i_ < 10; ++i_) if (i_ < 8 || i_ < nA) \
    __builtin_amdgcn_global_load_lds((const unsigned*)(Ab + (size_t)(tile) * 128 + rowoff[i_]), (LAS unsigned*)(lds + (slot) * FG_ABUF + (i_ * 4 + wave) * 1024), 16, 0, 0); } while (0)
#define FG_BLOAD(S, tile) do { unsigned long long p_ = (unsigned long long)(bsrc + (size_t)(tile) * 64 * ldb); asm volatile("" : "+v"(p_)); _Pragma("unroll") for (int r_ = 0; r_ < 8; ++r_) \
    asm volatile("global_load_dwordx4 %0, %1, off nt" : "=v"(bst##S[r_]) : "v"(p_ + (unsigned long long)r_ * ldb * 4) : "memory"); } while (0)
#define FG_BWRITE(S, buf) do { asm volatile("" : "+v"(bst##S[0]), "+v"(bst##S[1]), "+v"(bst##S[2]), "+v"(bst##S[3]), "+v"(bst##S[4]), "+v"(bst##S[5]), "+v"(bst##S[6]), "+v"(bst##S[7])); \
    _Pragma("unroll") for (int c_ = 0; c_ < 4; ++c_) { u32x4 w_; w_.x = cvt_pk_bf16(bst##S[0][c_], bst##S[1][c_]); w_.y = cvt_pk_bf16(bst##S[2][c_], bst##S[3][c_]); \
    w_.z = cvt_pk_bf16(bst##S[4][c_], bst##S[5][c_]); w_.w = cvt_pk_bf16(bst##S[6][c_], bst##S[7][c_]); \
    *(LAS u32x4*)(lds + FG_BOFF + (buf) * FG_BBUF + (4 * nq + c_) * 128 + ((kq ^ ((4 * nq + c_) & 7)) * 16)) = w_; } } while (0)
#define FG_WAITV(n) asm volatile("s_waitcnt vmcnt(%0)" :: "n"(n) : "memory")
#define FG_WAITVA(base) do { if (nA == 10) FG_WAITV((base) + 10); else if (nA == 9) FG_WAITV((base) + 9); else FG_WAITV((base) + 8); } while (0)
#define FG_BAR() do { asm volatile("s_waitcnt lgkmcnt(0)" ::: "memory"); __builtin_amdgcn_s_barrier(); asm volatile("" ::: "memory"); } while (0)
#define FG_ROT(t_) (((t_) + rot) & (nkt - 1))
#define FG_LSTEP(t, S0, S1) do { if ((t) < nkt) { \
    if (!(MODE & 2) && (t) + 2 < nkt) FG_DMA(((t) + 2) % 3, FG_ROT((t) + 2)); \
    if (!(MODE & 1) && (t) + 3 < nkt) FG_BLOAD(S0, FG_ROT((t) + 3)); \
    if ((t) + 1 < nkt) { if ((t) + 3 < nkt) { if (MODE & 2) FG_WAITV(2 * NBL); else FG_WAITVA(2 * NBL); } else if ((t) + 2 < nkt) { if (MODE & 2) FG_WAITV(NBL); else FG_WAITVA(NBL); } else FG_WAITV(0); \
        __builtin_amdgcn_sched_barrier(0); FG_BWRITE(S1, ((t) + 1) & 1); } \
    FG_BAR(); } } while (0)
template <bool ACT, int MODE = 0>
__device__ __forceinline__ void fg_unit(Frame& F, const bf16_t* A, int lda, int K, int nrows, const float* Bg, const float* Bu, int ldb, bf16_t* O, int ldo, const float* roww,
                                        const unsigned short* tokl = nullptr, unsigned* sync = nullptr, unsigned nsib = 8, int rot = 0) {
    LAS unsigned char* lds = F.lds;
    const int nkt = K / 64;
    for (int r0 = 0; r0 < nrows; r0 += FG_PASS) {
        const int pend = (r0 + FG_PASS < nrows) ? r0 + FG_PASS : nrows;
        constexpr int NC = ACT ? 64 : 128;
        LAS unsigned short* img = (LAS unsigned short*)lds;
        if (F.wave < 4) {
            const int wave = F.wave;
            int nA = (pend - r0 - wave * 8 + 31) >> 5; nA = nA < 8 ? 8 : (nA > 10 ? 10 : nA);
#ifdef FG_NOSKIP
            nA = 10;
#endif
            const char* Ab = (const char*)A + (ACT ? (size_t)0 : (size_t)r0 * lda * 2);
            unsigned rowoff[10];
            { const int l_ = mk_otid() & 63;
#pragma unroll
              for (int i = 0; i < 10; ++i) { const int row = i * 32 + wave * 8 + (l_ >> 3); const unsigned rr = ACT ? ((r0 + row < pend) ? (unsigned)tokl[r0 + row] : 0u) : (unsigned)row;
                  rowoff[i] = (rr * (unsigned)lda + (unsigned)(((l_ & 7) ^ ((l_ >> 3) & 7)) * 8)) * 2u; } }
            const int ltid = mk_otid() & 255, kq = ltid >> 5, nq = ltid & 31;
            const float* bsrc = (ACT ? (nq < 16 ? Bg + 4 * nq : Bu + 4 * (nq - 16)) : Bg + 4 * nq) + (size_t)(8 * kq) * ldb;
            constexpr int NBL = (MODE & 1) ? 0 : 8;
            f32x4 bst0[8], bst1[8], bst2[8];
            if (!(MODE & 2)) FG_DMA(0, FG_ROT(0)); if (!(MODE & 1)) FG_BLOAD(0, FG_ROT(0)); if (!(MODE & 2)) FG_DMA(1, FG_ROT(1)); if (!(MODE & 1)) { FG_BLOAD(1, FG_ROT(1)); FG_BLOAD(2, FG_ROT(2)); }
            if (MODE & 2) FG_WAITV(2 * NBL); else FG_WAITVA(2 * NBL);
            __builtin_amdgcn_sched_barrier(0);
            FG_BWRITE(0, 0);
            FG_BAR();
            for (int t0 = 0; t0 < nkt; t0 += 3) { FG_LSTEP(t0, 0, 1); FG_LSTEP(t0 + 1, 1, 2); FG_LSTEP(t0 + 2, 2, 0); }
        } else {
            const int cw = F.wave - 4, lane = mk_otid() & 63, fr = lane & 15, fq = lane >> 4;
            f32x4 acc[FG_MF][8];
#pragma unroll
            for (int i = 0; i < FG_MF; ++i)
#pragma unroll
                for (int j = 0; j < 8; ++j) acc[i][j] = (f32x4){0.f, 0.f, 0.f, 0.f};
            const int abase = (cw * (FG_MF * 16) + fr) * 128, bbase = FG_BOFF + fr * 128;
            const int swz0 = ((fq) ^ (fr & 7)) * 16, swz1 = ((4 + fq) ^ (fr & 7)) * 16;
            FG_BAR();
            for (int t = 0; t < nkt; ++t) {
                if (!(MODE & 4)) { LAS unsigned char* ca = lds + (t % 3) * FG_ABUF + abase; LAS unsigned char* cb = lds + (t & 1) * FG_BBUF + bbase;
#pragma unroll
                    for (int ks = 0; ks < 2; ++ks) { const int swz = ks ? swz1 : swz0; bf16x8 bf[8], af[FG_MF];
#pragma unroll
                        for (int nf = 0; nf < 8; ++nf) bf[nf] = *(const LAS bf16x8*)(cb + swz + nf * 2048);
#pragma unroll
                        for (int mf = 0; mf < FG_MF; ++mf) af[mf] = *(const LAS bf16x8*)(ca + swz + mf * 2048);
                        __builtin_amdgcn_sched_barrier(0); __builtin_amdgcn_s_setprio(1);
#pragma unroll
                        for (int mf = 0; mf < FG_MF; ++mf)
#pragma unroll
                            for (int nf = 0; nf < 8; ++nf) acc[mf][nf] = __builtin_amdgcn_mfma_f32_16x16x32_bf16(af[mf], bf[nf], acc[mf][nf], 0, 0, 0);
                        __builtin_amdgcn_s_setprio(0); __builtin_amdgcn_sched_barrier(0); } }
                if (sync != nullptr && r0 == 0 && cw == 0 && (t & 7) == 7 && t + 1 < nkt) {
                    if (lane == 0) { unsigned* sp = sync + (t >> 3); __hip_atomic_fetch_add(sp, 1u, __ATOMIC_RELAXED, __HIP_MEMORY_SCOPE_AGENT);
                        unsigned spin = 0; while (__hip_atomic_load(sp, __ATOMIC_RELAXED, __HIP_MEMORY_SCOPE_AGENT) < nsib && ++spin < 200000u) __builtin_amdgcn_s_sleep(2); } }
                FG_BAR();
            }
            if (MODE == 0) {
                constexpr int NC = ACT ? 64 : 128, RS = NC * 2 + 16, CPR = NC / 8;
                LAS unsigned char* stg = lds + FG_BOFF + FG_BBUF + cw * 4608;
#pragma unroll
                for (int mf = 0; mf < FG_MF; ++mf) {
#pragma unroll
                    for (int r = 0; r < 4; ++r) { const int rl = fq * 4 + r, row = cw * (FG_MF * 16) + mf * 16 + rl;
                        if constexpr (ACT) {
#pragma unroll
                            for (int h = 0; h < 4; ++h) { const float g = acc[mf][h][r], up = acc[mf][4 + h][r]; const float v = g * sigmoid_fast(g) * up;
                                *(LAS unsigned short*)(stg + rl * RS + (h * 16 + fr) * 2) = (unsigned short)f2bf(v); }
                        } else {
                            const float w = (r0 + row < pend) ? roww[r0 + row] : 0.f;
#pragma unroll
                            for (int nf = 0; nf < 8; ++nf) *(LAS unsigned short*)(stg + rl * RS + (nf * 16 + fr) * 2) = (unsigned short)f2bf(acc[mf][nf][r] * w);
                        }
                    }
                    asm volatile("s_waitcnt lgkmcnt(0)" ::: "memory");
#pragma unroll
                    for (int q = 0; q < (16 * CPR) / 64; ++q) { const int sidx = q * 64 + lane, rl = sidx / CPR, ch = sidx % CPR, row = cw * (FG_MF * 16) + mf * 16 + rl;
                        const u32x4 v = *(const LAS u32x4*)(stg + rl * RS + ch * 16);
                        if (r0 + row < pend) *(u32x4*)(O + (size_t)(r0 + row) * ldo + ch * 8) = v; }
                    asm volatile("s_waitcnt lgkmcnt(0)" ::: "memory");
                }
            }
        }
    }
}
template <bool ACT>
__device__ __forceinline__ void fg_stream(Frame& F, const AV& args, const int nv) {
    LAS unsigned char* lds = F.lds; unsigned char* ws = F.ws;
    constexpr int K = ACT ? D : DFF, nkt = K / 64, lda = ACT ? D : DFF, ldb = ACT ? DFF : D, ldo = ACT ? DFF : D;
    const int NT = nv * nkt, G = F.G, vcu = F.vcu;
    if (F.wave < 4) {
        const int wave = F.wave;
        const int l_ = mk_otid() & 63;
        const int ltid = mk_otid() & 255, kq = ltid >> 5, nq = ltid & 31;
        const char* Ab; unsigned rowoff[10]; unsigned rowoff1[10];
        int nA; { int nmax = 0; for (int v = 0; v < nv; ++v) { const int L = vcu + v * G, n_ = (int)F.MISC[MT_CNT + (ACT ? (L >> 3) : (L >> 4))]; nmax = n_ > nmax ? n_ : nmax; }
                  nA = (nmax - wave * 8 + 31) >> 5; nA = nA < 8 ? 8 : (nA > 10 ? 10 : nA); }
        const unsigned swz_ = (unsigned)(((l_ & 7) ^ ((l_ >> 3) & 7)) * 8);
        if constexpr (ACT) {
            Ab = (const char*)(ws + WS_XN);
            { const int e = vcu >> 3, n = (int)F.MISC[MT_CNT + e]; const unsigned short* tokl = (const unsigned short*)(ws + WS_MOE + MOE_TOK) + (size_t)e * T;
#pragma unroll
              for (int i = 0; i < 10; ++i) { const int row = i * 32 + wave * 8 + (l_ >> 3); const unsigned rr = (row < n) ? (unsigned)tokl[row] : 0u; rowoff[i] = (rr * (unsigned)lda + swz_) * 2u; } }
            if (nv > 1) { const int e = (vcu + G) >> 3, n = (int)F.MISC[MT_CNT + e]; const unsigned short* tokl = (const unsigned short*)(ws + WS_MOE + MOE_TOK) + (size_t)e * T;
#pragma unroll
              for (int i = 0; i < 10; ++i) { const int row = i * 32 + wave * 8 + (l_ >> 3); const unsigned rr = (row < n) ? (unsigned)tokl[row] : 0u; rowoff1[i] = (rr * (unsigned)lda + swz_) * 2u; } }
            else {
#pragma unroll
              for (int i = 0; i < 10; ++i) rowoff1[i] = rowoff[i]; }
        } else {
            Ab = (const char*)(ws + WS_ACT) + (size_t)F.MISC[MT_START + (vcu >> 4)] * (DFF * 2);
#pragma unroll
            for (int i = 0; i < 10; ++i) { const int row = i * 32 + wave * 8 + (l_ >> 3); rowoff[i] = ((unsigned)row * (unsigned)lda + swz_) * 2u; rowoff1[i] = 0; }
        }
#define FS_BBASE(v_) (ACT ? ((nq < 16 ? args.in(35) : args.in(36)) + (size_t)((vcu + (v_) * G) >> 3) * D * DFF + ((vcu + (v_) * G) & 7) * 64 + 4 * (nq & 15) + (size_t)(8 * kq) * ldb) \
                          : (args.in(37) + (size_t)((vcu + (v_) * G) >> 4) * DFF * D + ((vcu + (v_) * G) & 15) * 128 + 4 * nq + (size_t)(8 * kq) * ldb))
        const float* pB = FS_BBASE(0);
        int ktB = 0, vB = 0, ktA = 0, vA = 0, ktC = 0;
#define FS_BLOAD(S) do { unsigned long long p_ = (unsigned long long)pB; asm volatile("" : "+v"(p_)); _Pragma("unroll") for (int r_ = 0; r_ < 8; ++r_) \
    asm volatile("global_load_dwordx4 %0, %1, off nt" : "=v"(bst##S[r_]) : "v"(p_ + (unsigned long long)r_ * ldb * 4) : "memory"); \
    if (++ktB == nkt) { ktB = 0; ++vB; if (vB < nv) pB = FS_BBASE(vB); } else pB += (size_t)64 * ldb; } while (0)
#define FS_DMA(slot) do { FG_DMA(slot, ktA); if (++ktA == nkt) { ktA = 0; ++vA; if (vA < nv) { \
    if constexpr (ACT) { _Pragma("unroll") for (int i_ = 0; i_ < 10; ++i_) rowoff[i_] = rowoff1[i_]; } \
    else Ab = (const char*)(ws + WS_ACT) + (size_t)F.MISC[MT_START + ((vcu + vA * G) >> 4)] * (DFF * 2); } } } while (0)
#define FS_STEP(g, PH, S0, S1) do { if ((g) < NT) { \
    if ((g) + 2 < NT) FS_DMA(((PH) + 2) % 3); \
    if ((g) + 3 < NT) FS_BLOAD(S0); \
    if ((g) + 1 < NT) { if ((g) + 3 < NT) FG_WAITVA(16); else if ((g) + 2 < NT) FG_WAITVA(8); else FG_WAITV(0); \
        if (ktC == 0 && (g) > 0) FG_BAR(); \
        __builtin_amdgcn_sched_barrier(0); FG_BWRITE(S1, ((g) + 1) & 1); } \
    FG_BAR(); if (++ktC == nkt) ktC = 0; } } while (0)
        f32x4 bst0[8], bst1[8], bst2[8];
        FS_DMA(0); FS_BLOAD(0); FS_DMA(1); FS_BLOAD(1); FS_BLOAD(2);
        FG_WAITVA(16);
        __builtin_amdgcn_sched_barrier(0);
        FG_BWRITE(0, 0);
        FG_BAR();
        for (int g0 = 0; g0 < NT; g0 += 3) { FS_STEP(g0, 0, 0, 1); FS_STEP(g0 + 1, 1, 1, 2); FS_STEP(g0 + 2, 2, 2, 0); }
    } else {
        const int cw = F.wave - 4, lane = mk_otid() & 63, fr = lane & 15, fq = lane >> 4;
        const int abase = (cw * (FG_MF * 16) + fr) * 128, bbase = FG_BOFF + fr * 128;
        const int swz0 = ((fq) ^ (fr & 7)) * 16, swz1 = ((4 + fq) ^ (fr & 7)) * 16;
        int slot = 0, par = 0;
        FG_BAR();
        for (int v = 0; v < nv; ++v) {
            f32x4 acc[FG_MF][8];
#pragma unroll
            for (int i = 0; i < FG_MF; ++i)
#pragma unroll
                for (int j = 0; j < 8; ++j) acc[i][j] = (f32x4){0.f, 0.f, 0.f, 0.f};
            for (int t = 0; t < nkt; ++t) {
                { LAS unsigned char* ca = lds + slot * FG_ABUF + abase; LAS unsigned char* cb = lds + par * FG_BBUF + bbase;
#pragma unroll
                    for (int ks = 0; ks < 2; ++ks) { const int swz = ks ? swz1 : swz0; bf16x8 bf[8], af[FG_MF];
#pragma unroll
                        for (int nf = 0; nf < 8; ++nf) bf[nf] = *(const LAS bf16x8*)(cb + swz + nf * 2048);
#pragma unroll
                        for (int mf = 0; mf < FG_MF; ++mf) af[mf] = *(const LAS bf16x8*)(ca + swz + mf * 2048);
                        __builtin_amdgcn_sched_barrier(0); __builtin_amdgcn_s_setprio(1);
#pragma unroll
                        for (int mf = 0; mf < FG_MF; ++mf)
#pragma unroll
                            for (int nf = 0; nf < 8; ++nf) acc[mf][nf] = __builtin_amdgcn_mfma_f32_16x16x32_bf16(af[mf], bf[nf], acc[mf][nf], 0, 0, 0);
                        __builtin_amdgcn_s_setprio(0); __builtin_amdgcn_sched_barrier(0); } }
                FG_BAR();
                slot = (slot == 2) ? 0 : slot + 1; par ^= 1;
            }
            {
                const int lane = mk_otid() & 63, fr = lane & 15, fq = lane >> 4;
                const int L = vcu + v * G, e = ACT ? (L >> 3) : (L >> 4), ct = ACT ? (L & 7) : (L & 15);
                const int row0 = (int)F.MISC[MT_START + e], pend = (int)F.MISC[MT_CNT + e];
                bf16_t* O = ACT ? (bf16_t*)(ws + WS_ACT) + (size_t)row0 * DFF + ct * 64 : (bf16_t*)(ws + WS_YS) + (size_t)row0 * D + ct * 128;
                const float* roww = (const float*)(ws + WS_MOE + MOE_RWL) + (size_t)e * T;
                constexpr int NC = ACT ? 64 : 128, RS = NC * 2 + 16, CPR = NC / 8;
                LAS unsigned char* stg = lds + FG_BOFF + FG_BBUF + cw * 4608;
#pragma unroll
                for (int mf = 0; mf < FG_MF; ++mf) {
#pragma unroll
                    for (int r = 0; r < 4; ++r) { const int rl = fq * 4 + r, row = cw * (FG_MF * 16) + mf * 16 + rl;
                        if constexpr (ACT) {
#pragma unroll
                            for (int h = 0; h < 4; ++h) { const float g = acc[mf][h][r], up = acc[mf][4 + h][r]; const float vv = g * sigmoid_fast(g) * up;
                                *(LAS unsigned short*)(stg + rl * RS + (h * 16 + fr) * 2) = (unsigned short)f2bf(vv); }
                        } else {
                            const float w = (row < pend) ? roww[row] : 0.f;
#pragma unroll
                            for (int nf = 0; nf < 8; ++nf) *(LAS unsigned short*)(stg + rl * RS + (nf * 16 + fr) * 2) = (unsigned short)f2bf(acc[mf][nf][r] * w);
                        }
                    }
                    asm volatile("s_waitcnt lgkmcnt(0)" ::: "memory");
#pragma unroll
                    for (int q = 0; q < (16 * CPR) / 64; ++q) { const int sidx = q * 64 + lane, rl = sidx / CPR, ch = sidx % CPR, row = cw * (FG_MF * 16) + mf * 16 + rl;
                        const u32x4 vv = *(const LAS u32x4*)(stg + rl * RS + ch * 16);
                        if (row < pend) *(u32x4*)(O + (size_t)row * ldo + ch * 8) = vv; }
                    asm volatile("s_waitcnt lgkmcnt(0)" ::: "memory");
                }
            }
            if (v + 1 < nv) FG_BAR();
        }
    }
}
__device__ __forceinline__ void p13_combine(Frame& F, const AV& a, bool commit = true, bool tables = true) {
    if (tables) moe_tables(F);
    const unsigned* rec = (const unsigned*)(F.ws + WS_MOE + MOE_REC); const bf16_t* ys = (const bf16_t*)(F.ws + WS_YS);
    const int lane = F.lane;
    for (int t = F.vcu * NWAVES + F.wave; t < T; t += F.G * NWAVES) {
        const u32x4 r0 = *(const u32x4*)(rec + (size_t)t * 8), r1 = *(const u32x4*)(rec + (size_t)t * 8 + 4);
        const unsigned rowa = F.MISC[MT_START + r0.x] + r1.x, rowb = F.MISC[MT_START + r0.y] + r1.y;
        f32x4* o = (f32x4*)(a.out() + (size_t)t * D); const u32x4* hb = (const u32x4*)((const bf16_t*)(F.ws + WS_H1) + (size_t)t * D);
#pragma unroll
        for (int j = 0; j < 4; ++j) { const int c8 = j * 64 + lane;
            const u32x4 ya = *(const u32x4*)(ys + (size_t)rowa * D + c8 * 8), yb = *(const u32x4*)(ys + (size_t)rowb * D + c8 * 8), hw = hb[c8];
            f32x4 v0, v1;
            v0[0] = bf_lo(hw.x) + bf_lo(ya.x) + bf_lo(yb.x); v0[1] = bf_hi(hw.x) + bf_hi(ya.x) + bf_hi(yb.x); v0[2] = bf_lo(hw.y) + bf_lo(ya.y) + bf_lo(yb.y); v0[3] = bf_hi(hw.y) + bf_hi(ya.y) + bf_hi(yb.y);
            v1[0] = bf_lo(hw.z) + bf_lo(ya.z) + bf_lo(yb.z); v1[1] = bf_hi(hw.z) + bf_hi(ya.z) + bf_hi(yb.z); v1[2] = bf_lo(hw.w) + bf_lo(ya.w) + bf_lo(yb.w); v1[3] = bf_hi(hw.w) + bf_hi(ya.w) + bf_hi(yb.w);
            if (commit) { o[c8 * 2] = v0; o[c8 * 2 + 1] = v1; } else { asm volatile("" :: "v"(v0), "v"(v1)); } }
    }
}

__device__ __forceinline__ void mid_weight_copies(Frame& F, const AV& a, int gw, int NGW) {
    unsigned char* ws = F.ws; const float *glu_w = a.in(19), *xkv_w = a.in(26);
    constexpr int J1 = 256, J2 = J1 + 1024, J3 = J2 + 1024;
    for (int it = gw; it < J3; it += NGW) {
        if (it < J1) xpose_item(glu_w, DSSM, DSSM, (bf16_t*)(ws + WS_WGLU), DSSM, nullptr, it, F.lane);
        else if (it < J2) xpose_item(xkv_w, 4096, D, (bf16_t*)(ws + WS_WXK), D, nullptr, it - J1, F.lane);
        else xpose_item(xkv_w + 2048, 4096, D, (bf16_t*)(ws + WS_WXV), D, nullptr, it - J2, F.lane);
    }
    for (int m = NGW - 1 - gw; m < TM; m += NGW) rms_row_to_bf16(a.in(1) + (size_t)m * D, a.in(24), (bf16_t*)(ws + WS_MN) + (size_t)m * D, F.lane);
}

__device__ __forceinline__ void late_weight_copies(Frame& F, const AV& a, int gw, int NGW) {
    unsigned char* ws = F.ws; const float *ssm_out_w = a.in(21), *w_out = a.in(22), *norm2_w = a.in(23), *xq_w = a.in(25), *xo_w = a.in(29);
    constexpr int K0 = 512, K1 = K0 + 512, K2 = K1 + 1024, K3 = K2 + 1024;
    for (int it = gw; it < K3; it += NGW) {
        if (it < K0) xpose_item(w_out, D, D, (bf16_t*)(ws + WS_WOUT) + 1024, D, nullptr, it, F.lane);
        else if (it < K1) xpose_item(w_out + (size_t)1024 * D, D, D, (bf16_t*)(ws + WS_WOUT), D, ssm_out_w, it - K0, F.lane);
        else if (it < K2) xpose_item(xq_w, D, D, (bf16_t*)(ws + WS_WXQ), D, norm2_w, it - K1, F.lane);
        else xpose_item(xo_w, D, D, (bf16_t*)(ws + WS_WXO), D, nullptr, it - K2, F.lane);
    }
    const float* norm3_w = a.in(30);
    { bf16_t* rwh = (bf16_t*)(ws + WS_TAB + TAB_RWH); bf16_t* rwl = (bf16_t*)(ws + WS_TAB + TAB_RWL); const float *rc_w = a.in(31), *rf_w = a.in(33);
      for (int i = gw * 64 + F.lane; i < 80 * D; i += NGW * 64) { const int c = i / D, k = i % D; float v = c < 8 ? rc_w[k * 8 + c] : (c < 72 ? rf_w[k * 64 + c - 8] : 0.f); v *= norm3_w[k];
          const unsigned hb = f2bf(v); rwh[i] = (bf16_t)hb; rwl[i] = (bf16_t)f2bf(v - __uint_as_float(hb << 16)); } }
}


#ifdef PROBE_STREAM
__device__ __forceinline__ void stream_probe(Frame& F, const AV& args) {
    const int tid = mk_otid(), lane = tid & 63, wave = tid >> 6;
    LAS unsigned* dummy = (LAS unsigned*)(F.lds + RING_OFF + wave * 1024);
#if PROBE_STREAM == 1
    for (int L = F.vcu; L < NE * 8; L += F.G) { const int e = L >> 3, jt = L & 7;
        const char* g = (const char*)(args.in(35) + (size_t)e * D * DFF + jt * 64) + (size_t)(wave * 4 + (lane >> 4)) * (DFF * 4) + (lane & 15) * 16;
        const char* u = (const char*)(args.in(36) + (size_t)e * D * DFF + jt * 64) + (size_t)(wave * 4 + (lane >> 4)) * (DFF * 4) + (lane & 15) * 16;
        for (int kb = 0; kb < D / 32; ++kb) {
            __builtin_amdgcn_global_load_lds((const unsigned*)(g + (size_t)kb * 32 * DFF * 4), dummy, 16, 0, 0);
            __builtin_amdgcn_global_load_lds((const unsigned*)(u + (size_t)kb * 32 * DFF * 4), dummy, 16, 0, 0);
            asm volatile("s_waitcnt vmcnt(12)" ::: "memory");
        } }
#elif PROBE_STREAM == 2
    for (int L = F.vcu; L < NE * 8; L += F.G) {
        const char* g = (const char*)args.in(35) + (size_t)L * (1 << 19) + wave * 1024 + lane * 16;
        const char* u = (const char*)args.in(36) + (size_t)L * (1 << 19) + wave * 1024 + lane * 16;
        for (int kb = 0; kb < 64; ++kb) {
            __builtin_amdgcn_global_load_lds((const unsigned*)(g + (size_t)kb * 8192), dummy, 16, 0, 0);
            __builtin_amdgcn_global_load_lds((const unsigned*)(u + (size_t)kb * 8192), dummy, 16, 0, 0);
            asm volatile("s_waitcnt vmcnt(12)" ::: "memory");
        } }
#elif PROBE_STREAM == 3
    for (int L = F.vcu; L < NE * 16; L += F.G) { const int e = L >> 4, nt = L & 15;
        const char* g = (const char*)(args.in(37) + (size_t)e * DFF * D + nt * 128) + (size_t)(wave * 2 + (lane >> 5)) * (D * 4) + (lane & 31) * 16;
        for (int kb = 0; kb < DFF / 16; kb += 2) {
            __builtin_amdgcn_global_load_lds((const unsigned*)(g + (size_t)kb * 16 * D * 4), dummy, 16, 0, 0);
            __builtin_amdgcn_global_load_lds((const unsigned*)(g + (size_t)(kb + 1) * 16 * D * 4), dummy, 16, 0, 0);
            asm volatile("s_waitcnt vmcnt(12)" ::: "memory");
        } }
#elif PROBE_STREAM == 4
    for (int L = F.vcu; L < NE * 16; L += F.G) {
        const char* g = (const char*)args.in(37) + (size_t)L * (1 << 18) + wave * 1024 + lane * 16;
        for (int kb = 0; kb < 32; kb += 2) {
            __builtin_amdgcn_global_load_lds((const unsigned*)(g + (size_t)kb * 8192), dummy, 16, 0, 0);
            __builtin_amdgcn_global_load_lds((const unsigned*)(g + (size_t)(kb + 1) * 8192), dummy, 16, 0, 0);
            asm volatile("s_waitcnt vmcnt(12)" ::: "memory");
        } }
#elif PROBE_STREAM >= 5 && PROBE_STREAM <= 9
    if (wave < 4) {
    const int ltid = tid, kq = ltid >> 5, nq = ltid & 31;
    for (int L = F.vcu; L < NE * 8; L += F.G) { const int e = L >> 3, jt = L & 7;
        const float* base = (nq < 16 ? args.in(35) : args.in(36)) + (size_t)e * D * DFF + jt * 64 + (nq & 15) * 4 + (size_t)(8 * kq) * DFF;
        pg8::f32x4 s0[8], s1[8], s2[8]; pg8::f32x4 spc[8]; int spb = 0; (void)spc; (void)spb;
#define SP_LD(S, t_) { const float* bp = base + (size_t)((t_) < 32 ? (t_) : 31) * 64 * DFF; _Pragma("unroll") for (int r_ = 0; r_ < 8; ++r_) { SP_ONE(S[r_], bp + (size_t)r_ * DFF); } }
#if PROBE_STREAM == 5 || PROBE_STREAM >= 8
#define SP_ONE(v_, p_) asm volatile("global_load_dwordx4 %0, %1, off nt" : "=v"(v_) : "v"(p_) : "memory")
#elif PROBE_STREAM == 6
#define SP_ONE(v_, p_) asm volatile("global_load_dwordx4 %0, %1, off" : "=v"(v_) : "v"(p_) : "memory")
#else
#define SP_ONE(v_, p_) __builtin_amdgcn_global_load_lds((const unsigned*)(p_), dummy, 16, 0, 0)
#endif
#if PROBE_STREAM >= 9
#define SP_BAR { _Pragma("unroll") for (int c_ = 0; c_ < 4; ++c_) { u32x4 w_; w_.x = cvt_pk_bf16(spc[0][c_], spc[1][c_]); w_.y = cvt_pk_bf16(spc[2][c_], spc[3][c_]); \
    w_.z = cvt_pk_bf16(spc[4][c_], spc[5][c_]); w_.w = cvt_pk_bf16(spc[6][c_], spc[7][c_]); \
    *(LAS u32x4*)(F.lds + FG_BOFF + (spb & 1) * FG_BBUF + (4 * nq + c_) * 128 + ((kq ^ ((4 * nq + c_) & 7)) * 16)) = w_; } ++spb; \
    asm volatile("s_waitcnt lgkmcnt(0)" ::: "memory"); __builtin_amdgcn_s_barrier(); }
#elif PROBE_STREAM >= 8
#define SP_BAR __builtin_amdgcn_s_barrier();
#else
#define SP_BAR
#endif
#if PROBE_STREAM >= 9
#define SP_USE(S) { _Pragma("unroll") for (int r_ = 0; r_ < 8; ++r_) { asm volatile("" : "+v"(S[r_])); spc[r_] = S[r_]; } }
#else
#define SP_USE(S) { _Pragma("unroll") for (int r_ = 0; r_ < 8; ++r_) asm volatile("" :: "v"(S[r_])); }
#endif
        SP_LD(s0, 0) SP_LD(s1, 1)
        for (int t = 0; t < 33; t += 3) {
            SP_LD(s2, t + 2) asm volatile("s_waitcnt vmcnt(16)" ::: "memory"); SP_USE(s0) SP_BAR
            SP_LD(s0, t + 3) asm volatile("s_waitcnt vmcnt(16)" ::: "memory"); SP_USE(s1) SP_BAR
            SP_LD(s1, t + 4) asm volatile("s_waitcnt vmcnt(16)" ::: "memory"); SP_USE(s2) SP_BAR
        }
        asm volatile("s_waitcnt vmcnt(0)" ::: "memory"); SP_USE(s0) SP_USE(s1)
        }
    }
#if PROBE_STREAM >= 8
    else { for (int L = F.vcu; L < NE * 8; L += F.G) for (int t = 0; t < 33; ++t) __builtin_amdgcn_s_barrier(); }
#endif
#elif PROBE_STREAM == 10 || PROBE_STREAM == 11 || PROBE_STREAM == 12
    LAS unsigned char* lds = F.lds;
    const char* Ab = (const char*)(F.ws + WS_XN);
    constexpr int lda = D;
    if (wave < 4) {
        const int ltid = tid, kq = ltid >> 5, nq = ltid & 31;
#if PROBE_STREAM == 10 || PROBE_STREAM == 12
        unsigned rowoff[10];
#endif
        for (int L = F.vcu; L < NE * 8; L += F.G) { const int e = L >> 3, jt = L & 7;
#if PROBE_STREAM == 10 || PROBE_STREAM == 12
#pragma unroll
            for (int i = 0; i < 10; ++i) { const int row = i * 32 + wave * 8 + (lane >> 3); const unsigned rr = (unsigned)((e * 128 + row * 25) & 8191);
                rowoff[i] = (rr * (unsigned)lda + (unsigned)(((lane & 7) ^ ((lane >> 3) & 7)) * 8)) * 2u; }
#define SPA_DMA(t_) FG_DMA(((t_) % 3), ((t_) < 32 ? (t_) : 31));
#define SPA_N 10
#else
#define SPA_DMA(t_)
#define SPA_N 0
#endif
            const float* base = (nq < 16 ? args.in(35) : args.in(36)) + (size_t)e * D * DFF + jt * 64 + (nq & 15) * 4 + (size_t)(8 * kq) * DFF;
            f32x4 s0[8], s1[8], s2[8]; f32x4 spc[8]; int spb = 0;
#if PROBE_STREAM == 12
#define SQ_LD(S, t_) { _Pragma("unroll") for (int r_ = 0; r_ < 8; ++r_) S[r_] = (f32x4){0.f, 0.f, 0.f, 0.f}; }
#undef FG_WAITV
#define FG_WAITV(n) asm volatile("s_waitcnt vmcnt(10)" ::: "memory")
#else
#define SQ_LD(S, t_) { const float* bp = base + (size_t)((t_) < 32 ? (t_) : 31) * 64 * DFF; _Pragma("unroll") for (int r_ = 0; r_ < 8; ++r_) { asm volatile("global_load_dwordx4 %0, %1, off nt" : "=v"(S[r_]) : "v"(bp + (size_t)r_ * DFF) : "memory"); } }
#endif
#define SQ_USE(S) { _Pragma("unroll") for (int r_ = 0; r_ < 8; ++r_) { asm volatile("" : "+v"(S[r_])); spc[r_] = S[r_]; } }
#define SQ_BAR { _Pragma("unroll") for (int c_ = 0; c_ < 4; ++c_) { u32x4 w_; w_.x = cvt_pk_bf16(spc[0][c_], spc[1][c_]); w_.y = cvt_pk_bf16(spc[2][c_], spc[3][c_]); \
    w_.z = cvt_pk_bf16(spc[4][c_], spc[5][c_]); w_.w = cvt_pk_bf16(spc[6][c_], spc[7][c_]); \
    *(LAS u32x4*)(lds + FG_BOFF + (spb & 1) * FG_BBUF + (4 * nq + c_) * 128 + ((kq ^ ((4 * nq + c_) & 7)) * 16)) = w_; } ++spb; \
    asm volatile("s_waitcnt lgkmcnt(0)" ::: "memory"); __builtin_amdgcn_s_barrier(); }
            SPA_DMA(0) SQ_LD(s0, 0) SPA_DMA(1) SQ_LD(s1, 1)
            for (int t = 0; t < 33; t += 3) {
                SPA_DMA(t + 2) SQ_LD(s2, t + 2) FG_WAITV(16 + SPA_N); SQ_USE(s0) SQ_BAR
                SPA_DMA(t + 3) SQ_LD(s0, t + 3) FG_WAITV(16 + SPA_N); SQ_USE(s1) SQ_BAR
                SPA_DMA(t + 4) SQ_LD(s1, t + 4) FG_WAITV(16 + SPA_N); SQ_USE(s2) SQ_BAR
            }
            asm volatile("s_waitcnt vmcnt(0)" ::: "memory"); SQ_USE(s0) SQ_USE(s1)
        }
    } else {
#if PROBE_STREAM == 11
        const int wave_hi = wave;
        { const int wave = wave_hi - 4; unsigned rowoff[10];
        for (int L = F.vcu; L < NE * 8; L += F.G) { const int e = L >> 3;
#pragma unroll
            for (int i = 0; i < 10; ++i) { const int row = i * 32 + wave * 8 + (lane >> 3); const unsigned rr = (unsigned)((e * 128 + row * 25) & 8191);
                rowoff[i] = (rr * (unsigned)lda + (unsigned)(((lane & 7) ^ ((lane >> 3) & 7)) * 8)) * 2u; }
            FG_DMA(0, 0); FG_DMA(1, 1);
            for (int t = 0; t < 33; ++t) { FG_DMA(((t + 2) % 3), ((t + 2) < 32 ? (t + 2) : 31)); FG_WAITV(10); __builtin_amdgcn_s_barrier(); }
            asm volatile("s_waitcnt vmcnt(0)" ::: "memory");
        } }
#else
        for (int L = F.vcu; L < NE * 8; L += F.G) for (int t = 0; t < 33; ++t) __builtin_amdgcn_s_barrier();
#endif
    }
#endif
    asm volatile("s_waitcnt vmcnt(0)" ::: "memory");
    __syncthreads();
}
#endif

__global__ void __launch_bounds__(NTHR, 2) mk_fwd(Args args_by_value) {
    (void)args_by_value;
    AV args; args.kp = (kptr_t)__builtin_amdgcn_kernarg_segment_ptr();
    extern __shared__ __attribute__((aligned(16))) unsigned char lds[];
    Frame F;
    F.lds = (LAS unsigned char*)lds;
    F.MISC = (volatile LAS unsigned*)(F.lds + MISC_OFF);
    F.tid = threadIdx.x; F.lane = F.tid & 63; F.wave = __builtin_amdgcn_readfirstlane(F.tid >> 6);
    F.G = gridDim.x; { const int bx = blockIdx.x; F.vcu = (F.G % 8 == 0) ? (bx % 8) * (F.G / 8) + bx / 8 : bx; }
    F.ws = args.ws(); F.ctl = (gu32*)(F.ws + WS_CTL);
    for (int u = F.tid; u < (LDS_BYTES - MISC_OFF) / 4; u += NTHR) ((LAS unsigned*)(F.lds + MISC_OFF))[u] = 0u;
    __syncthreads();
    XcdBarrier bar = xcd_barrier_post((unsigned*)(F.ctl + CW_BAR), F.MISC + 8);
    { unsigned long long pc0; asm volatile("s_getpc_b64 %0" : "=s"(pc0)); bar.code = (const char*)(pc0 & ~127ull); bar.loc = F.vcu & 31; }
    const int lo = args.ph_lo(), hi = args.ph_hi();
#ifndef PROBE_MASK
#define PROBE_MASK 0
#define PROBE_EXTRA 0
#endif
#ifndef PROBE_MODE
#define PROBE_MODE 0
#endif
#define IN(k) (lo <= (k) && (k) < hi)
#define BOTH(k) (IN(k) && IN((k) + 1))
#define GRID_BAR() xcd_barrier(bar)
    unsigned char* ws = F.ws;
    unsigned long long ts_a = 0, ts_b = 0; (void)ts_a; (void)ts_b;
#ifdef TS_A
#define TSREC(k) if ((k) == TS_A) ts_a = __builtin_amdgcn_s_memrealtime(); if ((k) == TS_B) ts_b = __builtin_amdgcn_s_memrealtime();
#else
#define TSREC(k)
#endif
    TSREC(0) if (IN(0)) for (int rep_ = 0; rep_ < (((PROBE_MASK >> 0) & 1) ? 1 + PROBE_EXTRA : 1); ++rep_) { F.tid = mk_otid(); F.lane = F.tid & 63; p0_prologue(F, args, (rep_ < (((PROBE_MASK >> 0) & 1) ? PROBE_EXTRA : 0)) ? PROBE_MODE : 7, ts_a, ts_b); } if (BOTH(0)) GRID_BAR();
    TSREC(1) if (IN(1)) for (int rep_ = 0; rep_ < (((PROBE_MASK >> 1) & 1) ? 1 + PROBE_EXTRA : 1); ++rep_) { F.tid = mk_otid(); F.lane = F.tid & 63;
        pg8::Gemm g{D, D, D}; PlainSched S; S.init((const bf16_t*)(ws + WS_XN), D, (const bf16_t*)(ws + WS_W1T), D, T, DIN, F.G, (int)blockIdx.x);
        EpiG1 E{(bf16_t*)(ws + WS_QH), (bf16_t*)(ws + WS_KH), (bf16_t*)(ws + WS_VH), (bf16_t*)(ws + WS_U), args.in(4), args.in(5), (LAS float*)(F.lds + EPI_TBL)};
        pg8::gemm_phase<EpiG1, PlainSched>(F.lds + RING_OFF, g, S, E);
    } if (BOTH(1)) GRID_BAR();
#ifdef PROBE_XBAR
    for (int xb_ = 0; xb_ < PROBE_XBAR; ++xb_) GRID_BAR();
#endif
    TSREC(2) if (IN(2)) for (int rep_ = 0; rep_ < (((PROBE_MASK >> 2) & 1) ? 1 + PROBE_EXTRA : 1); ++rep_) { F.tid = mk_otid(); F.lane = F.tid & 63; if (rep_ == 0 || PROBE_MODE != 9) p2_attention(F, (char*)lds + RING_OFF);
        __syncthreads(); TSREC(130)
        if (rep_ == 0 || PROBE_MODE != 8) for (int L = F.vcu; L < NB * NG; L += F.G) ssm_unit(F, L & 3, L >> 2);
        TSREC(131)
        if (rep_ == 0) mid_weight_copies(F, args, F.vcu * NWAVES + F.wave, F.G * NWAVES);
        } if (BOTH(2)) GRID_BAR();
    TSREC(3) if (IN(3)) for (int rep_ = 0; rep_ < (((PROBE_MASK >> 3) & 1) ? 1 + PROBE_EXTRA : 1); ++rep_) { F.tid = mk_otid(); F.lane = F.tid & 63;
        p3_combine(F, args.in(10), F.vcu * NWAVES + F.wave, F.G * NWAVES);
        __syncthreads(); TSREC(111)
        float* ssq = (float*)(ws + WS_SSQ); const int G = F.G, bx = (int)blockIdx.x;
        if (rep_ == 0) late_weight_copies(F, args, F.vcu * NWAVES + F.wave, G * NWAVES);
        __syncthreads(); TSREC(112)
        { pg8::Gemm g{DSSM, DSSM, DSSM}; PlainSched S; S.init((const bf16_t*)(ws + WS_YG), DSSM, (const bf16_t*)(ws + WS_WGLU), DSSM, T, DSSM, G, bx);
          EpiGlu E{(const bf16_t*)(ws + WS_YG), args.in(20), (bf16_t*)(ws + WS_CAT), ssq + SQ_S};
          pg8::gemm_phase<EpiGlu, PlainSched>(F.lds + RING_OFF, g, S, E); }
        TSREC(113)
        { pg8::Gemm g{1024, D, D}; SchedKV S{G, (bx + G - (128 % G)) % G, (const char*)(ws + WS_MN), (const char*)(ws + WS_WXK), (const char*)(ws + WS_WXV)};
          EpiF32Slab E{(float*)(ws + WS_QX)};
          pg8::gemm_phase<EpiF32Slab, SchedKV>(F.lds + RING_OFF, g, S, E); }
        } if (BOTH(3)) GRID_BAR();
    TSREC(4) if (IN(4)) for (int rep_ = 0; rep_ < (((PROBE_MASK >> 4) & 1) ? 1 + PROBE_EXTRA : 1); ++rep_) { F.tid = mk_otid(); F.lane = F.tid & 63;
        if (rep_ == (((PROBE_MASK >> 4) & 1) ? PROBE_EXTRA : 0)) kv_finish(F, args.in(27), args.in(28), F.vcu * NWAVES + F.wave, F.G * NWAVES);
        float* ssq = (float*)(ws + WS_SSQ);
        pg8::Gemm g{D, D, D}; PlainSched S; S.init((const bf16_t*)(ws + WS_CAT), D, (const bf16_t*)(ws + WS_WOUT), D, T, D, F.G, (int)blockIdx.x);
        EpiOut E{args.in(0), (float*)(ws + WS_H1), (bf16_t*)(ws + WS_XN), ssq + SQ_S, ssq + SQ_H1, (LAS float*)(F.lds + RTAB_OFF), (LAS float*)(F.lds + EPI_TBL)};
        pg8::gemm_phase<EpiOut, PlainSched>(F.lds + RING_OFF, g, S, E);
        } if (BOTH(4)) GRID_BAR();

    TSREC(5) if (IN(5)) for (int rep_ = 0; rep_ < (((PROBE_MASK >> 5) & 1) ? 1 + PROBE_EXTRA : 1); ++rep_) { F.tid = mk_otid(); F.lane = F.tid & 63;
        float* ssq = (float*)(ws + WS_SSQ);
        pg8::Gemm g{D, D, D}; PlainSched S; S.init((const bf16_t*)(ws + WS_XN), D, (const bf16_t*)(ws + WS_WXQ), D, T, D, F.G, (int)blockIdx.x);
        typedef EpiGen<1, 32, false, 0, false, true, 1> E5;
        E5 E{ssq + SQ_H1, 1.f / 2048.f, nullptr, nullptr, (bf16_t*)(ws + WS_QX), D, ssq + SQ_QX, (LAS float*)(F.lds + RTAB_OFF), (LAS float*)(F.lds + EPI_TBL), nullptr};
        struct S5 { PlainSched s; __device__ __forceinline__ bool next(int i, pg8::Unit& u) const { if (!s.next(i, u)) return false; u.aux1 = u.pn * 4; return true; } } S5v{S};
        pg8::gemm_phase<E5, S5>(F.lds + RING_OFF, g, S5v, E);
        } if (BOTH(5)) GRID_BAR();
    TSREC(6) if (IN(6)) for (int rep_ = 0; rep_ < (((PROBE_MASK >> 6) & 1) ? 1 + PROBE_EXTRA : 1); ++rep_) { F.tid = mk_otid(); F.lane = F.tid & 63;
        float* ssq = (float*)(ws + WS_SSQ);
        pg8::Gemm g{512, D, D}; SchedSV S{F.G, F.vcu, (const char*)(ws + WS_QX), (const char*)(ws + WS_KX), (const char*)(ws + WS_WXO), (const char*)(ws + WS_VXT)};
        EpiSV E{ssq + SQ_QX, (bf16_t*)(ws + WS_PX), (bf16_t*)(ws + WS_OX), (LAS float*)(F.lds + RTAB_OFF), (LAS float*)(F.lds + EPI_TBL + 4096), (LAS float*)(F.lds + EPI_TBL)};
        pg8::gemm_phase<EpiSV, SchedSV>(F.lds + RING_OFF, g, S, E);
        } if (BOTH(6)) GRID_BAR();
    TSREC(8) if (IN(8)) for (int rep_ = 0; rep_ < (((PROBE_MASK >> 8) & 1) ? 1 + PROBE_EXTRA : 1); ++rep_) { F.tid = mk_otid(); F.lane = F.tid & 63;
        float* ssq = (float*)(ws + WS_SSQ);
        pg8::Gemm g{1024, 1024, 1024}; SchedPVW S; S.o.init(T / 256, D / 256, F.G, (int)blockIdx.x); S.A = (const char*)(ws + WS_PX); S.B = (const char*)(ws + WS_OX);
        typedef EpiGen<0, 4, false, 2, false, true, 1> E8;
        E8 E{nullptr, 0.f, nullptr, nullptr, (bf16_t*)(ws + WS_H1), D, ssq + SQ_H2, (LAS float*)(F.lds + RTAB_OFF), (LAS float*)(F.lds + EPI_TBL), (const bf16_t*)(ws + WS_XN)};
        pg8::gemm_phase<E8, SchedPVW>(F.lds + RING_OFF, g, S, E);
        } if (BOTH(8)) GRID_BAR();
    TSREC(9) if (IN(9)) for (int rep_ = 0; rep_ < (((PROBE_MASK >> 9) & 1) ? 1 + PROBE_EXTRA : 1); ++rep_) { F.tid = mk_otid(); F.lane = F.tid & 63; p9_router(F, args, rep_ == (((PROBE_MASK >> 9) & 1) ? PROBE_EXTRA : 0), ts_a, ts_b); } if (BOTH(9)) GRID_BAR();
    TSREC(11) if (IN(11)) for (int rep_ = 0; rep_ < (((PROBE_MASK >> 11) & 1) ? 1 + PROBE_EXTRA : 1); ++rep_) { F.tid = mk_otid(); F.lane = F.tid & 63;
        moe_tables(F);
        { const int nv_ = (NE * 8 - F.vcu + F.G - 1) / F.G;
          if (!(rep_ < (((PROBE_MASK >> 11) & 1) ? PROBE_EXTRA : 0) && PROBE_MODE != 0) && FG_STREAM && (int)F.MISC[MT_MAX] <= FG_ROWS && nv_ <= 2 && FG_PASS == FG_ROWS) fg_stream<true>(F, args, nv_); else
        for (int L = F.vcu; L < NE * 8; L += F.G) { const int e = L >> 3, jt = L & 7; const int row0 = (int)F.MISC[MT_START + e], n = (int)F.MISC[MT_CNT + e];
            const unsigned short* tokl = (const unsigned short*)(ws + WS_MOE + MOE_TOK) + (size_t)e * T;
            if (rep_ < (((PROBE_MASK >> 11) & 1) ? PROBE_EXTRA : 0)) fg_unit<true, PROBE_MODE>(F, (const bf16_t*)(ws + WS_XN), D, D, n, args.in(35) + (size_t)e * D * DFF + jt * 64, args.in(36) + (size_t)e * D * DFF + jt * 64, DFF,
                          (bf16_t*)(ws + WS_ACT) + (size_t)row0 * DFF + jt * 64, DFF, nullptr, tokl);
            else fg_unit<true>(F, (const bf16_t*)(ws + WS_XN), D, D, n, args.in(35) + (size_t)e * D * DFF + jt * 64, args.in(36) + (size_t)e * D * DFF + jt * 64, DFF,
                          (bf16_t*)(ws + WS_ACT) + (size_t)row0 * DFF + jt * 64, DFF, nullptr, tokl, (SIBSYNC && F.G == 256) ? (unsigned*)(F.ctl + CW_CNT + 16384) + e * 64 + (L / F.G) * 8 : nullptr, 8u, FG_ROT11); } }
        } if (BOTH(11)) GRID_BAR();
    TSREC(12) if (IN(12)) for (int rep_ = 0; rep_ < (((PROBE_MASK >> 12) & 1) ? 1 + PROBE_EXTRA : 1); ++rep_) { F.tid = mk_otid(); F.lane = F.tid & 63;
        if (!IN(11)) moe_tables(F);
        { const int nv_ = (NE * 16 - F.vcu + F.G - 1) / F.G;
          if (!(rep_ < (((PROBE_MASK >> 12) & 1) ? PROBE_EXTRA : 0) && PROBE_MODE != 0) && FG_STREAM && (int)F.MISC[MT_MAX] <= FG_ROWS && FG_PASS == FG_ROWS) fg_stream<false>(F, args, nv_); else
        for (int L = F.vcu; L < NE * 16; L += F.G) { const int e = L >> 4, nt = L & 15; const int row0 = (int)F.MISC[MT_START + e], n = (int)F.MISC[MT_CNT + e];
            if (rep_ < (((PROBE_MASK >> 12) & 1) ? PROBE_EXTRA : 0)) fg_unit<false, PROBE_MODE>(F, (const bf16_t*)(ws + WS_ACT) + (size_t)row0 * DFF, DFF, DFF, n, args.in(37) + (size_t)e * DFF * D + nt * 128, nullptr, D,
                           (bf16_t*)(ws + WS_YS) + (size_t)row0 * D + nt * 128, D, (const float*)(ws + WS_MOE + MOE_RWL) + (size_t)e * T);
            else fg_unit<false>(F, (const bf16_t*)(ws + WS_ACT) + (size_t)row0 * DFF, DFF, DFF, n, args.in(37) + (size_t)e * DFF * D + nt * 128, nullptr, D,
                           (bf16_t*)(ws + WS_YS) + (size_t)row0 * D + nt * 128, D, (const float*)(ws + WS_MOE + MOE_RWL) + (size_t)e * T, nullptr, nullptr, 16u, FG_ROT12); } }
        } if (BOTH(12)) GRID_BAR();
    TSREC(13) if (IN(13)) for (int rep_ = 0; rep_ < (((PROBE_MASK >> 13) & 1) ? 1 + PROBE_EXTRA : 1); ++rep_) { F.tid = mk_otid(); F.lane = F.tid & 63; p13_combine(F, args, rep_ == (((PROBE_MASK >> 13) & 1) ? PROBE_EXTRA : 0), !IN(11)); }
#ifdef TS_A
    TSREC(14)
    { const unsigned long long dl = ts_b > ts_a ? (ts_b - ts_a) * TS_MULT : 0ull, t0 = __builtin_amdgcn_s_memrealtime();
      while (__builtin_amdgcn_s_memrealtime() - t0 < dl) __builtin_amdgcn_s_sleep(8); }
#endif
#ifdef PROBE_STREAM
    GRID_BAR();
    for (int rep_ = 0; rep_ < PROBE_EXTRA; ++rep_) { stream_probe(F, args); }
#endif
#undef IN
#undef BOTH
}
}

extern "C" void kernel_launch(void* const* d_in, const int* in_sizes, int n_in, void* d_out, int out_size, void* d_ws, size_t ws_size, hipStream_t stream) {
    static int grid = 0;
    if (grid == 0) {
        if (n_in != 38 || out_size != mk::T * mk::D || ws_size < mk::WS_END) { fprintf(stderr, "kernel_launch: unexpected shapes (n_in %d, out %d, ws %zu)\n", n_in, out_size, ws_size); grid = -1; return; }
        int dev = 0, cus = 0; (void)hipGetDevice(&dev); (void)hipDeviceGetAttribute(&cus, hipDeviceAttributeMultiprocessorCount, dev);
        (void)hipFuncSetAttribute((const void*)mk::mk_fwd, hipFuncAttributeMaxDynamicSharedMemorySize, mk::LDS_BYTES);
        int per_cu = 0; (void)hipOccupancyMaxActiveBlocksPerMultiprocessor(&per_cu, (const void*)mk::mk_fwd, mk::NTHR, mk::LDS_BYTES);
        (void)hipGetLastError();
        grid = cus > 0 ? cus : 256;
        if (per_cu < 1) { fprintf(stderr, "kernel_launch: occupancy query reports %d blocks per CU; nothing launched\n", per_cu); grid = -1; return; }
    }
    if (grid < 0) return;
    (void)hipMemsetAsync((char*)d_ws + mk::WS_CTL, 0, mk::CTL_ZERO_BYTES, stream);
    mk::Args a{}; for (int i = 0; i < 38; ++i) a.in[i] = (const float*)d_in[i]; a.out = (float*)d_out; a.ws = (unsigned char*)d_ws; a.ph_lo = 0; a.ph_hi = 14;
    hipLaunchKernelGGL(mk::mk_fwd, dim3(grid), dim3(mk::NTHR), mk::LDS_BYTES, stream, a);
}
```
